# Optimizing an MI355X kernel written in HIP

```python
import math
import jax
import jax.numpy as jnp
from jax import lax
import numpy as np

D_MODEL = 1024
BATCH = 8
SEQ = 2048
DEPTH = 4

CTX_LEN = 256
GRID_W = 64
N_BRANCH = 3
N_MOD = 9
D_FF = 2816
MLA_HEADS = 8
MLA_NOPE = 64
MLA_ROPE = 32
MLA_QK = MLA_NOPE + MLA_ROPE
MLA_V = 64
MLA_Q_RANK = 384
MLA_KV_RANK = 256
DIFF_HEADS = 4
DIFF_DIM = 64
DIFF_V = 2 * DIFF_DIM
CONV_WIDTH = 512
CONV_K = 3
BRANCH_WIDTH = 512
Q_BLOCK = 128
ROPE_THETA = 10000.0
EPS = 1e-6

IN_SIZES = (MLA_Q_RANK, MLA_KV_RANK, MLA_ROPE,
            DIFF_HEADS * 2 * DIFF_DIM, DIFF_HEADS * 2 * DIFF_DIM, DIFF_HEADS * DIFF_V,
            CONV_WIDTH, CONV_WIDTH, CONV_WIDTH,
            N_BRANCH * D_MODEL)
IN_WIDTH = sum(IN_SIZES)
IN_OFFSETS = tuple(sum(IN_SIZES[:i + 1]) for i in range(len(IN_SIZES) - 1))

kernel_name = 'hybrid_mla_diffattn_shortconv_macaron_dit'


def rms_norm(x, g):
    xf = x.astype(jnp.float32)
    y = xf * lax.rsqrt(jnp.mean(xf * xf, axis=-1, keepdims=True) + EPS)
    return (y * g.astype(jnp.float32)).astype(x.dtype)


def modulate(x, g, shift, scale):
    return rms_norm(x, g) * (1.0 + scale) + shift


def swiglu(h, w_up, w_down):
    a, b = jnp.split(h @ w_up, 2, axis=-1)
    return (jax.nn.silu(a) * b) @ w_down


def axial_angles(n_tokens, rot_dim):
    rows = n_tokens // GRID_W
    row = jnp.broadcast_to(jnp.arange(rows, dtype=jnp.float32)[:, None], (rows, GRID_W)).reshape(-1)
    col = jnp.broadcast_to(jnp.arange(GRID_W, dtype=jnp.float32)[None, :], (rows, GRID_W)).reshape(-1)
    quarter = rot_dim // 4
    inv_freq = ROPE_THETA ** (-jnp.arange(quarter, dtype=jnp.float32) / quarter)
    return jnp.concatenate([row[:, None] * inv_freq, col[:, None] * inv_freq], axis=-1)


def apply_rope2d(x, ang):
    r = x.shape[-1]
    q4 = r // 4
    xs = x.astype(jnp.float32).reshape(x.shape[:-1] + (2, 2, q4))
    extra = x.ndim - 3
    a = ang.reshape((ang.shape[0],) + (1,) * extra + (2, q4))
    cos, sin = jnp.cos(a), jnp.sin(a)
    x1, x2 = xs[..., 0, :], xs[..., 1, :]
    out = jnp.stack([x1 * cos - x2 * sin, x2 * cos + x1 * sin], axis=-2)
    return out.reshape(x.shape).astype(x.dtype)


def rope_tail(x, ang, rot_dim):
    return jnp.concatenate([x[..., :-rot_dim], apply_rope2d(x[..., -rot_dim:], ang)], axis=-1)


def attend(q, k, v, mix, scale):
    b, sq, h, m, dk = q.shape
    blk = min(Q_BLOCK, sq)
    nb = sq // blk
    qb = jnp.moveaxis(q.reshape(b, nb, blk, h, m, dk), 1, 0)

    def one_block(qi):
        s = jnp.einsum('bqhmd,bkhmd->bhmqk', qi, k, preferred_element_type=jnp.float32) * scale
        p = jnp.einsum('bhmqk,m->bhqk', jax.nn.softmax(s, axis=-1), mix)
        return jnp.einsum('bhqk,bkhe->bqhe', p.astype(v.dtype), v)

    o = lax.map(one_block, qb)
    return jnp.moveaxis(o, 0, 1).reshape(b, sq, h, v.shape[-1])


def short_conv(u, w):
    t = u.shape[1]
    half = CONV_K // 2
    up = jnp.pad(u, ((0, 0), (half, half), (0, 0)))
    y = w[0] * up[:, :t]
    for j in range(1, CONV_K):
        y = y + w[j] * up[:, j:j + t]
    return y


def merge(branches, gate_logits, w_br, w_o):
    b, s, _ = gate_logits.shape
    y = jnp.stack(branches, axis=2)
    g = jax.nn.sigmoid(gate_logits.reshape(b, s, N_BRANCH, D_MODEL))
    m = jnp.sum(g * jnp.einsum('bsnw,nwd->bsnd', y, w_br), axis=2)
    return m @ w_o


def mixer(h_ctx, h_lat, ang_mla, ang_diff, p, lam_init, need_ctx):
    b, s, _ = h_lat.shape
    n_ctx = h_ctx.shape[1]
    t = n_ctx + s
    h_all = jnp.concatenate([h_ctx, h_lat], axis=1)
    proj = h_all @ p['w_in']
    (c_q, c_kv, k_rope, dq, dk, dv, conv_b, conv_c, conv_x, gate_logits) = jnp.split(proj, IN_OFFSETS, axis=-1)

    q = (rms_norm(c_q, p['g_cq']) @ p['w_uq']).reshape(b, t, MLA_HEADS, MLA_QK)
    kv = (rms_norm(c_kv, p['g_ckv']) @ p['w_ukv']).reshape(b, t, MLA_HEADS, MLA_NOPE + MLA_V)
    k_nope, v = kv[..., :MLA_NOPE], kv[..., MLA_NOPE:]
    k = jnp.concatenate([k_nope, jnp.broadcast_to(k_rope[:, :, None, :], (b, t, MLA_HEADS, MLA_ROPE))], axis=-1)
    q = rms_norm(q, p['g_q_mla'])
    k = rms_norm(k, p['g_k_mla'])
    k = jnp.concatenate([k[:, :n_ctx], rope_tail(k[:, n_ctx:], ang_mla, MLA_ROPE)], axis=1)
    q_lat = rope_tail(q[:, n_ctx:], ang_mla, MLA_ROPE)
    one = jnp.ones((1,), jnp.float32)
    mla_scale = MLA_QK ** -0.5
    mla_lat = attend(q_lat[:, :, :, None], k[:, :, :, None], v, one, mla_scale).reshape(b, s, BRANCH_WIDTH)

    dq = rms_norm(dq.reshape(b, t, DIFF_HEADS, 2, DIFF_DIM), p['g_q_diff'])
    dk = rms_norm(dk.reshape(b, t, DIFF_HEADS, 2, DIFF_DIM), p['g_k_diff'])
    dv = dv.reshape(b, t, DIFF_HEADS, DIFF_V)
    dk = jnp.concatenate([dk[:, :n_ctx], apply_rope2d(dk[:, n_ctx:], ang_diff)], axis=1)
    dq_lat = apply_rope2d(dq[:, n_ctx:], ang_diff)
    lv = p['lam'].astype(jnp.float32)
    lam = jnp.exp(jnp.sum(lv[0] * lv[1])) - jnp.exp(jnp.sum(lv[2] * lv[3])) + lam_init
    diff_mix = jnp.stack([jnp.ones_like(lam), -lam])
    diff_scale = DIFF_DIM ** -0.5

    def diff_out(o):
        return (rms_norm(o, p['g_subln']) * (1.0 - lam_init)).reshape(o.shape[0], o.shape[1], BRANCH_WIDTH)

    diff_lat = diff_out(attend(dq_lat, dk, dv, diff_mix, diff_scale))

    u = conv_c * conv_x
    conv_lat = conv_b[:, n_ctx:] * short_conv(u[:, n_ctx:], p['conv_w'])

    out_lat = merge([mla_lat, diff_lat, conv_lat], gate_logits[:, n_ctx:], p['w_br'], p['w_o'])
    if not need_ctx:
        return None, out_lat

    mla_ctx = attend(q[:, :n_ctx, :, None], k[:, :n_ctx, :, None], v[:, :n_ctx], one, mla_scale).reshape(b, n_ctx, BRANCH_WIDTH)
    diff_ctx = diff_out(attend(dq[:, :n_ctx], dk[:, :n_ctx], dv[:, :n_ctx], diff_mix, diff_scale))
    conv_ctx = conv_b[:, :n_ctx] * short_conv(u[:, :n_ctx], p['conv_w'])
    out_ctx = merge([mla_ctx, diff_ctx, conv_ctx], gate_logits[:, :n_ctx], p['w_br'], p['w_o'])
    return out_ctx, out_lat


def setup_inputs(seed: int = 0) -> dict:
    key = jax.random.key(seed)
    ks = iter(jax.random.split(key, 32))

    def normal(shape, scale):
        return scale * jax.random.normal(next(ks), shape, jnp.float32)

    def gain(shape):
        return 1.0 + 0.02 * jax.random.normal(next(ks), shape, jnp.float32)

    d, n = D_MODEL, DEPTH
    return {
        'x': normal((BATCH, SEQ, d), 1.0),
        'c': normal((BATCH, d), 1.0),
        'ctx': normal((BATCH, CTX_LEN, d), 1.0),
        'c_ctx': normal((d,), 1.0),
        'w_mod': normal((n, d, N_MOD * d), 0.5 * d ** -0.5),
        'b_mod': normal((n, N_MOD * d), 0.01),
        'norm_g': gain((n, 3, d)),
        'ffn1_up': normal((n, d, 2 * D_FF), d ** -0.5),
        'ffn1_down': normal((n, D_FF, d), D_FF ** -0.5),
        'ffn2_up': normal((n, d, 2 * D_FF), d ** -0.5),
        'ffn2_down': normal((n, D_FF, d), D_FF ** -0.5),
        'w_in': normal((n, d, IN_WIDTH), d ** -0.5),
        'g_cq': gain((n, MLA_Q_RANK)),
        'w_uq': normal((n, MLA_Q_RANK, MLA_HEADS * MLA_QK), MLA_Q_RANK ** -0.5),
        'g_ckv': gain((n, MLA_KV_RANK)),
        'w_ukv': normal((n, MLA_KV_RANK, MLA_HEADS * (MLA_NOPE + MLA_V)), MLA_KV_RANK ** -0.5),
        'g_q_mla': gain((n, MLA_QK)),
        'g_k_mla': gain((n, MLA_QK)),
        'g_q_diff': gain((n, DIFF_DIM)),
        'g_k_diff': gain((n, DIFF_DIM)),
        'lam': normal((n, 4, DIFF_DIM), 0.1),
        'g_subln': gain((n, DIFF_V)),
        'conv_w': normal((n, CONV_K, CONV_WIDTH), CONV_K ** -0.5),
        'w_br': normal((n, N_BRANCH, BRANCH_WIDTH, d), BRANCH_WIDTH ** -0.5),
        'w_o': normal((n, d, d), d ** -0.5),
    }


def reference(x, c, ctx, c_ctx, w_mod, b_mod, norm_g, ffn1_up, ffn1_down, ffn2_up, ffn2_down,
              w_in, g_cq, w_uq, g_ckv, w_ukv, g_q_mla, g_k_mla, g_q_diff, g_k_diff, lam,
              g_subln, conv_w, w_br, w_o):
    b, s, d = x.shape
    ang_mla = axial_angles(s, MLA_ROPE)
    ang_diff = axial_angles(s, DIFF_DIM)
    cond = jax.nn.silu(c)
    cond_ctx = jax.nn.silu(c_ctx)
    xl, xc = x, ctx
    for l in range(DEPTH):
        last = l == DEPTH - 1
        mod_l = (cond @ w_mod[l] + b_mod[l]).reshape(b, N_MOD, 1, d)
        mod_c = (cond_ctx @ w_mod[l] + b_mod[l]).reshape(N_MOD, d)
        ml = [mod_l[:, i] for i in range(N_MOD)]
        mc = [mod_c[i] for i in range(N_MOD)]

        xl = xl + 0.5 * ml[2] * swiglu(modulate(xl, norm_g[l, 0], ml[0], ml[1]), ffn1_up[l], ffn1_down[l])
        xc = xc + 0.5 * mc[2] * swiglu(modulate(xc, norm_g[l, 0], mc[0], mc[1]), ffn1_up[l], ffn1_down[l])

        hl = modulate(xl, norm_g[l, 1], ml[3], ml[4])
        hc = modulate(xc, norm_g[l, 1], mc[3], mc[4])
        p = {'w_in': w_in[l], 'g_cq': g_cq[l], 'w_uq': w_uq[l], 'g_ckv': g_ckv[l], 'w_ukv': w_ukv[l],
             'g_q_mla': g_q_mla[l], 'g_k_mla': g_k_mla[l], 'g_q_diff': g_q_diff[l], 'g_k_diff': g_k_diff[l],
             'lam': lam[l], 'g_subln': g_subln[l], 'conv_w': conv_w[l], 'w_br': w_br[l], 'w_o': w_o[l]}
        lam_init = 0.8 - 0.6 * math.exp(-0.3 * l)
        oc, ol = mixer(hc, hl, ang_mla, ang_diff, p, lam_init, not last)
        xl = xl + ml[5] * ol

        xl = xl + 0.5 * ml[8] * swiglu(modulate(xl, norm_g[l, 2], ml[6], ml[7]), ffn2_up[l], ffn2_down[l])
        if not last:
            xc = xc + mc[5] * oc
            xc = xc + 0.5 * mc[8] * swiglu(modulate(xc, norm_g[l, 2], mc[6], mc[7]), ffn2_up[l], ffn2_down[l])
    return xl
```

```cpp
#include <hip/hip_runtime.h>
#include <hip/hip_cooperative_groups.h>
#include <cstdio>
#include <type_traits>
namespace cg = cooperative_groups;

#define LAS __attribute__((address_space(3)))
typedef unsigned short bf16_t;
typedef short bf16x8 __attribute__((ext_vector_type(8)));
typedef float f32x4 __attribute__((ext_vector_type(4)));
typedef float f32x2 __attribute__((ext_vector_type(2)));
typedef unsigned u32x4 __attribute__((ext_vector_type(4)));
typedef unsigned u32x2 __attribute__((ext_vector_type(2)));
typedef __bf16 bf16x2_t __attribute__((ext_vector_type(2)));
#define DI __device__ __forceinline__

constexpr int D = 1024, NB = 8, SEQ = 2048, NCTX = 256, TT = 2304, DEPTH = 4;
constexpr int ML = NB * SEQ;
constexpr int MC = NB * NCTX;
constexpr int MT = ML + MC;
constexpr int DFF = 2816, INW = 6816, INWP = 6912;
constexpr int O_CQ = 0, O_CKV = 384, O_KR = 640, O_DQ = 672, O_DK = 1184, O_DV = 1696, O_CB = 2208, O_CC = 2720, O_CX = 3232, O_G = 3744;
constexpr float EPS = 1e-6f;
constexpr float LOG2E = 1.4426950408889634f;

constexpr size_t al256(size_t x) { return (x + 255) & ~(size_t)255; }
constexpr size_t WS_MOD = 0;
constexpr size_t WS_TAB = al256(WS_MOD + (size_t)4 * 9 * 9216 * 4);
constexpr size_t WS_XC = al256(WS_TAB + (size_t)2048 * 96 * 4);
constexpr size_t WS_W = al256(WS_XC + (size_t)MC * D * 4);
constexpr size_t W_1U = 0, W_1D = W_1U + (size_t)5632 * 1024, W_2U = W_1D + (size_t)1024 * 2816, W_2D = W_2U + (size_t)5632 * 1024,
                 W_IN = W_2D + (size_t)1024 * 2816, W_UQ = W_IN + (size_t)INWP * 1024, W_UKV = W_UQ + (size_t)768 * 384,
                 W_BR = W_UKV + (size_t)1024 * 256, W_O = W_BR + (size_t)3 * 1024 * 512, W_END = W_O + (size_t)1024 * 1024;
constexpr size_t WS_R1 = al256(WS_W + W_END * 2);
constexpr size_t R1_KVRAW = (size_t)MT * 768 * 2;
constexpr size_t WS_PROJ = al256(WS_R1 + (size_t)MT * (768 + 1024) * 2);
constexpr size_t WS_QKV = al256(WS_PROJ + (size_t)MT * INWP * 2);
constexpr size_t Q_QM = 0, Q_KM = Q_QM + (size_t)NB * 8 * TT * 96 * 2, Q_VTM = Q_KM + (size_t)NB * 8 * TT * 96 * 2, Q_QD = Q_VTM + (size_t)NB * 8 * 64 * TT * 2,
                 Q_KD = Q_QD + (size_t)NB * 8 * TT * 64 * 2, Q_VTD = Q_KD + (size_t)NB * 8 * TT * 64 * 2, Q_END = Q_VTD + (size_t)NB * 4 * 128 * TT * 2;
constexpr size_t WS_Y = al256(WS_QKV + Q_END);
constexpr size_t WS_BAR = al256(WS_Y + (size_t)3 * MT * 512 * 2);
constexpr size_t WS_W2 = al256(WS_BAR + 3456 * 4);
constexpr size_t WS_END = al256(WS_W2 + W_END * 2);
static_assert(Q_END >= (size_t)MT * 1024 * 4, "MACC alias");

struct Params {
    const float* in[25];
    float* out;
    unsigned char* ws;
};

DI unsigned pk2(float a, float b) { f32x2 f = {a, b}; bf16x2_t h = __builtin_convertvector(f, bf16x2_t); return __builtin_bit_cast(unsigned, h); }
DI float bflo(unsigned u) { return __uint_as_float(u << 16); }
DI float bfhi(unsigned u) { return __uint_as_float(u & 0xffff0000u); }
DI float wave_sum(float v) {
#pragma unroll
    for (int o = 32; o > 0; o >>= 1) v += __shfl_xor(v, o);
    return v;
}
DI float wave_max(float v) {
#pragma unroll
    for (int o = 32; o > 0; o >>= 1) v = fmaxf(v, __shfl_xor(v, o));
    return v;
}
DI float lam_init_of(int l) { return l == 0 ? 0.2f : (l == 1 ? 0.35550907f : (l == 2 ? 0.47071302f : 0.55605820f)); }
DI float sigmoidf_(float x) { return __builtin_amdgcn_rcpf(1.0f + __builtin_amdgcn_exp2f(-1.4426950408889634f * x)); }
DI int tidx() { int t = threadIdx.x; asm volatile("" : "+v"(t)); return t; }

namespace pg8 {
constexpr int BM = 256, BK = 64, HALF = 128, HTB = HALF * BK * 2, STAGE_BYTES = 8 * HTB, NXCD = 8, WGM = 8;
DI int lds_byte(int r, int c) { const int st = (r >> 4) * 2 + (c >> 5), rr = r & 15, cc = c & 31, ob = rr * 64 + cc * 2; return st * 1024 + (ob ^ (((ob >> 9) & 1) << 5)); }
DI void stage_rc(int b, int& R, int& C) { const int st = b / 1024, sb = b % 1024, swz = sb ^ (((sb >> 9) & 1) << 5); R = (st >> 1) * 16 + swz / 64; C = (st & 1) * 32 + (swz % 64) / 2; }
DI int perm32(int rho) { const int n = rho >> 4, i = rho & 15; return 8 * (i >> 2) + 4 * n + (i & 3); }
struct Unit { int pm, pn, k0, nt, split; };
struct Gemm { const bf16_t* A; const bf16_t* Bt; int lda, K; };

struct Sched {
    int nM, nN, nwg, G, c, rep, aStride, bStride, ntFull;
    int nSplit, P, splitPm0, nb;
    int kseg;
    DI void init(int M, int N, int K, int G_, int c_, int rep_ = 1, int as_ = 0, int bs_ = 0) { nM = M / BM; nN = N / BM; nwg = nM * nN; G = G_; c = c_; rep = rep_; aStride = as_; bStride = bs_; ntFull = K / BK;
        nSplit = 0; P = 1; splitPm0 = 0; nb = K / 128; kseg = 0; }
    DI void add_split(int tilesM, int pm0, int P_) { nSplit = tilesM * nN * P_; P = P_; splitPm0 = pm0; }
    DI bool next(int i, Unit& u) const {
        int it = i, n = 0;
        if (rep > 1) { it = i / rep; n = i - it * rep; }
        const long L = (long)it * G + c;
        if (L >= nwg) {
            const int s = (int)(L - nwg); if (s >= nSplit) return false;
            const int tile = s / P, j = s - tile * P, base = nb / P, rem = nb - base * P;
            u.pm = splitPm0 + tile / nN; u.pn = tile % nN; u.k0 = 128 * (j * base + (j < rem ? j : rem)); u.nt = 2 * (base + (j < rem ? 1 : 0)); u.split = j + 1; return true;
        }
        int wgid = (int)L; { const int q = nwg / NXCD, r = nwg % NXCD, xcd = wgid % NXCD, off = wgid / NXCD; wgid = (xcd < r ? xcd * (q + 1) : r * (q + 1) + (xcd - r) * q) + off; }
        const int nig = WGM * nN, gid = wgid / nig, fm = gid * WGM, gsz = (nM - fm) < WGM ? (nM - fm) : WGM;
        u.pm = fm + ((wgid % nig) % gsz) + n * aStride; u.pn = (wgid % nig) / gsz + n * bStride; u.k0 = 0; u.nt = ntFull; u.split = 0;
        if (kseg) { u.k0 = n * kseg; u.split = n; }
        return true;
    }
};

template <class Epi>
DI void gemm_phase(LAS unsigned char* lds, const Gemm g, const Sched& S, const Epi& E) {
    const int tid = tidx(), wid = __builtin_amdgcn_readfirstlane(tid >> 6), lane = tid & 63, wr = wid >> 2, wc = wid & 3, fr = lane & 15, fq = lane >> 4;
    const int K = g.K, lda = g.lda;
    unsigned voffA[2], voffB[2];
#pragma unroll
    for (int i = 0; i < 2; ++i) { int R, C; stage_rc(tid * 16 + i * 8192, R, C); const int Rb = Epi::PERM ? ((R & ~31) + perm32(R & 31)) : R;
        voffA[i] = (unsigned)(R * lda + C) * 2u; voffB[i] = (unsigned)(Rb * K + C) * 2u; }
    const size_t kstep = (size_t)(BK * 2);
    const size_t hstepA = (size_t)HALF * lda * 2, hstepB = (size_t)HALF * K * 2;
    const size_t tstepA = 2 * hstepA, tstepB = 2 * hstepB;
    const unsigned ldsw = (unsigned)wid * 1024u;
    const int aoff = lds_byte(wr * 64 + fr, fq * 8), boff = lds_byte(wc * 32 + fr, fq * 8);
#define PG8_SA(b, h) (((b) * 2 + (h)) * HTB)
#define PG8_SB(b, h) ((4 + (b) * 2 + (h)) * HTB)
#define PG8_STAGE(bufoff, gbase, voff) do { _Pragma("unroll") for (int _i = 0; _i < 2; ++_i) \
        __builtin_amdgcn_global_load_lds((const unsigned*)((const char*)(gbase) + (voff)[_i]), (LAS unsigned*)(lds + (bufoff) + ldsw + _i * 8192), 16, 0, 0); } while (0)
#define PG8_LDA(dst, b, h) do { _Pragma("unroll") for (int m = 0; m < 4; ++m) _Pragma("unroll") for (int k = 0; k < 2; ++k) dst[m][k] = *(const LAS bf16x8*)(lds + PG8_SA(b, h) + aoff + m * 2048 + k * 1024); } while (0)
#define PG8_LDB(dst, b, h) do { _Pragma("unroll") for (int n = 0; n < 2; ++n) _Pragma("unroll") for (int k = 0; k < 2; ++k) dst[n][k] = *(const LAS bf16x8*)(lds + PG8_SB(b, h) + boff + n * 2048 + k * 1024); } while (0)
#define PG8_MMA(ai, bj, At, Bt) do { __builtin_amdgcn_s_setprio(1); _Pragma("unroll") for (int m = 0; m < 4; ++m) _Pragma("unroll") for (int n = 0; n < 2; ++n) _Pragma("unroll") for (int k = 0; k < 2; ++k) \
        acc[ai][bj][m][n] = __builtin_amdgcn_mfma_f32_16x16x32_bf16(Bt[n][k], At[m][k], acc[ai][bj][m][n], 0, 0, 0); __builtin_amdgcn_s_setprio(0); } while (0)
#define PG8_WAIT_V(n) asm volatile("s_waitcnt vmcnt(" #n ")" ::: "memory")
#define PG8_WAIT_L(n) asm volatile("s_waitcnt lgkmcnt(" #n ")" ::: "memory")
#define PG8_BAR __builtin_amdgcn_s_barrier()
#define PG8_SCHED __builtin_amdgcn_sched_barrier(0)
    Unit cur, nxt; int ui = 0;
    if (!S.next(0, cur)) return;
    f32x4 acc[2][2][4][2];
#pragma unroll
    for (int a = 0; a < 2; ++a)
#pragma unroll
        for (int b = 0; b < 2; ++b)
#pragma unroll
            for (int m = 0; m < 4; ++m)
#pragma unroll
                for (int n = 0; n < 2; ++n) acc[a][b][m][n] = (f32x4){0.f, 0.f, 0.f, 0.f};
    bf16x8 At[4][2], B0[2][2], B1[2][2];
    const char* cA = (const char*)g.A + (size_t)cur.pm * tstepA + (size_t)cur.k0 * 2; const char* cB = (const char*)g.Bt + (size_t)cur.pn * tstepB + (size_t)cur.k0 * 2;
    PG8_STAGE(PG8_SB(0, 0), cB, voffB); PG8_STAGE(PG8_SA(0, 0), cA, voffA); PG8_STAGE(PG8_SB(0, 1), cB + hstepB, voffB); PG8_STAGE(PG8_SA(0, 1), cA + hstepA, voffA);
    if (wr == 1) PG8_BAR;
    PG8_WAIT_V(4); PG8_BAR;
    PG8_STAGE(PG8_SB(1, 0), cB + kstep, voffB); PG8_STAGE(PG8_SA(1, 0), cA + kstep, voffA); PG8_STAGE(PG8_SB(1, 1), cB + hstepB + kstep, voffB);
    PG8_WAIT_V(6); PG8_BAR;
    for (;;) {
        const bool has_next = S.next(ui + 1, nxt);
        const char* nA = has_next ? (const char*)g.A + (size_t)nxt.pm * tstepA + (size_t)nxt.k0 * 2 : cA; const char* nB = has_next ? (const char*)g.Bt + (size_t)nxt.pn * tstepB + (size_t)nxt.k0 * 2 : cB;
        const int nt = cur.nt;
        for (int t = 0; t < nt; t += 2) {
            const bool last = (t == nt - 2);
            const char* a1 = cA + (size_t)(t + 1) * kstep;
            const char* a2 = last ? nA : cA + (size_t)(t + 2) * kstep; const char* b2 = last ? nB : cB + (size_t)(t + 2) * kstep;
            const char* a3 = a2 + kstep; const char* b3 = b2 + kstep;
            PG8_LDB(B0, 0, 0); PG8_SCHED; PG8_LDA(At, 0, 0); PG8_STAGE(PG8_SA(1, 1), a1 + hstepA, voffA);
            PG8_WAIT_L(8); PG8_BAR; PG8_WAIT_L(0); PG8_MMA(0, 0, At, B0); PG8_BAR; PG8_SCHED;
            PG8_LDB(B1, 0, 1); PG8_STAGE(PG8_SB(0, 0), b2, voffB);
            PG8_BAR; PG8_WAIT_L(0); PG8_MMA(0, 1, At, B1); PG8_BAR;
            PG8_LDA(At, 0, 1); PG8_STAGE(PG8_SA(0, 0), a2, voffA);
            PG8_BAR; PG8_WAIT_L(0); PG8_MMA(1, 0, At, B0); PG8_BAR; PG8_SCHED;
            PG8_STAGE(PG8_SB(0, 1), b2 + hstepB, voffB);
            PG8_WAIT_V(6); PG8_BAR; PG8_MMA(1, 1, At, B1); PG8_BAR;
            PG8_LDB(B0, 1, 0); PG8_SCHED; PG8_LDA(At, 1, 0); PG8_STAGE(PG8_SA(0, 1), a2 + hstepA, voffA);
            PG8_WAIT_L(8); PG8_BAR; PG8_WAIT_L(0); PG8_MMA(0, 0, At, B0); PG8_BAR; PG8_SCHED;
            PG8_LDB(B1, 1, 1); PG8_STAGE(PG8_SB(1, 0), b3, voffB);
            PG8_BAR; PG8_WAIT_L(0); PG8_MMA(0, 1, At, B1); PG8_BAR;
            PG8_LDA(At, 1, 1); PG8_STAGE(PG8_SA(1, 0), a3, voffA);
            PG8_BAR; PG8_WAIT_L(0); PG8_MMA(1, 0, At, B0); PG8_BAR; PG8_SCHED;
            PG8_STAGE(PG8_SB(1, 1), b3 + hstepB, voffB);
            PG8_WAIT_V(6); PG8_BAR; PG8_MMA(1, 1, At, B1); PG8_BAR;
        }
        E(acc, cur, wr, wc, fr, fq);
        if (!has_next) break;
        if (!(Epi::CHAIN && nxt.split != 0)) {
#pragma unroll
            for (int a = 0; a < 2; ++a)
#pragma unroll
                for (int b = 0; b < 2; ++b)
#pragma unroll
                    for (int m = 0; m < 4; ++m)
#pragma unroll
                        for (int n = 0; n < 2; ++n) acc[a][b][m][n] = (f32x4){0.f, 0.f, 0.f, 0.f};
        }
        cur = nxt; cA = nA; cB = nB; ++ui;
    }
    PG8_WAIT_V(0);
    if (wr == 0) PG8_BAR;
    PG8_BAR;
#undef PG8_SA
#undef PG8_SB
#undef PG8_STAGE
#undef PG8_LDA
#undef PG8_LDB
#undef PG8_MMA
#undef PG8_WAIT_V
#undef PG8_WAIT_L
#undef PG8_BAR
#undef PG8_SCHED
}
}
using pg8::Unit;
typedef f32x4 AccT[2][2][4][2];

struct EpiStore {
    static constexpr bool PERM = true, CHAIN = false;
    bf16_t* O; int ld; int sig0;
    DI void operator()(const AccT& acc, const Unit& u, int wr, int wc, int fr, int fq) const {
        const int row0 = u.pm * 256 + wr * 64 + fr, col0 = u.pn * 256 + wc * 32 + 8 * fq;
#pragma unroll
        for (int ai = 0; ai < 2; ++ai)
#pragma unroll
            for (int m = 0; m < 4; ++m) { bf16_t* rowp = O + (size_t)(row0 + ai * 128 + m * 16) * ld + col0;
#pragma unroll
                for (int bj = 0; bj < 2; ++bj) { f32x4 v0 = acc[ai][bj][m][0], v1 = acc[ai][bj][m][1];
                    if (u.pn * 256 + bj * 128 + wc * 32 >= sig0) {
#pragma unroll
                        for (int j = 0; j < 4; ++j) { v0[j] = sigmoidf_(v0[j]); v1[j] = sigmoidf_(v1[j]); } }
                    u32x4 w; w.x = pk2(v0[0], v0[1]); w.y = pk2(v0[2], v0[3]); w.z = pk2(v1[0], v1[1]); w.w = pk2(v1[2], v1[3]);
                    *(u32x4*)(rowp + bj * 128) = w; } }
    }
};
struct EpiSwiglu {
    static constexpr bool PERM = true, CHAIN = false;
    bf16_t* O;
    DI void operator()(const AccT& acc, const Unit& u, int wr, int wc, int fr, int fq) const {
        const int row0 = u.pm * 256 + wr * 64 + fr, col0 = (u.pn * 256 + wc * 32 + 8 * fq) >> 1;
#pragma unroll
        for (int ai = 0; ai < 2; ++ai)
#pragma unroll
            for (int m = 0; m < 4; ++m) { bf16_t* rowp = O + (size_t)(row0 + ai * 128 + m * 16) * DFF + col0;
#pragma unroll
                for (int bj = 0; bj < 2; ++bj) { const f32x4 v0 = acc[ai][bj][m][0], v1 = acc[ai][bj][m][1];
                    const float r0 = v0[0] * sigmoidf_(v0[0]) * v0[1], r1 = v0[2] * sigmoidf_(v0[2]) * v0[3];
                    const float r2 = v1[0] * sigmoidf_(v1[0]) * v1[1], r3 = v1[2] * sigmoidf_(v1[2]) * v1[3];
                    u32x2 w; w.x = pk2(r0, r1); w.y = pk2(r2, r3);
                    *(u32x2*)(rowp + bj * 64) = w; } }
    }
};
struct EpiResid {
    static constexpr bool PERM = false, CHAIN = false;
    float* xl; float* xc; const float* modl; int midx; float coef; float* part;
    DI void operator()(const AccT& acc, const Unit& u, int wr, int wc, int fr, int fq) const {
        const int bi = u.pm < 64 ? (u.pm >> 3) : 8;
        float* base = u.pm < 64 ? xl + (size_t)u.pm * 256 * D : xc + (size_t)(u.pm - 64) * 256 * D;
        if (u.split) base = part + (size_t)(u.split - 1) * MC * D + (size_t)(u.pm - 64) * 256 * D;
        const int row0 = wr * 64 + fr, col0 = u.pn * 256 + wc * 32 + 4 * fq;
        const float* mp = modl + (size_t)bi * 9216 + midx * 1024 + col0;
#pragma unroll
        for (int bj = 0; bj < 2; ++bj) {
            f32x4 mv[2];
#pragma unroll
            for (int n = 0; n < 2; ++n) mv[n] = *(const f32x4*)(mp + bj * 128 + n * 16) * coef;
            float* cb = base + (size_t)row0 * D + col0 + bj * 128;
            f32x4 xv[2][2][4];
            if (!u.split) {
#pragma unroll
                for (int n = 0; n < 2; ++n)
#pragma unroll
                    for (int ai = 0; ai < 2; ++ai)
#pragma unroll
                        for (int m = 0; m < 4; ++m) xv[n][ai][m] = *(const f32x4*)(cb + n * 16 + (size_t)(ai * 128 + m * 16) * D);
            } else {
#pragma unroll
                for (int n = 0; n < 2; ++n)
#pragma unroll
                    for (int ai = 0; ai < 2; ++ai)
#pragma unroll
                        for (int m = 0; m < 4; ++m) xv[n][ai][m] = (f32x4){0.f, 0.f, 0.f, 0.f};
            }
#pragma unroll
            for (int n = 0; n < 2; ++n)
#pragma unroll
                for (int ai = 0; ai < 2; ++ai)
#pragma unroll
                    for (int m = 0; m < 4; ++m) *(f32x4*)(cb + n * 16 + (size_t)(ai * 128 + m * 16) * D) = xv[n][ai][m] + mv[n] * acc[ai][bj][m][n];
        }
    }
};
struct EpiMerge {
    static constexpr bool PERM = false, CHAIN = true;
    bf16_t* mb; const bf16_t* proj;
    DI void operator()(AccT& acc, const Unit& u, int wr, int wc, int fr, int fq) const {
        const int seg = u.split;
        const int row0 = u.pm * 256 + wr * 64 + fr, col0 = u.pn * 256 + wc * 32 + 4 * fq;
#pragma unroll
        for (int ai = 0; ai < 2; ++ai) {
            u32x2 ga[4][4], gb[4][4];
#pragma unroll
            for (int m = 0; m < 4; ++m) { const bf16_t* gp = proj + (size_t)(row0 + ai * 128 + m * 16) * INWP + O_G + seg * 1024 + col0;
#pragma unroll
                for (int q = 0; q < 4; ++q) { const int co = (q >> 1) * 128 + (q & 1) * 16; ga[m][q] = *(const u32x2*)(gp + co); gb[m][q] = seg < 2 ? *(const u32x2*)(gp + 1024 + co) : (u32x2){0u, 0u}; } }
#pragma unroll
            for (int m = 0; m < 4; ++m) { const size_t row = (size_t)(row0 + ai * 128 + m * 16);
#pragma unroll
                for (int q = 0; q < 4; ++q) { const int bj = q >> 1, n = q & 1, co = bj * 128 + n * 16;
                    f32x4 r; r[0] = fmaxf(bflo(ga[m][q].x), 1e-20f); r[1] = fmaxf(bfhi(ga[m][q].x), 1e-20f); r[2] = fmaxf(bflo(ga[m][q].y), 1e-20f); r[3] = fmaxf(bfhi(ga[m][q].y), 1e-20f);
                    if (seg < 2) {
                        r[0] *= __builtin_amdgcn_rcpf(fmaxf(bflo(gb[m][q].x), 1e-20f)); r[1] *= __builtin_amdgcn_rcpf(fmaxf(bfhi(gb[m][q].x), 1e-20f));
                        r[2] *= __builtin_amdgcn_rcpf(fmaxf(bflo(gb[m][q].y), 1e-20f)); r[3] *= __builtin_amdgcn_rcpf(fmaxf(bfhi(gb[m][q].y), 1e-20f));
                        acc[ai][bj][m][n] = acc[ai][bj][m][n] * r; }
                    else { const f32x4 v = acc[ai][bj][m][n] * r; u32x2 w; w.x = pk2(v[0], v[1]); w.y = pk2(v[2], v[3]); *(u32x2*)(mb + row * D + col0 + co) = w; } } }
        }
    }
};

DI void mod_phase(const Params& p, LAS unsigned char* ldsb) {
    LAS float* sc = (LAS float*)ldsb;
    LAS float* red = sc + 9216;
    const int tid = tidx(), wid = tid >> 6, lane = tid & 63;
    for (int i = tid; i < 9216; i += 512) { const int bi = i >> 10, k = i & 1023; const float cv = bi < 8 ? p.in[1][bi * 1024 + k] : p.in[3][k]; sc[i] = cv / (1.0f + expf(-cv)); }
    __syncthreads();
    float* MOD = (float*)(p.ws + WS_MOD);
    for (int item = blockIdx.x; item < 144; item += gridDim.x) {
        const int l = item / 36, j0 = (item % 36) * 256;
        const float* w = p.in[4] + ((size_t)l * 1024 + wid * 128) * 9216 + j0 + lane * 4;
        f32x4 acc[9];
#pragma unroll
        for (int b = 0; b < 9; ++b) acc[b] = (f32x4){0.f, 0.f, 0.f, 0.f};
#pragma unroll 8
        for (int kk = 0; kk < 128; ++kk) { const f32x4 wv = *(const f32x4*)(w + (size_t)kk * 9216); const int k = wid * 128 + kk;
#pragma unroll
            for (int b = 0; b < 9; ++b) acc[b] = acc[b] + wv * sc[b * 1024 + k]; }
#pragma unroll
        for (int b = 0; b < 9; ++b) *(LAS f32x4*)(red + (wid * 9 + b) * 256 + lane * 4) = acc[b];
        __syncthreads();
        for (int o = tid; o < 9 * 256; o += 512) { const int b = o >> 8, cn = o & 255; float s = 0.f;
#pragma unroll
            for (int w8 = 0; w8 < 8; ++w8) s += red[(w8 * 9 + b) * 256 + cn];
            MOD[((size_t)l * 9 + b) * 9216 + j0 + cn] = s + p.in[5][(size_t)l * 9216 + j0 + cn]; }
        __syncthreads();
    }
}
DI void tab_phase(const Params& p) {
    float* TABM = (float*)(p.ws + WS_TAB);
    float* TABD = TABM + 2048 * 32;
    const int gt = blockIdx.x * 512 + tidx(), nth = gridDim.x * 512;
    for (int i = gt; i < 2048 * 48; i += nth) {
        const int s = i / 48, a = i % 48;
        const float row = (float)(s >> 6), col = (float)(s & 63);
        float pos, invf; int idx; float* dst; int half;
        if (a < 16) { const int axis = a >> 3, f = a & 7; pos = axis ? col : row; invf = exp2f(-(float)f * (13.287712379549449f / 8.0f)); dst = TABM + s * 32; idx = a; half = 16; }
        else { const int a2 = a - 16, axis = a2 >> 4, f = a2 & 15; pos = axis ? col : row; invf = exp2f(-(float)f * (13.287712379549449f / 16.0f)); dst = TABD + s * 64; idx = a2; half = 32; }
        const float ang = pos * invf;
        float rev = ang * 0.15915494309189535f; rev -= floorf(rev);
        dst[idx] = __builtin_amdgcn_cosf(rev); dst[half + idx] = __builtin_amdgcn_sinf(rev);
    }
}

DI void convT(const float* __restrict__ src, int K, int N, bf16_t* __restrict__ dst, int mode, const float* kscale, LAS float* tile, int rot, int vid, int vcnt, int ldd = 0, int koff = 0) {
    if (ldd == 0) ldd = K;
    const int tilesN = (N + 63) >> 6, tilesK = K >> 6, nt = tilesN * tilesK, tid = tidx();
    int start = vid - (rot % vcnt); if (start < 0) start += vcnt;
    const int kr = tid >> 4, c4 = (tid & 15) * 4;
    f32x4 r0, r1;
    auto fetch = [&](int tl) {
        const int tk = tl / tilesN, tn = tl - tk * tilesN, n = tn * 64 + c4, k0 = tk * 64 + kr;
        r0 = (f32x4){0.f, 0.f, 0.f, 0.f}; r1 = r0;
        if (n < N) { r0 = *(const f32x4*)(src + (size_t)k0 * N + n); r1 = *(const f32x4*)(src + (size_t)(k0 + 32) * N + n); }
        if (kscale) { r0 = r0 * kscale[k0]; r1 = r1 * kscale[k0 + 32]; }
    };
    if (start < nt) fetch(start);
    for (int tl = start; tl < nt; tl += vcnt) {
        const int tk = tl / tilesN, tn = tl - tk * tilesN;
        { LAS float* tp = tile + kr * 65 + c4; tp[0] = r0[0]; tp[1] = r0[1]; tp[2] = r0[2]; tp[3] = r0[3];
          tp += 32 * 65; tp[0] = r1[0]; tp[1] = r1[1]; tp[2] = r1[2]; tp[3] = r1[3]; }
        if (tl + vcnt < nt) fetch(tl + vcnt);
        __syncthreads();
        { const int nl = tid >> 3, k8 = (tid & 7) * 8, n = tn * 64 + nl;
          if (n < N) { float f[8];
#pragma unroll
              for (int j = 0; j < 8; ++j) f[j] = tile[(k8 + j) * 65 + nl];
              u32x4 w; w.x = pk2(f[0], f[1]); w.y = pk2(f[2], f[3]); w.z = pk2(f[4], f[5]); w.w = pk2(f[6], f[7]);
              int drow = n;
              if (mode == 1) drow = n < DFF ? 2 * n : 2 * (n - DFF) + 1;
              else if (mode == 2) { const int h = n / 96, o = n - h * 96, q = o - 64; if (o >= 64) drow = h * 96 + 64 + 2 * ((q >> 4) * 8 + (q & 7)) + ((q >> 3) & 1); }
              else if (mode == 3) { if (n >= O_KR && n < O_DQ) { const int q = n - O_KR; drow = O_KR + 2 * ((q >> 4) * 8 + (q & 7)) + ((q >> 3) & 1); }
                                    else if (n >= O_DQ && n < O_DV) { const int o = (n - O_DQ) & 63; drow = n - o + 2 * ((o >> 5) * 16 + (o & 15)) + ((o >> 4) & 1); } }
              *(u32x4*)(dst + (size_t)drow * ldd + koff + tk * 64 + k8) = w; } }
        __syncthreads();
    }
}
DI void conv_weights(const Params& p, int l, LAS unsigned char* ldsb, bf16_t* W, int vid, int vcnt) {
    LAS float* tile = (LAS float*)ldsb;
    convT(p.in[7] + (size_t)l * 1024 * 5632, 1024, 5632, W + W_1U, 1, nullptr, tile, 0, vid, vcnt);
    convT(p.in[8] + (size_t)l * 2816 * 1024, 2816, 1024, W + W_1D, 0, nullptr, tile, 128, vid, vcnt);
    convT(p.in[9] + (size_t)l * 1024 * 5632, 1024, 5632, W + W_2U, 1, nullptr, tile, 64, vid, vcnt);
    convT(p.in[10] + (size_t)l * 2816 * 1024, 2816, 1024, W + W_2D, 0, nullptr, tile, 192, vid, vcnt);
    convT(p.in[11] + (size_t)l * 1024 * INW, 1024, INW, W + W_IN, 3, nullptr, tile, 32, vid, vcnt);
    convT(p.in[13] + (size_t)l * 384 * 768, 384, 768, W + W_UQ, 2, p.in[12] + l * 384, tile, 160, vid, vcnt);
    convT(p.in[15] + (size_t)l * 256 * 1024, 256, 1024, W + W_UKV, 0, p.in[14] + l * 256, tile, 232, vid, vcnt);
    for (int n = 0; n < 3; ++n) convT(p.in[23] + ((size_t)l * 3 + n) * 512 * 1024, 512, 1024, W + W_BR, 0, nullptr, tile, 40 + n * 72, vid, vcnt, 1536, n * 512);
    convT(p.in[24] + (size_t)l * 1024 * 1024, 1024, 1024, W + W_O, 0, nullptr, tile, 96, vid, vcnt);
    { u32x4* z = (u32x4*)(W + W_IN + (size_t)INW * 1024); const int nz = (INWP - INW) * 1024 / 8;
      for (int i = vid * 512 + tidx(); i < nz; i += vcnt * 512) z[i] = (u32x4){0u, 0u, 0u, 0u}; }
}

DI void norm_phase(const float* sl, const float* sc_, float* dl, float* dc, bool copy, bf16_t* H, const float* g, const float* modl, int shift_i, int scale_i, int Mrows, const float* part, int npart) {
    const int tid_ = tidx(), lane = tid_ & 63, gw = blockIdx.x * 8 + (tid_ >> 6), nw = gridDim.x * 8;
    constexpr int R = 3;
    for (int row0 = gw; row0 < Mrows; row0 += R * nw) {
        f32x4 v[R][4]; float ss[R]; bool ok[R];
#pragma unroll
        for (int r = 0; r < R; ++r) { int row = row0 + r * nw; ok[r] = row < Mrows; row = ok[r] ? row : Mrows - 1;
            const float* src = row < ML ? sl + (size_t)row * D : sc_ + (size_t)(row - ML) * D;
#pragma unroll
            for (int i = 0; i < 4; ++i) v[r][i] = *(const f32x4*)(src + i * 256 + lane * 4); }
#pragma unroll
        for (int r = 0; r < R; ++r) { const int row = row0 + r * nw;
            if (ok[r] && npart > 0 && row >= ML) {
                f32x4 pv[4][4];
#pragma unroll
                for (int j = 0; j < 4; ++j) { const float* pp = part + (size_t)j * MC * D + (size_t)(row - ML) * D;
#pragma unroll
                    for (int i = 0; i < 4; ++i) pv[j][i] = *(const f32x4*)(pp + i * 256 + lane * 4); }
#pragma unroll
                for (int j = 0; j < 4; ++j)
#pragma unroll
                    for (int i = 0; i < 4; ++i) v[r][i] = v[r][i] + pv[j][i]; }
            float s = 0.f;
#pragma unroll
            for (int i = 0; i < 4; ++i) s += v[r][i][0] * v[r][i][0] + v[r][i][1] * v[r][i][1] + v[r][i][2] * v[r][i][2] + v[r][i][3] * v[r][i][3];
            ss[r] = s; }
#pragma unroll
        for (int o = 32; o > 0; o >>= 1) {
#pragma unroll
            for (int r = 0; r < R; ++r) ss[r] += __shfl_xor(ss[r], o); }
#pragma unroll
        for (int r = 0; r < R; ++r) { const int row = row0 + r * nw;
            if (!ok[r]) continue;
            const int bi = row < ML ? (row >> 11) : 8;
            const float rstd = rsqrtf(ss[r] * (1.0f / 1024.0f) + EPS);
            const float* mb = modl + (size_t)bi * 9216;
#pragma unroll
            for (int i = 0; i < 4; ++i) { const int col = i * 256 + lane * 4;
                const f32x4 gg = *(const f32x4*)(g + col), scv = *(const f32x4*)(mb + scale_i * 1024 + col), shv = *(const f32x4*)(mb + shift_i * 1024 + col);
                const f32x4 h = v[r][i] * rstd * gg * (scv + 1.0f) + shv;
                u32x2 w; w.x = pk2(h[0], h[1]); w.y = pk2(h[2], h[3]);
                *(u32x2*)(H + (size_t)row * D + col) = w; }
            if (copy || (npart > 0 && row >= ML)) { float* dst = row < ML ? dl + (size_t)row * D : dc + (size_t)(row - ML) * D;
#pragma unroll
                for (int i = 0; i < 4; ++i) *(f32x4*)(dst + i * 256 + lane * 4) = v[r][i]; }
        }
    }
}

template <int NV> DI void load_bf16_row(const bf16_t* src, float* v, float mul) {
#pragma unroll
    for (int i = 0; i < NV / 8; ++i) { const u32x4 w = *(const u32x4*)(src + i * 8);
        v[i * 8 + 0] = bflo(w.x) * mul; v[i * 8 + 1] = bfhi(w.x) * mul; v[i * 8 + 2] = bflo(w.y) * mul; v[i * 8 + 3] = bfhi(w.y) * mul;
        v[i * 8 + 4] = bflo(w.z) * mul; v[i * 8 + 5] = bfhi(w.z) * mul; v[i * 8 + 6] = bflo(w.w) * mul; v[i * 8 + 7] = bfhi(w.w) * mul; }
}
template <int NV> DI void store_bf16_row(bf16_t* dst, const float* v) {
#pragma unroll
    for (int i = 0; i < NV / 8; ++i) { u32x4 w; w.x = pk2(v[i * 8], v[i * 8 + 1]); w.y = pk2(v[i * 8 + 2], v[i * 8 + 3]); w.z = pk2(v[i * 8 + 4], v[i * 8 + 5]); w.w = pk2(v[i * 8 + 6], v[i * 8 + 7]);
        *(u32x4*)(dst + i * 8) = w; }
}
template <int NV> DI float sumsq_row(const bf16_t* src, float mul) {
    float ss = 0.f;
#pragma unroll
    for (int i = 0; i < NV / 8; ++i) { const u32x4 w = *(const u32x4*)(src + i * 8); const unsigned ww[4] = {w.x, w.y, w.z, w.w};
#pragma unroll
        for (int j = 0; j < 4; ++j) { const float a = bflo(ww[j]) * mul, b = bfhi(ww[j]) * mul; ss += a * a; ss += b * b; } }
    return ss;
}
template <int NV> DI void emit_plain(const bf16_t* src, float mul, const LAS float* g, bf16_t* dst) {
#pragma unroll 2
    for (int i = 0; i < NV / 8; ++i) { const u32x4 w = *(const u32x4*)(src + i * 8); const unsigned ww[4] = {w.x, w.y, w.z, w.w}; unsigned o[4];
#pragma unroll
        for (int j = 0; j < 4; ++j) o[j] = pk2(bflo(ww[j]) * mul * g[i * 8 + 2 * j], bfhi(ww[j]) * mul * g[i * 8 + 2 * j + 1]);
        u32x4 ov; ov.x = o[0]; ov.y = o[1]; ov.z = o[2]; ov.w = o[3]; *(u32x4*)(dst + i * 8) = ov; }
}
template <int QF> DI void emit_rope_axis(const bf16_t* src, float mul, const LAS float* g, const float* cp, const float* sp, bf16_t* dst) {
    float v[2 * QF];
#pragma unroll
    for (int i = 0; i < QF / 4; ++i) { const u32x4 w = *(const u32x4*)(src + i * 8); const unsigned ww[4] = {w.x, w.y, w.z, w.w};
#pragma unroll
        for (int j = 0; j < 4; ++j) { v[i * 8 + 2 * j] = bflo(ww[j]) * mul * g[i * 8 + 2 * j]; v[i * 8 + 2 * j + 1] = bfhi(ww[j]) * mul * g[i * 8 + 2 * j + 1]; } }
    if (cp) {
#pragma unroll
        for (int f = 0; f < QF; ++f) { const float c = cp[f], s = sp[f], x1 = v[f], x2 = v[QF + f]; v[f] = x1 * c - x2 * s; v[QF + f] = x2 * c + x1 * s; }
    }
#pragma unroll
    for (int i = 0; i < QF / 4; ++i) { u32x4 ov; ov.x = pk2(v[i * 8], v[i * 8 + 1]); ov.y = pk2(v[i * 8 + 2], v[i * 8 + 3]); ov.z = pk2(v[i * 8 + 4], v[i * 8 + 5]); ov.w = pk2(v[i * 8 + 6], v[i * 8 + 7]); *(u32x4*)(dst + i * 8) = ov; }
}
DI float sumsq8(u32x4 w) { const unsigned ww[4] = {w.x, w.y, w.z, w.w}; float ss = 0.f;
#pragma unroll
    for (int j = 0; j < 4; ++j) { const float a = bflo(ww[j]), b = bfhi(ww[j]); ss += a * a; ss += b * b; }
    return ss; }
DI void unpack8(u32x4 w, float* v, float mul) { const unsigned ww[4] = {w.x, w.y, w.z, w.w};
#pragma unroll
    for (int j = 0; j < 4; ++j) { v[2 * j] = bflo(ww[j]) * mul; v[2 * j + 1] = bfhi(ww[j]) * mul; } }
DI u32x4 pack8(const float* v) { u32x4 o; o.x = pk2(v[0], v[1]); o.y = pk2(v[2], v[3]); o.z = pk2(v[4], v[5]); o.w = pk2(v[6], v[7]); return o; }
DI float red8(float v) { v += __shfl_xor(v, 1); v += __shfl_xor(v, 2); v += __shfl_xor(v, 4); return v; }

DI void prep_body(const Params& p, int l, LAS unsigned char* ldsb,
                  const bf16_t* __restrict__ PROJ, const bf16_t* __restrict__ QRAW, const bf16_t* __restrict__ KVRAW,
                  bf16_t* __restrict__ QM, bf16_t* __restrict__ KM, bf16_t* __restrict__ VTM, bf16_t* __restrict__ QD, bf16_t* __restrict__ KD, bf16_t* __restrict__ VTD, bf16_t* __restrict__ Y2,
                  const float* __restrict__ TABM, const float* __restrict__ TABD, const float* __restrict__ cw) {
    const int tid = tidx(), wid = tid >> 6, lane = tid & 63, hd = lane >> 3, s = lane & 7;
    const float qsm = 0.10206207261596577f * LOG2E, qsd = 0.125f * LOG2E;
    LAS float* gl = (LAS float*)ldsb;
    if (tid < 96) { const int q = tid - 64, pp = q >> 1, hh = q & 1; const int orig = tid < 64 ? tid : 64 + 16 * (pp >> 3) + 8 * hh + (pp & 7);
        gl[tid] = p.in[16][l * 96 + orig]; gl[96 + tid] = p.in[17][l * 96 + orig]; }
    if (tid < 64) { const int pp = tid >> 1, hh = tid & 1, orig = 32 * (pp >> 4) + 16 * hh + (pp & 15);
        gl[192 + tid] = p.in[18][l * 64 + orig]; gl[256 + tid] = p.in[19][l * 64 + orig]; }
    __syncthreads();
    float gqn[8], gqr[4], gkn[8], gkr[4], gdq[8], gdk[8];
#pragma unroll
    for (int j = 0; j < 8; ++j) { gqn[j] = gl[8 * s + j]; gkn[j] = gl[96 + 8 * s + j]; gdq[j] = gl[192 + 8 * s + j]; gdk[j] = gl[256 + 8 * s + j]; }
#pragma unroll
    for (int j = 0; j < 4; ++j) { gqr[j] = gl[64 + 4 * s + j]; gkr[j] = gl[96 + 64 + 4 * s + j]; }
    __syncthreads();
    LAS unsigned char* Vl = ldsb;
#pragma unroll 1
    for (int item = blockIdx.x; item < 5 * (MT / 64); item += gridDim.x) {
        const int type = item / (MT / 64), blk = item - type * (MT / 64);
        const int r0 = blk * 64; int b, t0, spos0, seglen; bool latent;
        if (r0 < ML) { b = r0 >> 11; spos0 = r0 & 2047; t0 = 256 + spos0; latent = true; seglen = 2048; }
        else { const int rc = r0 - ML; b = rc >> 8; spos0 = rc & 255; t0 = spos0; latent = false; seglen = 256; }
        if (type == 0) {
#pragma unroll 1
            for (int kb4 = 0; kb4 < 8; kb4 += 4) {
                float s1[4], s2[4]; u32x4 wqn[4], wkn[4]; u32x2 wqr[4], wkr[4]; f32x2 cm[4], sm[4];
#pragma unroll
            for (int k = 0; k < 4; ++k) {
                const int tl = wid * 8 + kb4 + k, r = r0 + tl, t = t0 + tl, spos = spos0 + tl;
                const bf16_t* prow = PROJ + (size_t)r * INWP;
                s1[k] = sumsq8(*(const u32x4*)(prow + O_CQ + (lane < 48 ? lane : 0) * 8)); s1[k] = lane < 48 ? s1[k] : 0.f;
                s2[k] = sumsq8(*(const u32x4*)(prow + O_CKV + (lane < 32 ? lane : 0) * 8)); s2[k] = lane < 32 ? s2[k] : 0.f;
                wqn[k] = *(const u32x4*)(QRAW + (size_t)r * 768 + hd * 96 + 8 * s);
                wqr[k] = *(const u32x2*)(QRAW + (size_t)r * 768 + hd * 96 + 64 + 4 * s);
                wkn[k] = *(const u32x4*)(KVRAW + (size_t)r * 1024 + hd * 128 + 8 * s);
                wkr[k] = *(const u32x2*)(prow + O_KR + 4 * s);
                cm[k] = *(const f32x2*)(TABM + (latent ? spos : 0) * 32 + 2 * s); sm[k] = *(const f32x2*)(TABM + (latent ? spos : 0) * 32 + 16 + 2 * s);
                cm[k][0] = latent ? cm[k][0] : 1.f; cm[k][1] = latent ? cm[k][1] : 1.f; sm[k][0] = latent ? sm[k][0] : 0.f; sm[k][1] = latent ? sm[k][1] : 0.f;
            }
#pragma unroll
            for (int k = 0; k < 4; ++k) {
                const int tl = wid * 8 + kb4 + k, r = r0 + tl, t = t0 + tl; (void)r;
                s1[k] = wave_sum(s1[k]); s2[k] = wave_sum(s2[k]);
                const float rcq = rsqrtf(s1[k] * (1.0f / 384.0f) + EPS), rckv = rsqrtf(s2[k] * (1.0f / 256.0f) + EPS);
                { float vn[8], vr[4]; unpack8(wqn[k], vn, rcq); vr[0] = bflo(wqr[k].x) * rcq; vr[1] = bfhi(wqr[k].x) * rcq; vr[2] = bflo(wqr[k].y) * rcq; vr[3] = bfhi(wqr[k].y) * rcq;
                  float ss = vr[0] * vr[0] + vr[1] * vr[1] + vr[2] * vr[2] + vr[3] * vr[3];
#pragma unroll
                  for (int j = 0; j < 8; ++j) ss += vn[j] * vn[j];
                  ss = red8(ss); const float mul = rsqrtf(ss * (1.0f / 96.0f) + EPS) * qsm;
#pragma unroll
                  for (int j = 0; j < 8; ++j) vn[j] *= mul * gqn[j];
#pragma unroll
                  for (int j = 0; j < 4; ++j) vr[j] *= mul * gqr[j];
                  const float a0 = vr[0] * cm[k][0] - vr[1] * sm[k][0], a1 = vr[1] * cm[k][0] + vr[0] * sm[k][0], a2 = vr[2] * cm[k][1] - vr[3] * sm[k][1], a3 = vr[3] * cm[k][1] + vr[2] * sm[k][1];
                  bf16_t* d = QM + ((size_t)(b * 8 + hd) * TT + t) * 96;
                  *(u32x4*)(d + 8 * s) = pack8(vn); u32x2 o; o.x = pk2(a0, a1); o.y = pk2(a2, a3); *(u32x2*)(d + 64 + 4 * s) = o; }
                { float vn[8], vr[4]; unpack8(wkn[k], vn, rckv); vr[0] = bflo(wkr[k].x); vr[1] = bfhi(wkr[k].x); vr[2] = bflo(wkr[k].y); vr[3] = bfhi(wkr[k].y);
                  float ss = vr[0] * vr[0] + vr[1] * vr[1] + vr[2] * vr[2] + vr[3] * vr[3];
#pragma unroll
                  for (int j = 0; j < 8; ++j) ss += vn[j] * vn[j];
                  ss = red8(ss); const float mul = rsqrtf(ss * (1.0f / 96.0f) + EPS);
#pragma unroll
                  for (int j = 0; j < 8; ++j) vn[j] *= mul * gkn[j];
#pragma unroll
                  for (int j = 0; j < 4; ++j) vr[j] *= mul * gkr[j];
                  const float a0 = vr[0] * cm[k][0] - vr[1] * sm[k][0], a1 = vr[1] * cm[k][0] + vr[0] * sm[k][0], a2 = vr[2] * cm[k][1] - vr[3] * sm[k][1], a3 = vr[3] * cm[k][1] + vr[2] * sm[k][1];
                  bf16_t* d = KM + ((size_t)(b * 8 + hd) * TT + t) * 96;
                  *(u32x4*)(d + 8 * s) = pack8(vn); u32x2 o; o.x = pk2(a0, a1); o.y = pk2(a2, a3); *(u32x2*)(d + 64 + 4 * s) = o; }
            }
            }
        } else if (type == 1) {
#pragma unroll 1
            for (int kb4 = 0; kb4 < 8; kb4 += 4) {
                u32x4 wdq[4], wdk[4]; f32x4 cd[4], sd[4];
#pragma unroll
                for (int k = 0; k < 4; ++k) { const int tl = wid * 8 + kb4 + k, r = r0 + tl, spos = spos0 + tl;
                    const bf16_t* prow = PROJ + (size_t)r * INWP;
                    wdq[k] = *(const u32x4*)(prow + O_DQ + lane * 8); wdk[k] = *(const u32x4*)(prow + O_DK + lane * 8);
                    cd[k] = *(const f32x4*)(TABD + (latent ? spos : 0) * 64 + 4 * s); sd[k] = *(const f32x4*)(TABD + (latent ? spos : 0) * 64 + 32 + 4 * s); }
#pragma unroll
                for (int k = 0; k < 4; ++k) { const int tl = wid * 8 + kb4 + k, t = t0 + tl;
#pragma unroll
                    for (int j = 0; j < 4; ++j) { cd[k][j] = latent ? cd[k][j] : 1.f; sd[k][j] = latent ? sd[k][j] : 0.f; }
#pragma unroll
                    for (int qk = 0; qk < 2; ++qk) { float v[8]; unpack8(qk ? wdk[k] : wdq[k], v, 1.0f); float ss = 0.f;
#pragma unroll
                      for (int j = 0; j < 8; ++j) ss += v[j] * v[j];
                      ss = red8(ss); const float mul = rsqrtf(ss * (1.0f / 64.0f) + EPS) * (qk ? 1.0f : qsd);
#pragma unroll
                      for (int j = 0; j < 8; ++j) v[j] *= mul * (qk ? gdk[j] : gdq[j]);
                      float o[8];
#pragma unroll
                      for (int jj = 0; jj < 4; ++jj) { o[2 * jj] = v[2 * jj] * cd[k][jj] - v[2 * jj + 1] * sd[k][jj]; o[2 * jj + 1] = v[2 * jj + 1] * cd[k][jj] + v[2 * jj] * sd[k][jj]; }
                      bf16_t* d = (qk ? KD : QD) + ((size_t)(b * 8 + hd) * TT + t) * 64 + 8 * s;
                      *(u32x4*)d = pack8(o); }
                }
            }
        } else if (type < 4) {
#pragma unroll 4
            for (int k = 0; k < 8; ++k) {
                const int tl = wid * 8 + k, r = r0 + tl;
                const bf16_t* prow = PROJ + (size_t)r * INWP;
                const bool mla = (type == 2);
                float s2 = sumsq8(*(const u32x4*)(prow + O_CKV + (lane < 32 ? lane : 0) * 8)); s2 = lane < 32 ? s2 : 0.f;
                const bf16_t* wsrc = mla ? KVRAW + (size_t)r * 1024 + hd * 128 + 64 + 8 * s : prow + O_DV + lane * 8;
                const u32x4 w = *(const u32x4*)wsrc;
                s2 = wave_sum(s2); const float sc = mla ? rsqrtf(s2 * (1.0f / 256.0f) + EPS) : 1.0f;
                float v[8]; unpack8(w, v, sc);
                const u32x4 o = pack8(v); const unsigned ow[4] = {o.x, o.y, o.z, o.w};
                LAS bf16_t* dl = (LAS bf16_t*)(Vl + (size_t)(hd * 64 + 8 * s) * 144) + tl;
#pragma unroll
                for (int j = 0; j < 4; ++j) { dl[(2 * j) * 72] = (bf16_t)(ow[j] & 0xffffu); dl[(2 * j + 1) * 72] = (bf16_t)(ow[j] >> 16); }
            }
            __syncthreads();
            { bf16_t* VT = type == 2 ? VTM : VTD;
#pragma unroll
              for (int kk = 0; kk < 8; ++kk) { const int row = (tid >> 3) + 64 * kk, ch = tid & 7;
                  const u32x4 w = *(LAS const u32x4*)(Vl + row * 144 + ch * 16);
                  *(u32x4*)(VT + ((size_t)(b * 512 + row) * TT + t0 + ch * 8)) = w; } }
            __syncthreads();
        } else {
            float w0[8], w1[8], w2[8];
            { const f32x4 a = *(const f32x4*)(cw + lane * 8), a2 = *(const f32x4*)(cw + lane * 8 + 4), b1 = *(const f32x4*)(cw + 512 + lane * 8), b2 = *(const f32x4*)(cw + 512 + lane * 8 + 4),
                          c1 = *(const f32x4*)(cw + 1024 + lane * 8), c2 = *(const f32x4*)(cw + 1024 + lane * 8 + 4);
#pragma unroll
              for (int j = 0; j < 4; ++j) { w0[j] = a[j]; w0[4 + j] = a2[j]; w1[j] = b1[j]; w1[4 + j] = b2[j]; w2[j] = c1[j]; w2[4 + j] = c2[j]; } }
            const int rf = r0 + wid * 8, sf = spos0 + wid * 8;
            const bf16_t* pb = PROJ + (size_t)rf * INWP + lane * 8;
            float up[8], uc[8];
#pragma unroll
            for (int j = 0; j < 8; ++j) up[j] = 0.f;
            { const bool hasp = sf > 0; const bf16_t* pp = hasp ? pb - (size_t)INWP : pb;
              float a[8], c[8]; unpack8(*(const u32x4*)(pp + O_CC), a, 1.0f); unpack8(*(const u32x4*)(pp + O_CX), c, 1.0f);
#pragma unroll
              for (int j = 0; j < 8; ++j) up[j] = hasp ? a[j] * c[j] : 0.f; }
            { float a[8], c[8]; unpack8(*(const u32x4*)(pb + O_CC), a, 1.0f); unpack8(*(const u32x4*)(pb + O_CX), c, 1.0f);
#pragma unroll
              for (int j = 0; j < 8; ++j) uc[j] = a[j] * c[j]; }
#pragma unroll
            for (int k = 0; k < 8; ++k) { const bf16_t* q = pb + (size_t)k * INWP;
                float un[8];
                { const bool hasn = sf + k + 1 < seglen; const bf16_t* qn = hasn ? q + INWP : q;
                  float a[8], c[8]; unpack8(*(const u32x4*)(qn + O_CC), a, 1.0f); unpack8(*(const u32x4*)(qn + O_CX), c, 1.0f);
#pragma unroll
                  for (int j = 0; j < 8; ++j) un[j] = hasn ? a[j] * c[j] : 0.f; }
                float cb[8]; unpack8(*(const u32x4*)(q + O_CB), cb, 1.0f);
                float y[8];
#pragma unroll
                for (int j = 0; j < 8; ++j) y[j] = cb[j] * (w0[j] * up[j] + w1[j] * uc[j] + w2[j] * un[j]);
                *(u32x4*)(Y2 + (size_t)(rf + k) * 1536 + lane * 8) = pack8(y);
#pragma unroll
                for (int j = 0; j < 8; ++j) { up[j] = uc[j]; uc[j] = un[j]; } }
        }
    }
}

DI void prep_phase(const Params& p, int l, LAS unsigned char* ldsb) {
    const float* TABM = (const float*)(p.ws + WS_TAB);
    prep_body(p, l, ldsb, (const bf16_t*)(p.ws + WS_PROJ), (const bf16_t*)(p.ws + WS_R1), (const bf16_t*)(p.ws + WS_R1 + R1_KVRAW),
              (bf16_t*)(p.ws + WS_QKV + Q_QM), (bf16_t*)(p.ws + WS_QKV + Q_KM), (bf16_t*)(p.ws + WS_QKV + Q_VTM), (bf16_t*)(p.ws + WS_QKV + Q_QD), (bf16_t*)(p.ws + WS_QKV + Q_KD), (bf16_t*)(p.ws + WS_QKV + Q_VTD),
              (bf16_t*)(p.ws + WS_Y) + 1024, TABM, TABM + 2048 * 32, p.in[22] + (size_t)l * 3 * 512);
}

template <int KC, int DS, bool DIFF>
DI void attn_item(LAS unsigned char* lds, const bf16_t* Qw  , const bf16_t* K0, const bf16_t* K1, const bf16_t* Vt, int nkeys, float cshift,
                  f32x4 (&oacc)[DS][2], float (&lsum)[2]) {
    constexpr int DK = KC * 32, KROW = DK * 2 + 32, VROW = 160, DV = DS * 16;
    constexpr int KBYTES = (DIFF ? 2 : 1) * 64 * KROW, STG = KBYTES + DV * VROW;
    const int tid = tidx(), wid = tid >> 6, lane = tid & 63, fr = lane & 15, fq = lane >> 4;
    const int comp = DIFF ? (wid >> 2) : 0;
    const int vpos = (((tid & 7) >> 2) * 32 + (tid & 1) * 16 + ((tid >> 1) & 1) * 4) * 2;
    bf16x8 qf[2][KC];
#pragma unroll
    for (int qs = 0; qs < 2; ++qs)
#pragma unroll
        for (int kc = 0; kc < KC; ++kc) qf[qs][kc] = *(const bf16x8*)(Qw + (size_t)(qs * 16 + fr) * DK + kc * 32 + fq * 8);
#pragma unroll
    for (int ds = 0; ds < DS; ++ds) { oacc[ds][0] = (f32x4){0.f, 0.f, 0.f, 0.f}; oacc[ds][1] = (f32x4){0.f, 0.f, 0.f, 0.f}; }
    lsum[0] = 0.f; lsum[1] = 0.f;
    u32x4 rk0, rk1, rv0, rv1;
    auto gload = [&](int t) {
        if constexpr (!DIFF) {
            const char* kb = (const char*)K0 + (size_t)t * 64 * DK * 2;
            rk0 = *(const u32x4*)(kb + tid * 16);
            if (tid < 256) rk1 = *(const u32x4*)(kb + (512 + tid) * 16);
            rv0 = *(const u32x4*)((const char*)Vt + (size_t)(tid >> 3) * TT * 2 + (size_t)t * 128 + (tid & 7) * 16);
        } else {
            rk0 = *(const u32x4*)((const char*)K0 + (size_t)t * 64 * DK * 2 + tid * 16);
            rk1 = *(const u32x4*)((const char*)K1 + (size_t)t * 64 * DK * 2 + tid * 16);
            rv0 = *(const u32x4*)((const char*)Vt + (size_t)(tid >> 3) * TT * 2 + (size_t)t * 128 + (tid & 7) * 16);
            rv1 = *(const u32x4*)((const char*)Vt + (size_t)(64 + (tid >> 3)) * TT * 2 + (size_t)t * 128 + (tid & 7) * 16);
        }
    };
    auto lstore = [&](int st) {
        LAS unsigned char* kb = lds + st * STG; LAS unsigned char* vb = kb + KBYTES;
        if constexpr (!DIFF) {
            { const int key = tid / 12, pc = tid - key * 12; *(LAS u32x4*)(kb + key * KROW + pc * 16) = rk0; }
            if (tid < 256) { const int c = 512 + tid, key = c / 12, pc = c - key * 12; *(LAS u32x4*)(kb + key * KROW + pc * 16) = rk1; }
            { LAS unsigned char* d = vb + (tid >> 3) * VROW + vpos; *(LAS u32x2*)d = (u32x2){rv0.x, rv0.y}; *(LAS u32x2*)(d + 16) = (u32x2){rv0.z, rv0.w}; }
        } else {
            *(LAS u32x4*)(kb + (tid >> 3) * KROW + (tid & 7) * 16) = rk0;
            *(LAS u32x4*)(kb + 64 * KROW + (tid >> 3) * KROW + (tid & 7) * 16) = rk1;
            { LAS unsigned char* d = vb + (tid >> 3) * VROW + vpos; *(LAS u32x2*)d = (u32x2){rv0.x, rv0.y}; *(LAS u32x2*)(d + 16) = (u32x2){rv0.z, rv0.w}; }
            { LAS unsigned char* d = vb + (64 + (tid >> 3)) * VROW + vpos; *(LAS u32x2*)d = (u32x2){rv1.x, rv1.y}; *(LAS u32x2*)(d + 16) = (u32x2){rv1.z, rv1.w}; }
        }
    };
    auto readK = [&](int st, int kk, bf16x8 (&kf)[2][KC]) {
        LAS const unsigned char* kb = lds + st * STG + comp * 64 * KROW;
#pragma unroll
        for (int kc = 0; kc < KC; ++kc)
#pragma unroll
            for (int ks = 0; ks < 2; ++ks) kf[ks][kc] = *(LAS const bf16x8*)(kb + ((2 * kk + ks) * 16 + fr) * KROW + (kc * 32 + fq * 8) * 2);
    };
    auto readV = [&](int st, int kk, int d0, bf16x8 (&vf)[4]) {
        LAS const unsigned char* vb = lds + st * STG + KBYTES;
#pragma unroll
        for (int i = 0; i < 4; ++i) vf[i] = *(LAS const bf16x8*)(vb + ((d0 + i) * 16 + fr) * VROW + (kk * 32 + fq * 8) * 2);
    };
    auto smma = [&](const bf16x8 (&kf)[2][KC], f32x4 (&sacc)[2][2]) {
#pragma unroll
        for (int ks = 0; ks < 2; ++ks) { sacc[ks][0] = (f32x4){-cshift, -cshift, -cshift, -cshift}; sacc[ks][1] = (f32x4){-cshift, -cshift, -cshift, -cshift}; }
#pragma unroll
        for (int kc = 0; kc < KC; ++kc)
#pragma unroll
            for (int ks = 0; ks < 2; ++ks)
#pragma unroll
                for (int qs = 0; qs < 2; ++qs) sacc[ks][qs] = __builtin_amdgcn_mfma_f32_16x16x32_bf16(kf[ks][kc], qf[qs][kc], sacc[ks][qs], 0, 0, 0);
    };
    auto softmax = [&](const f32x4 (&sacc)[2][2], bf16x8 (&pb)[2]) {
#pragma unroll
        for (int qs = 0; qs < 2; ++qs) {
            float e[8];
#pragma unroll
            for (int j = 0; j < 4; ++j) { e[j] = __builtin_amdgcn_exp2f(sacc[0][qs][j]); e[4 + j] = __builtin_amdgcn_exp2f(sacc[1][qs][j]); }
            lsum[qs] += ((e[0] + e[1]) + (e[2] + e[3])) + ((e[4] + e[5]) + (e[6] + e[7]));
            u32x4 w; w.x = pk2(e[0], e[1]); w.y = pk2(e[2], e[3]); w.z = pk2(e[4], e[5]); w.w = pk2(e[6], e[7]);
            pb[qs] = __builtin_bit_cast(bf16x8, w);
        }
    };
    auto pv4 = [&](const bf16x8 (&vf)[4], int d0, const bf16x8 (&pb)[2]) {
#pragma unroll
        for (int i = 0; i < 4; ++i)
#pragma unroll
            for (int qs = 0; qs < 2; ++qs) oacc[d0 + i][qs] = __builtin_amdgcn_mfma_f32_16x16x32_bf16(vf[i], pb[qs], oacc[d0 + i][qs], 0, 0, 0);
    };
#define SB() __builtin_amdgcn_sched_barrier(0)
    const int ntiles = nkeys >> 6;
    if constexpr (!DIFF) {
        gload(0); lstore(0); gload(1); lstore(1);
        __syncthreads();
        f32x4 sA[2][2], sB[2][2]; bf16x8 pb[2]; bf16x8 kf[2][KC]; bf16x8 vf[4];
        readK(0, 0, kf); smma(kf, sA);
        int st = 0;
        auto iter = [&](auto m1c, auto m2c, int t) {
            constexpr bool m1 = decltype(m1c)::value, m2 = decltype(m2c)::value;
            const int st1 = (st == 2) ? 0 : st + 1, st2 = (st1 == 2) ? 0 : st1 + 1;
            if constexpr (m2) gload(t + 2);
            readK(st, 1, kf); readV(st, 0, 0, vf); SB();
            smma(kf, sB); softmax(sA, pb);
            pv4(vf, 0, pb); SB();
            if constexpr (m1) readK(st1, 0, kf);
            readV(st, 1, 0, vf); SB();
            if constexpr (m1) smma(kf, sA);
            softmax(sB, pb);
            pv4(vf, 0, pb); SB();
            if constexpr (m2) lstore(st2);
            __syncthreads();
            st = st1;
        };
#pragma unroll 1
        for (int t = 0; t + 2 < ntiles; ++t) iter(std::true_type{}, std::true_type{}, t);
        iter(std::true_type{}, std::false_type{}, ntiles - 2);
        iter(std::false_type{}, std::false_type{}, ntiles - 1);
    } else {
        gload(0); lstore(0);
        __syncthreads();
        f32x4 sA[2][2]; bf16x8 pb[2]; bf16x8 kf[2][KC]; bf16x8 vf[4], vg[4];
        auto iter = [&](auto morec, int t) {
            constexpr bool more = decltype(morec)::value;
            const int st = t & 1;
            if constexpr (more) gload(t + 1);
#pragma unroll
            for (int kk = 0; kk < 2; ++kk) {
                readK(st, kk, kf); readV(st, kk, 0, vf); SB();
                smma(kf, sA); softmax(sA, pb); readV(st, kk, 4, vg);
                pv4(vf, 0, pb);
                pv4(vg, 4, pb); SB();
            }
            if constexpr (more) lstore((t + 1) & 1);
            __syncthreads();
        };
#pragma unroll 1
        for (int t = 0; t + 1 < ntiles; ++t) iter(std::true_type{}, t);
        iter(std::false_type{}, ntiles - 1);
    }
#undef SB
#pragma unroll
    for (int qs = 0; qs < 2; ++qs) { lsum[qs] += __shfl_xor(lsum[qs], 16); lsum[qs] += __shfl_xor(lsum[qs], 32); }
}

DI void attn_phase(const Params& p, int l, bool need_ctx, LAS unsigned char* lds) {
    const int tid = tidx(), wid = tid >> 6, lane = tid & 63, fr = lane & 15, fq = lane >> 4;
    const bf16_t* QM = (const bf16_t*)(p.ws + WS_QKV + Q_QM); const bf16_t* KM = (const bf16_t*)(p.ws + WS_QKV + Q_KM); const bf16_t* VTM = (const bf16_t*)(p.ws + WS_QKV + Q_VTM);
    const bf16_t* QD = (const bf16_t*)(p.ws + WS_QKV + Q_QD); const bf16_t* KD = (const bf16_t*)(p.ws + WS_QKV + Q_KD); const bf16_t* VTD = (const bf16_t*)(p.ws + WS_QKV + Q_VTD);
    bf16_t* Y0 = (bf16_t*)(p.ws + WS_Y); bf16_t* Y1 = Y0 + 512;
    float gq = 0.f, gk = 0.f;
    { const float a = lane < 48 ? fmaxf(fabsf(p.in[16][l * 96 + lane]), fabsf(p.in[16][l * 96 + 48 + lane])) : 0.f; gq = wave_max(a);
      const float b = lane < 48 ? fmaxf(fabsf(p.in[17][l * 96 + lane]), fabsf(p.in[17][l * 96 + 48 + lane])) : 0.f; gk = wave_max(b); }
    const float cs_m = gq * gk * 9.797958971132712f * LOG2E;
    { gq = wave_max(fabsf(p.in[18][l * 64 + lane])); gk = wave_max(fabsf(p.in[19][l * 64 + lane])); }
    const float cs_d = gq * gk * 8.0f * LOG2E;
    const float li = lam_init_of(l);
    float lam;
    { const float* lv = p.in[20] + (size_t)l * 256; const float s1 = wave_sum(lv[lane] * lv[64 + lane]), s2 = wave_sum(lv[128 + lane] * lv[192 + lane]); lam = expf(s1) - expf(s2) + li; }
    const float* gsub = p.in[21] + l * 128;
    const int first = need_ctx ? 0 : 128;
    for (int item = first + blockIdx.x; item < 1152; item += gridDim.x) {
        if (item < 64 || (item >= 128 && item < 640)) {
            int bh, tq0, nkeys;
            if (item < 64) { bh = item; tq0 = 0; nkeys = 256; } else { const int i = item - 128; bh = (i >> 8) * 32 + (i & 31); tq0 = 256 + ((i >> 5) & 7) * 256; nkeys = TT; }
            const int b = bh >> 3, h = bh & 7;
            f32x4 oacc[4][2]; float lsum[2];
            attn_item<3, 4, false>(lds, QM + ((size_t)bh * TT + tq0 + wid * 32) * 96, KM + (size_t)bh * TT * 96, nullptr, VTM + (size_t)bh * 64 * TT, nkeys, cs_m, oacc, lsum);
#pragma unroll
            for (int qs = 0; qs < 2; ++qs) { const float inv = 1.0f / lsum[qs]; const int tq = tq0 + wid * 32 + qs * 16 + fr;
                const size_t row = tq >= 256 ? (size_t)b * 2048 + (tq - 256) : (size_t)ML + b * 256 + tq;
#pragma unroll
                for (int ds = 0; ds < 4; ++ds) { const f32x4 o = oacc[ds][qs] * inv; u32x2 w; w.x = pk2(o[0], o[1]); w.y = pk2(o[2], o[3]);
                    *(u32x2*)(Y0 + row * 1536 + h * 64 + ds * 16 + fq * 4) = w; } }
        } else {
            int bh, tq0, nkeys;
            if (item < 128) { const int i = item - 64; bh = i & 31; tq0 = (i >> 5) * 128; nkeys = 256; } else { const int i = item - 640; bh = (i >> 8) * 16 + (i & 15); tq0 = 256 + ((i >> 4) & 15) * 128; nkeys = TT; }
            const int b = bh >> 2, h = bh & 3, comp = wid >> 2, wq = wid & 3;
            f32x4 oacc[8][2]; float lsum[2];
            const size_t kvec = (size_t)(bh * 2) * TT * 64;
            attn_item<2, 8, true>(lds, QD + ((size_t)(bh * 2 + comp) * TT + tq0 + wq * 32) * 64, KD + kvec, KD + kvec + (size_t)TT * 64, VTD + (size_t)bh * 128 * TT, nkeys, cs_d, oacc, lsum);
            LAS float* X = (LAS float*)lds;
            if (comp == 1) {
#pragma unroll
                for (int qs = 0; qs < 2; ++qs) { const float sc = lam / lsum[qs]; const int ql = wq * 32 + qs * 16 + fr;
#pragma unroll
                    for (int ds = 0; ds < 8; ++ds) *(LAS f32x4*)(X + ql * 132 + ds * 16 + fq * 4) = oacc[ds][qs] * sc; }
            }
            __syncthreads();
            if (comp == 0) {
#pragma unroll
                for (int qs = 0; qs < 2; ++qs) { const float inv = 1.0f / lsum[qs]; const int ql = wq * 32 + qs * 16 + fr; const int tq = tq0 + ql;
                    float ss = 0.f;
#pragma unroll
                    for (int ds = 0; ds < 8; ++ds) { const f32x4 o2 = *(LAS const f32x4*)(X + ql * 132 + ds * 16 + fq * 4); const f32x4 o = oacc[ds][qs] * inv - o2; oacc[ds][qs] = o;
                        ss += o[0] * o[0] + o[1] * o[1] + o[2] * o[2] + o[3] * o[3]; }
                    ss += __shfl_xor(ss, 16); ss += __shfl_xor(ss, 32);
                    const float rs = rsqrtf(ss * (1.0f / 128.0f) + EPS) * (1.0f - li);
                    const size_t row = tq >= 256 ? (size_t)b * 2048 + (tq - 256) : (size_t)ML + b * 256 + tq;
#pragma unroll
                    for (int ds = 0; ds < 8; ++ds) { const f32x4 gg = *(const f32x4*)(gsub + ds * 16 + fq * 4); const f32x4 o = oacc[ds][qs] * rs * gg;
                        u32x2 w; w.x = pk2(o[0], o[1]); w.y = pk2(o[2], o[3]);
                        *(u32x2*)(Y1 + row * 1536 + h * 128 + ds * 16 + fq * 4) = w; } }
            }
            __syncthreads();
        }
    }
}

#define XB_TMO      128
#define XB_XCNT(j)  (256  + 64 * (j))
#define XB_XSUB(j)  (1280 + 64 * (j))
#define XB_XGEN(j)  (2304 + 64 * (j))
#define XB_TOP      3328
#define XB_TOPGEN   3392
#define XCD_BAR_WORDS 3456
#define XB_SPIN_CAP (1u << 18)
DI unsigned xb_ld(unsigned* p) { return __hip_atomic_load(p, __ATOMIC_RELAXED, __HIP_MEMORY_SCOPE_AGENT); }
DI unsigned xb_add(unsigned* p, unsigned v) { return __hip_atomic_fetch_add(p, v, __ATOMIC_RELAXED, __HIP_MEMORY_SCOPE_AGENT); }
DI unsigned xb_xcc_id() { return (unsigned)__builtin_amdgcn_s_getreg((3 << 11) | 20) & 0xFu; }
#define XB_SPIN(cond, bar) do { unsigned _sp = 0; while (cond) { __builtin_amdgcn_s_sleep(1); \
    if ((++_sp & 255u) == 0u) { if (xb_ld(&(bar)[XB_TMO])) break; if (_sp > XB_SPIN_CAP) { atomicAdd(&(bar)[XB_TMO], 1u); break; } } } } while (0)
struct XcdBarrier { unsigned* bar; unsigned x; volatile LAS unsigned* st; };
DI XcdBarrier xcd_barrier_post(unsigned* bar, volatile LAS unsigned* st) {
    XcdBarrier b; b.bar = bar; b.x = xb_xcc_id(); b.st = st;
    if (threadIdx.x == 0) (void)xb_add(&bar[XB_XCNT(b.x)], 1u);
    return b;
}
DI void xcd_barrier_complete(unsigned* bar, unsigned x, unsigned& nloc, unsigned& nx) {
    const unsigned G = gridDim.x * gridDim.y * gridDim.z;
    unsigned sum, cnt, mine, sp = 0u;
    for (;;) {
        sum = 0u; cnt = 0u; mine = 0u;
#pragma unroll
        for (unsigned j = 0; j < 16; ++j) { const unsigned c = xb_ld(&bar[XB_XCNT(j)]); sum += c; cnt += (c > 0u) ? 1u : 0u; mine = (j == x) ? c : mine; }
        if (sum == G) break;
        __builtin_amdgcn_s_sleep(1);
        if ((++sp & 255u) == 0u) { if (xb_ld(&bar[XB_TMO])) break; if (sp > XB_SPIN_CAP) { atomicAdd(&bar[XB_TMO], 1u); break; } }
    }
    nloc = mine > 0u ? mine : 1u; nx = cnt > 0u ? cnt : 1u;
}
DI void xcd_barrier(const XcdBarrier& b) {
    asm volatile("s_waitcnt vmcnt(0)" ::: "memory");
    __syncthreads();
    if (threadIdx.x == 0) {
        unsigned* bar = b.bar;
        __builtin_amdgcn_s_waitcnt(0);
        unsigned nloc = b.st[0], nx = b.st[1];
        if (nloc == 0u) { xcd_barrier_complete(bar, b.x, nloc, nx); b.st[0] = nloc; b.st[1] = nx; }
        const unsigned old = xb_add(&bar[XB_XSUB(b.x)], 1u);
        const unsigned gen = old / nloc;
        if (old + 1u == (gen + 1u) * nloc) {
            __builtin_amdgcn_fence(__ATOMIC_RELEASE, "agent");
            asm volatile("s_waitcnt vmcnt(0)" ::: "memory");
            const unsigned og = xb_add(&bar[XB_TOP], 1u);
            const unsigned tg = og / nx;
            if (og + 1u == (tg + 1u) * nx) xb_add(&bar[XB_TOPGEN], 1u);
            else XB_SPIN(xb_ld(&bar[XB_TOPGEN]) == tg, bar);
            __builtin_amdgcn_fence(__ATOMIC_ACQUIRE, "agent");
            xb_add(&bar[XB_XGEN(b.x)], 1u);
            asm volatile("s_waitcnt vmcnt(0)" ::: "memory");
        } else {
            XB_SPIN(xb_ld(&bar[XB_XGEN(b.x)]) == gen, bar);
            __builtin_amdgcn_fence(__ATOMIC_ACQUIRE, "agent");
            asm volatile("s_waitcnt vmcnt(0)" ::: "memory");
        }
    }
    __syncthreads();
}

#ifndef PROBE_MASK
#define PROBE_MASK 0
#endif
#define REPS(bit) for (int rep_ = 0; rep_ < (((PROBE_MASK) >> (bit)) & 1) + 1; ++rep_)
typedef const __attribute__((address_space(4))) Params* KP;
#define PH_BEGIN KP pp_ = (KP)__builtin_amdgcn_kernarg_segment_ptr(); asm volatile("" : "+s"(pp_)); const Params& p = *(const Params*)pp_; \
    int G = gridDim.x, c = blockIdx.x; asm volatile("" : "+s"(G), "+s"(c)); \
    float* XL = p.out; float* XC = (float*)(p.ws + WS_XC); const float* modl = (const float*)(p.ws + WS_MOD) + (size_t)l * 9 * 9216; const float* ng = p.in[6] + (size_t)l * 3 * 1024; \
    bf16_t* W = (bf16_t*)(p.ws + ((l & 1) ? WS_W2 : WS_W)); bf16_t* H = (bf16_t*)(p.ws + WS_R1); bf16_t* MB = H; bf16_t* QRAW = H; bf16_t* KVRAW = (bf16_t*)(p.ws + WS_R1 + R1_KVRAW); \
    bf16_t* PROJ = (bf16_t*)(p.ws + WS_PROJ); bf16_t* ACT = PROJ; float* MACC = (float*)(p.ws + WS_QKV); float* PART = MACC; bf16_t* Y = (bf16_t*)(p.ws + WS_Y); \
    (void)G; (void)c; (void)XL; (void)XC; (void)modl; (void)ng; (void)W; (void)H; (void)MB; (void)QRAW; (void)KVRAW; (void)PROJ; (void)ACT; (void)MACC; (void)Y; (void)PART;

__global__ void __launch_bounds__(512, 2) fwd_megakernel(Params p_unused) {
    extern __shared__ __attribute__((aligned(16))) unsigned char shm[];
    LAS unsigned char* lds = (LAS unsigned char*)shm;
    cg::grid_group grid = cg::this_grid();
    volatile LAS unsigned* xst = (volatile LAS unsigned*)(lds + pg8::STAGE_BYTES);
    if (threadIdx.x < 4) xst[threadIdx.x] = 0u;
    __syncthreads();
    XcdBarrier xb;
    { KP pp_ = (KP)__builtin_amdgcn_kernarg_segment_ptr(); xb = xcd_barrier_post((unsigned*)(pp_->ws + WS_BAR), xst); }
#define GSYNC() xcd_barrier(xb)

    REPS(6) { int l = 0; PH_BEGIN; mod_phase(p, lds); }
    { int l = 0; PH_BEGIN; tab_phase(p); }
    REPS(6) { int l = 0; PH_BEGIN; conv_weights(p, 0, lds, W, c, G); }
    grid.sync();

#pragma unroll 1
    for (int lq = 0; lq < DEPTH; ++lq) {
        int l = lq; asm volatile("" : "+s"(l));
        const bool last = (l == DEPTH - 1);
        const int Mx = last ? ML : MT;
        REPS(2) { PH_BEGIN; if (l == 0) norm_phase(p.in[0], p.in[2], XL, XC, true, H, ng, modl, 0, 1, MT, PART, 0); else norm_phase(XL, XC, XL, XC, false, H, ng, modl, 0, 1, MT, PART, 4); }
        GSYNC();
        REPS(1) { PH_BEGIN; pg8::Sched S; S.init(MT, 5632, 1024, G, c); pg8::Gemm g{H, W + W_1U, 1024, 1024}; EpiSwiglu E{ACT}; pg8::gemm_phase(lds, g, S, E); }
        GSYNC();
        { PH_BEGIN; pg8::Sched S; S.init(ML, 1024, DFF, G, c); S.add_split(MC / 256, ML / 256, 4); pg8::Gemm g{ACT, W + W_1D, DFF, DFF}; EpiResid E{XL, XC, modl, 2, 0.5f, PART}; pg8::gemm_phase(lds, g, S, E); }
        GSYNC();
        REPS(2) { PH_BEGIN; norm_phase(XL, XC, XL, XC, false, H, ng + 1024, modl, 3, 4, MT, PART, 4); }
        GSYNC();
        if (!last) { REPS(1) { PH_BEGIN; pg8::Sched S; S.init(MT, INWP, 1024, G, c); pg8::Gemm g{H, W + W_IN, 1024, 1024}; EpiStore E{PROJ, INWP, O_G}; pg8::gemm_phase(lds, g, S, E); } }
        else {
            { PH_BEGIN; pg8::Sched S; S.init(ML, INWP, 1024, G, c); pg8::Gemm g{H, W + W_IN, 1024, 1024}; EpiStore E{PROJ, INWP, O_G}; pg8::gemm_phase(lds, g, S, E); }
            { PH_BEGIN; pg8::Sched S; S.init(MC, 2048, 1024, G, (c + 64) % G); pg8::Gemm g{H + (size_t)ML * 1024, W + W_IN + (size_t)256 * 1024, 1024, 1024}; EpiStore E{PROJ + (size_t)ML * INWP + 256, INWP, 1 << 30}; pg8::gemm_phase(lds, g, S, E); }
        }
        GSYNC();
        REPS(2) { PH_BEGIN; pg8::Sched S; S.init(MT, 768, 384, G, c); pg8::Gemm g{PROJ + O_CQ, W + W_UQ, INWP, 384}; EpiStore E{QRAW, 768, 1 << 30}; pg8::gemm_phase(lds, g, S, E); }
        REPS(2) { PH_BEGIN; pg8::Sched S; S.init(MT, 1024, 256, G, (c + 40) % G); pg8::Gemm g{PROJ + O_CKV, W + W_UKV, INWP, 256}; EpiStore E{KVRAW, 1024, 1 << 30}; pg8::gemm_phase(lds, g, S, E); }
        GSYNC();
        REPS(2) { PH_BEGIN; prep_phase(p, l, lds); }
        GSYNC();
        REPS(0) { PH_BEGIN; attn_phase(p, l, !last, lds); }
        GSYNC();
        { PH_BEGIN; pg8::Sched S; S.init(Mx, 1024, 512, G, c, 3, 0, 0); S.kseg = 512; pg8::Gemm g{Y, W + W_BR, 1536, 1536}; EpiMerge E{MB, PROJ}; pg8::gemm_phase(lds, g, S, E);
          { int heavy = (MT / 256) * 4 - G; if (heavy < 0 || heavy >= G) heavy = 0;
            if (!last && c >= heavy) { bf16_t* Wn = (bf16_t*)(p.ws + (((l + 1) & 1) ? WS_W2 : WS_W)); conv_weights(p, l + 1, lds, Wn, c - heavy, G - heavy); } } }
        GSYNC();
        for (int r_ = 0; r_ < 6 * (((PROBE_MASK) >> 3) & 1); ++r_) GSYNC();
        { PH_BEGIN; pg8::Sched S; S.init(ML, 1024, 1024, G, c); if (!last) S.add_split(MC / 256, ML / 256, 4); pg8::Gemm g{MB, W + W_O, 1024, 1024}; EpiResid E{XL, XC, modl, 5, 1.0f, PART}; pg8::gemm_phase(lds, g, S, E); }
        GSYNC();
        REPS(2) { PH_BEGIN; norm_phase(XL, XC, XL, XC, false, H, ng + 2048, modl, 6, 7, Mx, PART, last ? 0 : 4); }
        GSYNC();
        REPS(1) { PH_BEGIN; pg8::Sched S; S.init(Mx, 5632, 1024, G, c); pg8::Gemm g{H, W + W_2U, 1024, 1024}; EpiSwiglu E{ACT}; pg8::gemm_phase(lds, g, S, E); }
        GSYNC();
        { PH_BEGIN; pg8::Sched S; S.init(ML, 1024, DFF, G, c); if (!last) S.add_split(MC / 256, ML / 256, 4); pg8::Gemm g{ACT, W + W_2D, DFF, DFF}; EpiResid E{XL, XC, modl, 8, 0.5f, PART}; pg8::gemm_phase(lds, g, S, E); }
        GSYNC();
    }
}

extern "C" void kernel_launch(void* const* d_in, const int* in_sizes, int n_in, void* d_out, int out_size, void* d_ws, size_t ws_size, hipStream_t stream) {
    constexpr int LDS_BYTES = pg8::STAGE_BYTES + 16;
    static int grid = 0;
    if (grid == 0) {
        if (n_in != 25 || ws_size < WS_END) { fprintf(stderr, "kernel_launch: bad inputs (n_in %d, ws %zu need %zu)\n", n_in, ws_size, (size_t)WS_END); grid = -1; return; }
        int dev = 0, cus = 0, per_cu = 0;
        hipGetDevice(&dev);
        hipDeviceGetAttribute(&cus, hipDeviceAttributeMultiprocessorCount, dev);
        hipFuncSetAttribute((const void*)fwd_megakernel, hipFuncAttributeMaxDynamicSharedMemorySize, LDS_BYTES);
        hipOccupancyMaxActiveBlocksPerMultiprocessor(&per_cu, (const void*)fwd_megakernel, 512, LDS_BYTES);
        if (per_cu < 1) per_cu = 1;
        (void)hipGetLastError();
        grid = cus;
    }
    if (grid < 0) return;
    Params p{};
    for (int i = 0; i < 25; ++i) p.in[i] = (const float*)d_in[i];
    p.out = (float*)d_out; p.ws = (unsigned char*)d_ws;
    (void)hipMemsetAsync((unsigned char*)d_ws + WS_BAR, 0, XCD_BAR_WORDS * 4, stream);
    void* args[] = {&p};
    hipError_t e = hipLaunchCooperativeKernel((const void*)fwd_megakernel, dim3(grid), dim3(512), args, LDS_BYTES, stream);
    if (e != hipSuccess) fprintf(stderr, "cooperative launch failed: %s (grid %d)\n", hipGetErrorString(e), grid);
}
```

```cpp
#include <hip/hip_runtime.h>
#include <hip/hip_cooperative_groups.h>
#include <cstdio>
#include <type_traits>
namespace cg = cooperative_groups;

#define LAS __attribute__((address_space(3)))
typedef unsigned short bf16_t;
typedef short bf16x8 __attribute__((ext_vector_type(8)));
typedef float f32x4 __attribute__((ext_vector_type(4)));
typedef float f32x2 __attribute__((ext_vector_type(2)));
typedef unsigned u32x4 __attribute__((ext_vector_type(4)));
typedef unsigned u32x2 __attribute__((ext_vector_type(2)));
typedef __bf16 bf16x2_t __attribute__((ext_vector_type(2)));
#define DI __device__ __forceinline__

constexpr int D = 1024, NB = 8, SEQ = 2048, NCTX = 256, TT = 2304, DEPTH = 4;
constexpr int ML = NB * SEQ;
constexpr int MC = NB * NCTX;
constexpr int MT = ML + MC;
constexpr int DFF = 2816, INW = 6816, INWP = 6912;
constexpr int O_CQ = 0, O_CKV = 384, O_KR = 640, O_DQ = 672, O_DK = 1184, O_DV = 1696, O_CB = 2208, O_CC = 2720, O_CX = 3232, O_G = 3744;
constexpr float EPS = 1e-6f;
constexpr float LOG2E = 1.4426950408889634f;

constexpr size_t al256(size_t x) { return (x + 255) & ~(size_t)255; }
constexpr size_t WS_MOD = 0;
constexpr size_t WS_TAB = al256(WS_MOD + (size_t)4 * 9 * 9216 * 4);
constexpr size_t WS_XC = al256(WS_TAB + (size_t)2048 * 96 * 4);
constexpr size_t WS_W = al256(WS_XC + (size_t)MC * D * 4);
constexpr size_t W_1U = 0, W_1D = W_1U + (size_t)5632 * 1024, W_2U = W_1D + (size_t)1024 * 2816, W_2D = W_2U + (size_t)5632 * 1024,
                 W_IN = W_2D + (size_t)1024 * 2816, W_UQ = W_IN + (size_t)INWP * 1024, W_UKV = W_UQ + (size_t)768 * 384,
                 W_BR = W_UKV + (size_t)1024 * 256, W_O = W_BR + (size_t)3 * 1024 * 512, W_END = W_O + (size_t)1024 * 1024;
constexpr size_t WS_R1 = al256(WS_W + W_END * 2);
constexpr size_t R1_KVRAW = (size_t)MT * 768 * 2;
constexpr size_t WS_PROJ = al256(WS_R1 + (size_t)MT * (768 + 1024) * 2);
constexpr size_t WS_QKV = al256(WS_PROJ + (size_t)MT * INWP * 2);
constexpr size_t Q_QM = 0, Q_KM = Q_QM + (size_t)NB * 8 * TT * 96 * 2, Q_VTM = Q_KM + (size_t)NB * 8 * TT * 96 * 2, Q_QD = Q_VTM + (size_t)NB * 8 * 64 * TT * 2,
                 Q_KD = Q_QD + (size_t)NB * 8 * TT * 64 * 2, Q_VTD = Q_KD + (size_t)NB * 8 * TT * 64 * 2, Q_END = Q_VTD + (size_t)NB * 4 * 128 * TT * 2;
constexpr size_t WS_Y = al256(WS_QKV + Q_END);
constexpr size_t WS_BAR = al256(WS_Y + (size_t)3 * MT * 512 * 2);
constexpr size_t WS_W2 = al256(WS_BAR + 3456 * 4);
constexpr size_t WS_END = al256(WS_W2 + W_END * 2);
static_assert(Q_END >= (size_t)MT * 1024 * 4, "MACC alias");

struct Params {
    const float* in[25];
    float* out;
    unsigned char* ws;
};

DI unsigned pk2(float a, float b) { f32x2 f = {a, b}; bf16x2_t h = __builtin_convertvector(f, bf16x2_t); return __builtin_bit_cast(unsigned, h); }
DI float bflo(unsigned u) { return __uint_as_float(u << 16); }
DI float bfhi(unsigned u) { return __uint_as_float(u & 0xffff0000u); }
DI float wave_sum(float v) {
#pragma unroll
    for (int o = 32; o > 0; o >>= 1) v += __shfl_xor(v, o);
    return v;
}
DI float wave_max(float v) {
#pragma unroll
    for (int o = 32; o > 0; o >>= 1) v = fmaxf(v, __shfl_xor(v, o));
    return v;
}
DI float lam_init_of(int l) { return l == 0 ? 0.2f : (l == 1 ? 0.35550907f : (l == 2 ? 0.47071302f : 0.55605820f)); }
DI float sigmoidf_(float x) { return __builtin_amdgcn_rcpf(1.0f + __builtin_amdgcn_exp2f(-1.4426950408889634f * x)); }
DI int tidx() { int t = threadIdx.x; asm volatile("" : "+v"(t)); return t; }

namespace pg8 {
constexpr int BM = 256, BK = 64, HALF = 128, HTB = HALF * BK * 2, STAGE_BYTES = 8 * HTB, NXCD = 8, WGM = 8;
DI int lds_byte(int r, int c) { const int st = (r >> 4) * 2 + (c >> 5), rr = r & 15, cc = c & 31, ob = rr * 64 + cc * 2; return st * 1024 + (ob ^ (((ob >> 9) & 1) << 5)); }
DI void stage_rc(int b, int& R, int& C) { const int st = b / 1024, sb = b % 1024, swz = sb ^ (((sb >> 9) & 1) << 5); R = (st >> 1) * 16 + swz / 64; C = (st & 1) * 32 + (swz % 64) / 2; }
DI int perm32(int rho) { const int n = rho >> 4, i = rho & 15; return 8 * (i >> 2) + 4 * n + (i & 3); }
struct Unit { int pm, pn, k0, nt, split; };
struct Gemm { const bf16_t* A; const bf16_t* Bt; int lda, K; };

struct Sched {
    int nM, nN, nwg, G, c, rep, aStride, bStride, ntFull;
    int nSplit, P, splitPm0, nb;
    int kseg;
    DI void init(int M, int N, int K, int G_, int c_, int rep_ = 1, int as_ = 0, int bs_ = 0) { nM = M / BM; nN = N / BM; nwg = nM * nN; G = G_; c = c_; rep = rep_; aStride = as_; bStride = bs_; ntFull = K / BK;
        nSplit = 0; P = 1; splitPm0 = 0; nb = K / 128; kseg = 0; }
    DI void add_split(int tilesM, int pm0, int P_) { nSplit = tilesM * nN * P_; P = P_; splitPm0 = pm0; }
    DI bool next(int i, Unit& u) const {
        int it = i, n = 0;
        if (rep > 1) { it = i / rep; n = i - it * rep; }
        const long L = (long)it * G + c;
        if (L >= nwg) {
            const int s = (int)(L - nwg); if (s >= nSplit) return false;
            const int tile = s / P, j = s - tile * P, base = nb / P, rem = nb - base * P;
            u.pm = splitPm0 + tile / nN; u.pn = tile % nN; u.k0 = 128 * (j * base + (j < rem ? j : rem)); u.nt = 2 * (base + (j < rem ? 1 : 0)); u.split = j + 1; return true;
        }
        int wgid = (int)L; { const int q = nwg / NXCD, r = nwg % NXCD, xcd = wgid % NXCD, off = wgid / NXCD; wgid = (xcd < r ? xcd * (q + 1) : r * (q + 1) + (xcd - r) * q) + off; }
        const int nig = WGM * nN, gid = wgid / nig, fm = gid * WGM, gsz = (nM - fm) < WGM ? (nM - fm) : WGM;
        u.pm = fm + ((wgid % nig) % gsz) + n * aStride; u.pn = (wgid % nig) / gsz + n * bStride; u.k0 = 0; u.nt = ntFull; u.split = 0;
        if (kseg) { u.k0 = n * kseg; u.split = n; }
        return true;
    }
};

template <class Epi>
DI void gemm_phase(LAS unsigned char* lds, const Gemm g, const Sched& S, const Epi& E) {
    const int tid = tidx(), wid = __builtin_amdgcn_readfirstlane(tid >> 6), lane = tid & 63, wr = wid >> 2, wc = wid & 3, fr = lane & 15, fq = lane >> 4;
    const int K = g.K, lda = g.lda;
    unsigned voffA[2], voffB[2];
#pragma unroll
    for (int i = 0; i < 2; ++i) { int R, C; stage_rc(tid * 16 + i * 8192, R, C); const int Rb = Epi::PERM ? ((R & ~31) + perm32(R & 31)) : R;
        voffA[i] = (unsigned)(R * lda + C) * 2u; voffB[i] = (unsigned)(Rb * K + C) * 2u; }
    const size_t kstep = (size_t)(BK * 2);
    const size_t hstepA = (size_t)HALF * lda * 2, hstepB = (size_t)HALF * K * 2;
    const size_t tstepA = 2 * hstepA, tstepB = 2 * hstepB;
    const unsigned ldsw = (unsigned)wid * 1024u;
    const int aoff = lds_byte(wr * 64 + fr, fq * 8), boff = lds_byte(wc * 32 + fr, fq * 8);
#define PG8_SA(b, h) (((b) * 2 + (h)) * HTB)
#define PG8_SB(b, h) ((4 + (b) * 2 + (h)) * HTB)
#define PG8_STAGE(bufoff, gbase, voff) do { _Pragma("unroll") for (int _i = 0; _i < 2; ++_i) \
        __builtin_amdgcn_global_load_lds((const unsigned*)((const char*)(gbase) + (voff)[_i]), (LAS unsigned*)(lds + (bufoff) + ldsw + _i * 8192), 16, 0, 0); } while (0)
#define PG8_LDA(dst, b, h) do { _Pragma("unroll") for (int m = 0; m < 4; ++m) _Pragma("unroll") for (int k = 0; k < 2; ++k) dst[m][k] = *(const LAS bf16x8*)(lds + PG8_SA(b, h) + aoff + m * 2048 + k * 1024); } while (0)
#define PG8_LDB(dst, b, h) do { _Pragma("unroll") for (int n = 0; n < 2; ++n) _Pragma("unroll") for (int k = 0; k < 2; ++k) dst[n][k] = *(const LAS bf16x8*)(lds + PG8_SB(b, h) + boff + n * 2048 + k * 1024); } while (0)
#define PG8_MMA(ai, bj, At, Bt) do { __builtin_amdgcn_s_setprio(1); _Pragma("unroll") for (int m = 0; m < 4; ++m) _Pragma("unroll") for (int n = 0; n < 2; ++n) _Pragma("unroll") for (int k = 0; k < 2; ++k) \
        acc[ai][bj][m][n] = __builtin_amdgcn_mfma_f32_16x16x32_bf16(Bt[n][k], At[m][k], acc[ai][bj][m][n], 0, 0, 0); __builtin_amdgcn_s_setprio(0); } while (0)
#define PG8_WAIT_V(n) asm volatile("s_waitcnt vmcnt(" #n ")" ::: "memory")
#define PG8_WAIT_L(n) asm volatile("s_waitcnt lgkmcnt(" #n ")" ::: "memory")
#define PG8_BAR __builtin_amdgcn_s_barrier()
#define PG8_SCHED __builtin_amdgcn_sched_barrier(0)
    Unit cur, nxt; int ui = 0;
    if (!S.next(0, cur)) return;
    f32x4 acc[2][2][4][2];
#pragma unroll
    for (int a = 0; a < 2; ++a)
#pragma unroll
        for (int b = 0; b < 2; ++b)
#pragma unroll
            for (int m = 0; m < 4; ++m)
#pragma unroll
                for (int n = 0; n < 2; ++n) acc[a][b][m][n] = (f32x4){0.f, 0.f, 0.f, 0.f};
    bf16x8 At[4][2], B0[2][2], B1[2][2];
    const char* cA = (const char*)g.A + (size_t)cur.pm * tstepA + (size_t)cur.k0 * 2; const char* cB = (const char*)g.Bt + (size_t)cur.pn * tstepB + (size_t)cur.k0 * 2;
    PG8_STAGE(PG8_SB(0, 0), cB, voffB); PG8_STAGE(PG8_SA(0, 0), cA, voffA); PG8_STAGE(PG8_SB(0, 1), cB + hstepB, voffB); PG8_STAGE(PG8_SA(0, 1), cA + hstepA, voffA);
    if (wr == 1) PG8_BAR;
    PG8_WAIT_V(4); PG8_BAR;
    PG8_STAGE(PG8_SB(1, 0), cB + kstep, voffB); PG8_STAGE(PG8_SA(1, 0), cA + kstep, voffA); PG8_STAGE(PG8_SB(1, 1), cB + hstepB + kstep, voffB);
    PG8_WAIT_V(6); PG8_BAR;
    for (;;) {
        const bool has_next = S.next(ui + 1, nxt);
        const char* nA = has_next ? (const char*)g.A + (size_t)nxt.pm * tstepA + (size_t)nxt.k0 * 2 : cA; const char* nB = has_next ? (const char*)g.Bt + (size_t)nxt.pn * tstepB + (size_t)nxt.k0 * 2 : cB;
        const int nt = cur.nt;
        for (int t = 0; t < nt; t += 2) {
            const bool last = (t == nt - 2);
            const char* a1 = cA + (size_t)(t + 1) * kstep;
            const char* a2 = last ? nA : cA + (size_t)(t + 2) * kstep; const char* b2 = last ? nB : cB + (size_t)(t + 2) * kstep;
            const char* a3 = a2 + kstep; const char* b3 = b2 + kstep;
            PG8_LDB(B0, 0, 0); PG8_SCHED; PG8_LDA(At, 0, 0); PG8_STAGE(PG8_SA(1, 1), a1 + hstepA, voffA);
            PG8_WAIT_L(8); PG8_BAR; PG8_WAIT_L(0); PG8_MMA(0, 0, At, B0); PG8_BAR; PG8_SCHED;
            PG8_LDB(B1, 0, 1); PG8_STAGE(PG8_SB(0, 0), b2, voffB);
            PG8_BAR; PG8_WAIT_L(0); PG8_MMA(0, 1, At, B1); PG8_BAR;
            PG8_LDA(At, 0, 1); PG8_STAGE(PG8_SA(0, 0), a2, voffA);
            PG8_BAR; PG8_WAIT_L(0); PG8_MMA(1, 0, At, B0); PG8_BAR; PG8_SCHED;
            PG8_STAGE(PG8_SB(0, 1), b2 + hstepB, voffB);
            PG8_WAIT_V(6); PG8_BAR; PG8_MMA(1, 1, At, B1); PG8_BAR;
            PG8_LDB(B0, 1, 0); PG8_SCHED; PG8_LDA(At, 1, 0); PG8_STAGE(PG8_SA(0, 1), a2 + hstepA, voffA);
            PG8_WAIT_L(8); PG8_BAR; PG8_WAIT_L(0); PG8_MMA(0, 0, At, B0); PG8_BAR; PG8_SCHED;
            PG8_LDB(B1, 1, 1); PG8_STAGE(PG8_SB(1, 0), b3, voffB);
            PG8_BAR; PG8_WAIT_L(0); PG8_MMA(0, 1, At, B1); PG8_BAR;
            PG8_LDA(At, 1, 1); PG8_STAGE(PG8_SA(1, 0), a3, voffA);
            PG8_BAR; PG8_WAIT_L(0); PG8_MMA(1, 0, At, B0); PG8_BAR; PG8_SCHED;
            PG8_STAGE(PG8_SB(1, 1), b3 + hstepB, voffB);
            PG8_WAIT_V(6); PG8_BAR; PG8_MMA(1, 1, At, B1); PG8_BAR;
        }
        E(acc, cur, wr, wc, fr, fq);
        if (!has_next) break;
        if (!(Epi::CHAIN && nxt.split != 0)) {
#pragma unroll
            for (int a = 0; a < 2; ++a)
#pragma unroll
                for (int b = 0; b < 2; ++b)
#pragma unroll
                    for (int m = 0; m < 4; ++m)
#pragma unroll
                        for (int n = 0; n < 2; ++n) acc[a][b][m][n] = (f32x4){0.f, 0.f, 0.f, 0.f};
        }
        cur = nxt; cA = nA; cB = nB; ++ui;
    }
    PG8_WAIT_V(0);
    if (wr == 0) PG8_BAR;
    PG8_BAR;
#undef PG8_SA
#undef PG8_SB
#undef PG8_STAGE
#undef PG8_LDA
#undef PG8_LDB
#undef PG8_MMA
#undef PG8_WAIT_V
#undef PG8_WAIT_L
#undef PG8_BAR
#undef PG8_SCHED
}
}
using pg8::Unit;
typedef f32x4 AccT[2][2][4][2];

struct EpiStore {
    static constexpr bool PERM = true, CHAIN = false;
    bf16_t* O; int ld; int sig0;
    DI void operator()(const AccT& acc, const Unit& u, int wr, int wc, int fr, int fq) const {
        const int row0 = u.pm * 256 + wr * 64 + fr, col0 = u.pn * 256 + wc * 32 + 8 * fq;
#pragma unroll
        for (int ai = 0; ai < 2; ++ai)
#pragma unroll
            for (int m = 0; m < 4; ++m) { bf16_t* rowp = O + (size_t)(row0 + ai * 128 + m * 16) * ld + col0;
#pragma unroll
                for (int bj = 0; bj < 2; ++bj) { f32x4 v0 = acc[ai][bj][m][0], v1 = acc[ai][bj][m][1];
                    if (u.pn * 256 + bj * 128 + wc * 32 >= sig0) {
#pragma unroll
                        for (int j = 0; j < 4; ++j) { v0[j] = sigmoidf_(v0[j]); v1[j] = sigmoidf_(v1[j]); } }
                    u32x4 w; w.x = pk2(v0[0], v0[1]); w.y = pk2(v0[2], v0[3]); w.z = pk2(v1[0], v1[1]); w.w = pk2(v1[2], v1[3]);
                    *(u32x4*)(rowp + bj * 128) = w; } }
    }
};
struct EpiSwiglu {
    static constexpr bool PERM = true, CHAIN = false;
    bf16_t* O;
    DI void operator()(const AccT& acc, const Unit& u, int wr, int wc, int fr, int fq) const {
        const int row0 = u.pm * 256 + wr * 64 + fr, col0 = (u.pn * 256 + wc * 32 + 8 * fq) >> 1;
#pragma unroll
        for (int ai = 0; ai < 2; ++ai)
#pragma unroll
            for (int m = 0; m < 4; ++m) { bf16_t* rowp = O + (size_t)(row0 + ai * 128 + m * 16) * DFF + col0;
#pragma unroll
                for (int bj = 0; bj < 2; ++bj) { const f32x4 v0 = acc[ai][bj][m][0], v1 = acc[ai][bj][m][1];
                    const float r0 = v0[0] * sigmoidf_(v0[0]) * v0[1], r1 = v0[2] * sigmoidf_(v0[2]) * v0[3];
                    const float r2 = v1[0] * sigmoidf_(v1[0]) * v1[1], r3 = v1[2] * sigmoidf_(v1[2]) * v1[3];
                    u32x2 w; w.x = pk2(r0, r1); w.y = pk2(r2, r3);
                    *(u32x2*)(rowp + bj * 64) = w; } }
    }
};
struct EpiResid {
    static constexpr bool PERM = false, CHAIN = false;
    float* xl; float* xc; const float* modl; int midx; float coef; float* part;
    DI void operator()(const AccT& acc, const Unit& u, int wr, int wc, int fr, int fq) const {
        const int bi = u.pm < 64 ? (u.pm >> 3) : 8;
        float* base = u.pm < 64 ? xl + (size_t)u.pm * 256 * D : xc + (size_t)(u.pm - 64) * 256 * D;
        if (u.split) base = part + (size_t)(u.split - 1) * MC * D + (size_t)(u.pm - 64) * 256 * D;
        const int row0 = wr * 64 + fr, col0 = u.pn * 256 + wc * 32 + 4 * fq;
        const float* mp = modl + (size_t)bi * 9216 + midx * 1024 + col0;
#pragma unroll
        for (int bj = 0; bj < 2; ++bj) {
            f32x4 mv[2];
#pragma unroll
            for (int n = 0; n < 2; ++n) mv[n] = *(const f32x4*)(mp + bj * 128 + n * 16) * coef;
            float* cb = base + (size_t)row0 * D + col0 + bj * 128;
            f32x4 xv[2][2][4];
            if (!u.split) {
#pragma unroll
                for (int n = 0; n < 2; ++n)
#pragma unroll
                    for (int ai = 0; ai < 2; ++ai)
#pragma unroll
                        for (int m = 0; m < 4; ++m) xv[n][ai][m] = *(const f32x4*)(cb + n * 16 + (size_t)(ai * 128 + m * 16) * D);
            } else {
#pragma unroll
                for (int n = 0; n < 2; ++n)
#pragma unroll
                    for (int ai = 0; ai < 2; ++ai)
#pragma unroll
                        for (int m = 0; m < 4; ++m) xv[n][ai][m] = (f32x4){0.f, 0.f, 0.f, 0.f};
            }
#pragma unroll
            for (int n = 0; n < 2; ++n)
#pragma unroll
                for (int ai = 0; ai < 2; ++ai)
#pragma unroll
                    for (int m = 0; m < 4; ++m) *(f32x4*)(cb + n * 16 + (size_t)(ai * 128 + m * 16) * D) = xv[n][ai][m] + mv[n] * acc[ai][bj][m][n];
        }
    }
};
struct EpiMerge {
    static constexpr bool PERM = false, CHAIN = true;
    bf16_t* mb; const bf16_t* proj;
    DI void operator()(AccT& acc, const Unit& u, int wr, int wc, int fr, int fq) const {
        const int seg = u.split;
        const int row0 = u.pm * 256 + wr * 64 + fr, col0 = u.pn * 256 + wc * 32 + 4 * fq;
#pragma unroll
        for (int ai = 0; ai < 2; ++ai) {
            u32x2 ga[4][4], gb[4][4];
#pragma unroll
            for (int m = 0; m < 4; ++m) { const bf16_t* gp = proj + (size_t)(row0 + ai * 128 + m * 16) * INWP + O_G + seg * 1024 + col0;
#pragma unroll
                for (int q = 0; q < 4; ++q) { const int co = (q >> 1) * 128 + (q & 1) * 16; ga[m][q] = *(const u32x2*)(gp + co); gb[m][q] = seg < 2 ? *(const u32x2*)(gp + 1024 + co) : (u32x2){0u, 0u}; } }
#pragma unroll
            for (int m = 0; m < 4; ++m) { const size_t row = (size_t)(row0 + ai * 128 + m * 16);
#pragma unroll
                for (int q = 0; q < 4; ++q) { const int bj = q >> 1, n = q & 1, co = bj * 128 + n * 16;
                    f32x4 r; r[0] = fmaxf(bflo(ga[m][q].x), 1e-20f); r[1] = fmaxf(bfhi(ga[m][q].x), 1e-20f); r[2] = fmaxf(bflo(ga[m][q].y), 1e-20f); r[3] = fmaxf(bfhi(ga[m][q].y), 1e-20f);
                    if (seg < 2) {
                        r[0] *= __builtin_amdgcn_rcpf(fmaxf(bflo(gb[m][q].x), 1e-20f)); r[1] *= __builtin_amdgcn_rcpf(fmaxf(bfhi(gb[m][q].x), 1e-20f));
                        r[2] *= __builtin_amdgcn_rcpf(fmaxf(bflo(gb[m][q].y), 1e-20f)); r[3] *= __builtin_amdgcn_rcpf(fmaxf(bfhi(gb[m][q].y), 1e-20f));
                        acc[ai][bj][m][n] = acc[ai][bj][m][n] * r; }
                    else { const f32x4 v = acc[ai][bj][m][n] * r; u32x2 w; w.x = pk2(v[0], v[1]); w.y = pk2(v[2], v[3]); *(u32x2*)(mb + row * D + col0 + co) = w; } } }
        }
    }
};

DI void mod_phase(const Params& p, LAS unsigned char* ldsb) {
    LAS float* sc = (LAS float*)ldsb;
    LAS float* red = sc + 9216;
    const int tid = tidx(), wid = tid >> 6, lane = tid & 63;
    for (int i = tid; i < 9216; i += 512) { const int bi = i >> 10, k = i & 1023; const float cv = bi < 8 ? p.in[1][bi * 1024 + k] : p.in[3][k]; sc[i] = cv / (1.0f + expf(-cv)); }
    __syncthreads();
    float* MOD = (float*)(p.ws + WS_MOD);
    for (int item = blockIdx.x; item < 144; item += gridDim.x) {
        const int l = item / 36, j0 = (item % 36) * 256;
        const float* w = p.in[4] + ((size_t)l * 1024 + wid * 128) * 9216 + j0 + lane * 4;
        f32x4 acc[9];
#pragma unroll
        for (int b = 0; b < 9; ++b) acc[b] = (f32x4){0.f, 0.f, 0.f, 0.f};
#pragma unroll 8
        for (int kk = 0; kk < 128; ++kk) { const f32x4 wv = __builtin_nontemporal_load((const f32x4*)(w + (size_t)kk * 9216)); const int k = wid * 128 + kk;
#pragma unroll
            for (int b = 0; b < 9; ++b) acc[b] = acc[b] + wv * sc[b * 1024 + k]; }
#pragma unroll
        for (int b = 0; b < 9; ++b) *(LAS f32x4*)(red + (wid * 9 + b) * 256 + lane * 4) = acc[b];
        __syncthreads();
        for (int o = tid; o < 9 * 256; o += 512) { const int b = o >> 8, cn = o & 255; float s = 0.f;
#pragma unroll
            for (int w8 = 0; w8 < 8; ++w8) s += red[(w8 * 9 + b) * 256 + cn];
            MOD[((size_t)l * 9 + b) * 9216 + j0 + cn] = s + p.in[5][(size_t)l * 9216 + j0 + cn]; }
        __syncthreads();
    }
}
DI void tab_phase(const Params& p) {
    float* TABM = (float*)(p.ws + WS_TAB);
    float* TABD = TABM + 2048 * 32;
    const int gt = blockIdx.x * 512 + tidx(), nth = gridDim.x * 512;
    for (int i = gt; i < 2048 * 48; i += nth) {
        const int s = i / 48, a = i % 48;
        const float row = (float)(s >> 6), col = (float)(s & 63);
        float pos, invf; int idx; float* dst; int half;
        if (a < 16) { const int axis = a >> 3, f = a & 7; pos = axis ? col : row; invf = exp2f(-(float)f * (13.287712379549449f / 8.0f)); dst = TABM + s * 32; idx = a; half = 16; }
        else { const int a2 = a - 16, axis = a2 >> 4, f = a2 & 15; pos = axis ? col : row; invf = exp2f(-(float)f * (13.287712379549449f / 16.0f)); dst = TABD + s * 64; idx = a2; half = 32; }
        const float ang = pos * invf;
        float rev = ang * 0.15915494309189535f; rev -= floorf(rev);
        dst[idx] = __builtin_amdgcn_cosf(rev); dst[half + idx] = __builtin_amdgcn_sinf(rev);
    }
}

DI void convT(const float* __restrict__ src, int K, int N, bf16_t* __restrict__ dst, int mode, const float* kscale, LAS float* tile, int rot, int vid, int vcnt, int ldd = 0, int koff = 0) {
    if (ldd == 0) ldd = K;
    const int tilesN = (N + 63) >> 6, tilesK = K >> 6, nt = tilesN * tilesK, tid = tidx();
    int start = vid - (rot % vcnt); if (start < 0) start += vcnt;
    const int kr = tid >> 4, c4 = (tid & 15) * 4;
    f32x4 r0, r1;
    auto fetch = [&](int tl) {
        const int tk = tl / tilesN, tn = tl - tk * tilesN, n = tn * 64 + c4, k0 = tk * 64 + kr;
        r0 = (f32x4){0.f, 0.f, 0.f, 0.f}; r1 = r0;
        if (n < N) { r0 = __builtin_nontemporal_load((const f32x4*)(src + (size_t)k0 * N + n)); r1 = __builtin_nontemporal_load((const f32x4*)(src + (size_t)(k0 + 32) * N + n)); }
        if (kscale) { r0 = r0 * kscale[k0]; r1 = r1 * kscale[k0 + 32]; }
    };
    if (start < nt) fetch(start);
    for (int tl = start; tl < nt; tl += vcnt) {
        const int tk = tl / tilesN, tn = tl - tk * tilesN;
        { LAS float* tp = tile + kr * 65 + c4; tp[0] = r0[0]; tp[1] = r0[1]; tp[2] = r0[2]; tp[3] = r0[3];
          tp += 32 * 65; tp[0] = r1[0]; tp[1] = r1[1]; tp[2] = r1[2]; tp[3] = r1[3]; }
        if (tl + vcnt < nt) fetch(tl + vcnt);
        __syncthreads();
        { const int nl = tid >> 3, k8 = (tid & 7) * 8, n = tn * 64 + nl;
          if (n < N) { float f[8];
#pragma unroll
              for (int j = 0; j < 8; ++j) f[j] = tile[(k8 + j) * 65 + nl];
              u32x4 w; w.x = pk2(f[0], f[1]); w.y = pk2(f[2], f[3]); w.z = pk2(f[4], f[5]); w.w = pk2(f[6], f[7]);
              int drow = n;
              if (mode == 1) drow = n < DFF ? 2 * n : 2 * (n - DFF) + 1;
              else if (mode == 2) { const int h = n / 96, o = n - h * 96, q = o - 64; if (o >= 64) drow = h * 96 + 64 + 2 * ((q >> 4) * 8 + (q & 7)) + ((q >> 3) & 1); }
              else if (mode == 3) { if (n >= O_KR && n < O_DQ) { const int q = n - O_KR; drow = O_KR + 2 * ((q >> 4) * 8 + (q & 7)) + ((q >> 3) & 1); }
                                    else if (n >= O_DQ && n < O_DV) { const int o = (n - O_DQ) & 63; drow = n - o + 2 * ((o >> 5) * 16 + (o & 15)) + ((o >> 4) & 1); } }
              *(u32x4*)(dst + (size_t)drow * ldd + koff + tk * 64 + k8) = w; } }
        __syncthreads();
    }
}
DI void conv_weights(const Params& p, int l, LAS unsigned char* ldsb, bf16_t* W, int vid, int vcnt) {
    LAS float* tile = (LAS float*)ldsb;
    convT(p.in[7] + (size_t)l * 1024 * 5632, 1024, 5632, W + W_1U, 1, nullptr, tile, 0, vid, vcnt);
    convT(p.in[8] + (size_t)l * 2816 * 1024, 2816, 1024, W + W_1D, 0, nullptr, tile, 128, vid, vcnt);
    convT(p.in[9] + (size_t)l * 1024 * 5632, 1024, 5632, W + W_2U, 1, nullptr, tile, 64, vid, vcnt);
    convT(p.in[10] + (size_t)l * 2816 * 1024, 2816, 1024, W + W_2D, 0, nullptr, tile, 192, vid, vcnt);
    convT(p.in[11] + (size_t)l * 1024 * INW, 1024, INW, W + W_IN, 3, nullptr, tile, 32, vid, vcnt);
    convT(p.in[13] + (size_t)l * 384 * 768, 384, 768, W + W_UQ, 2, p.in[12] + l * 384, tile, 160, vid, vcnt);
    convT(p.in[15] + (size_t)l * 256 * 1024, 256, 1024, W + W_UKV, 0, p.in[14] + l * 256, tile, 232, vid, vcnt);
    for (int n = 0; n < 3; ++n) convT(p.in[23] + ((size_t)l * 3 + n) * 512 * 1024, 512, 1024, W + W_BR, 0, nullptr, tile, 40 + n * 72, vid, vcnt, 1536, n * 512);
    convT(p.in[24] + (size_t)l * 1024 * 1024, 1024, 1024, W + W_O, 0, nullptr, tile, 96, vid, vcnt);
    { u32x4* z = (u32x4*)(W + W_IN + (size_t)INW * 1024); const int nz = (INWP - INW) * 1024 / 8;
      for (int i = vid * 512 + tidx(); i < nz; i += vcnt * 512) z[i] = (u32x4){0u, 0u, 0u, 0u}; }
}

DI void norm_phase(const float* sl, const float* sc_, float* dl, float* dc, bool copy, bf16_t* H, const float* g, const float* modl, int shift_i, int scale_i, int Mrows, const float* part, int npart) {
    const int tid_ = tidx(), lane = tid_ & 63, gw = blockIdx.x * 8 + (tid_ >> 6), nw = gridDim.x * 8;
    constexpr int R = 3;
    for (int row0 = gw; row0 < Mrows; row0 += R * nw) {
        f32x4 v[R][4]; float ss[R]; bool ok[R];
#pragma unroll
        for (int r = 0; r < R; ++r) { int row = row0 + r * nw; ok[r] = row < Mrows; row = ok[r] ? row : Mrows - 1;
            const float* src = row < ML ? sl + (size_t)row * D : sc_ + (size_t)(row - ML) * D;
#pragma unroll
            for (int i = 0; i < 4; ++i) v[r][i] = *(const f32x4*)(src + i * 256 + lane * 4); }
#pragma unroll
        for (int r = 0; r < R; ++r) { const int row = row0 + r * nw;
            if (ok[r] && npart > 0 && row >= ML) {
                f32x4 pv[4][4];
#pragma unroll
                for (int j = 0; j < 4; ++j) { const float* pp = part + (size_t)j * MC * D + (size_t)(row - ML) * D;
#pragma unroll
                    for (int i = 0; i < 4; ++i) pv[j][i] = *(const f32x4*)(pp + i * 256 + lane * 4); }
#pragma unroll
                for (int j = 0; j < 4; ++j)
#pragma unroll
                    for (int i = 0; i < 4; ++i) v[r][i] = v[r][i] + pv[j][i]; }
            float s = 0.f;
#pragma unroll
            for (int i = 0; i < 4; ++i) s += v[r][i][0] * v[r][i][0] + v[r][i][1] * v[r][i][1] + v[r][i][2] * v[r][i][2] + v[r][i][3] * v[r][i][3];
            ss[r] = s; }
#pragma unroll
        for (int o = 32; o > 0; o >>= 1) {
#pragma unroll
            for (int r = 0; r < R; ++r) ss[r] += __shfl_xor(ss[r], o); }
#pragma unroll
        for (int r = 0; r < R; ++r) { const int row = row0 + r * nw;
            if (!ok[r]) continue;
            const int bi = row < ML ? (row >> 11) : 8;
            const float rstd = rsqrtf(ss[r] * (1.0f / 1024.0f) + EPS);
            const float* mb = modl + (size_t)bi * 9216;
#pragma unroll
            for (int i = 0; i < 4; ++i) { const int col = i * 256 + lane * 4;
                const f32x4 gg = *(const f32x4*)(g + col), scv = *(const f32x4*)(mb + scale_i * 1024 + col), shv = *(const f32x4*)(mb + shift_i * 1024 + col);
                const f32x4 h = v[r][i] * rstd * gg * (scv + 1.0f) + shv;
                u32x2 w; w.x = pk2(h[0], h[1]); w.y = pk2(h[2], h[3]);
                *(u32x2*)(H + (size_t)row * D + col) = w; }
            if (copy || (npart > 0 && row >= ML)) { float* dst = row < ML ? dl + (size_t)row * D : dc + (size_t)(row - ML) * D;
#pragma unroll
                for (int i = 0; i < 4; ++i) *(f32x4*)(dst + i * 256 + lane * 4) = v[r][i]; }
        }
    }
}

template <int NV> DI void load_bf16_row(const bf16_t* src, float* v, float mul) {
#pragma unroll
    for (int i = 0; i < NV / 8; ++i) { const u32x4 w = *(const u32x4*)(src + i * 8);
        v[i * 8 + 0] = bflo(w.x) * mul; v[i * 8 + 1] = bfhi(w.x) * mul; v[i * 8 + 2] = bflo(w.y) * mul; v[i * 8 + 3] = bfhi(w.y) * mul;
        v[i * 8 + 4] = bflo(w.z) * mul; v[i * 8 + 5] = bfhi(w.z) * mul; v[i * 8 + 6] = bflo(w.w) * mul; v[i * 8 + 7] = bfhi(w.w) * mul; }
}
template <int NV> DI void store_bf16_row(bf16_t* dst, const float* v) {
#pragma unroll
    for (int i = 0; i < NV / 8; ++i) { u32x4 w; w.x = pk2(v[i * 8], v[i * 8 + 1]); w.y = pk2(v[i * 8 + 2], v[i * 8 + 3]); w.z = pk2(v[i * 8 + 4], v[i * 8 + 5]); w.w = pk2(v[i * 8 + 6], v[i * 8 + 7]);
        *(u32x4*)(dst + i * 8) = w; }
}
template <int NV> DI float sumsq_row(const bf16_t* src, float mul) {
    float ss = 0.f;
#pragma unroll
    for (int i = 0; i < NV / 8; ++i) { const u32x4 w = *(const u32x4*)(src + i * 8); const unsigned ww[4] = {w.x, w.y, w.z, w.w};
#pragma unroll
        for (int j = 0; j < 4; ++j) { const float a = bflo(ww[j]) * mul, b = bfhi(ww[j]) * mul; ss += a * a; ss += b * b; } }
    return ss;
}
template <int NV> DI void emit_plain(const bf16_t* src, float mul, const LAS float* g, bf16_t* dst) {
#pragma unroll 2
    for (int i = 0; i < NV / 8; ++i) { const u32x4 w = *(const u32x4*)(src + i * 8); const unsigned ww[4] = {w.x, w.y, w.z, w.w}; unsigned o[4];
#pragma unroll
        for (int j = 0; j < 4; ++j) o[j] = pk2(bflo(ww[j]) * mul * g[i * 8 + 2 * j], bfhi(ww[j]) * mul * g[i * 8 + 2 * j + 1]);
        u32x4 ov; ov.x = o[0]; ov.y = o[1]; ov.z = o[2]; ov.w = o[3]; *(u32x4*)(dst + i * 8) = ov; }
}
template <int QF> DI void emit_rope_axis(const bf16_t* src, float mul, const LAS float* g, const float* cp, const float* sp, bf16_t* dst) {
    float v[2 * QF];
#pragma unroll
    for (int i = 0; i < QF / 4; ++i) { const u32x4 w = *(const u32x4*)(src + i * 8); const unsigned ww[4] = {w.x, w.y, w.z, w.w};
#pragma unroll
        for (int j = 0; j < 4; ++j) { v[i * 8 + 2 * j] = bflo(ww[j]) * mul * g[i * 8 + 2 * j]; v[i * 8 + 2 * j + 1] = bfhi(ww[j]) * mul * g[i * 8 + 2 * j + 1]; } }
    if (cp) {
#pragma unroll
        for (int f = 0; f < QF; ++f) { const float c = cp[f], s = sp[f], x1 = v[f], x2 = v[QF + f]; v[f] = x1 * c - x2 * s; v[QF + f] = x2 * c + x1 * s; }
    }
#pragma unroll
    for (int i = 0; i < QF / 4; ++i) { u32x4 ov; ov.x = pk2(v[i * 8], v[i * 8 + 1]); ov.y = pk2(v[i * 8 + 2], v[i * 8 + 3]); ov.z = pk2(v[i * 8 + 4], v[i * 8 + 5]); ov.w = pk2(v[i * 8 + 6], v[i * 8 + 7]); *(u32x4*)(dst + i * 8) = ov; }
}
DI float sumsq8(u32x4 w) { const unsigned ww[4] = {w.x, w.y, w.z, w.w}; float ss = 0.f;
#pragma unroll
    for (int j = 0; j < 4; ++j) { const float a = bflo(ww[j]), b = bfhi(ww[j]); ss += a * a; ss += b * b; }
    return ss; }
DI void unpack8(u32x4 w, float* v, float mul) { const unsigned ww[4] = {w.x, w.y, w.z, w.w};
#pragma unroll
    for (int j = 0; j < 4; ++j) { v[2 * j] = bflo(ww[j]) * mul; v[2 * j + 1] = bfhi(ww[j]) * mul; } }
DI u32x4 pack8(const float* v) { u32x4 o; o.x = pk2(v[0], v[1]); o.y = pk2(v[2], v[3]); o.z = pk2(v[4], v[5]); o.w = pk2(v[6], v[7]); return o; }
DI float red8(float v) { v += __shfl_xor(v, 1); v += __shfl_xor(v, 2); v += __shfl_xor(v, 4); return v; }

DI void prep_body(const Params& p, int l, LAS unsigned char* ldsb,
                  const bf16_t* __restrict__ PROJ, const bf16_t* __restrict__ QRAW, const bf16_t* __restrict__ KVRAW,
                  bf16_t* __restrict__ QM, bf16_t* __restrict__ KM, bf16_t* __restrict__ VTM, bf16_t* __restrict__ QD, bf16_t* __restrict__ KD, bf16_t* __restrict__ VTD, bf16_t* __restrict__ Y2,
                  const float* __restrict__ TABM, const float* __restrict__ TABD, const float* __restrict__ cw) {
    const int tid = tidx(), wid = tid >> 6, lane = tid & 63, hd = lane >> 3, s = lane & 7;
    const float qsm = 0.10206207261596577f * LOG2E, qsd = 0.125f * LOG2E;
    LAS float* gl = (LAS float*)ldsb;
    if (tid < 96) { const int q = tid - 64, pp = q >> 1, hh = q & 1; const int orig = tid < 64 ? tid : 64 + 16 * (pp >> 3) + 8 * hh + (pp & 7);
        gl[tid] = p.in[16][l * 96 + orig]; gl[96 + tid] = p.in[17][l * 96 + orig]; }
    if (tid < 64) { const int pp = tid >> 1, hh = tid & 1, orig = 32 * (pp >> 4) + 16 * hh + (pp & 15);
        gl[192 + tid] = p.in[18][l * 64 + orig]; gl[256 + tid] = p.in[19][l * 64 + orig]; }
    __syncthreads();
    float gqn[8], gqr[4], gkn[8], gkr[4], gdq[8], gdk[8];
#pragma unroll
    for (int j = 0; j < 8; ++j) { gqn[j] = gl[8 * s + j]; gkn[j] = gl[96 + 8 * s + j]; gdq[j] = gl[192 + 8 * s + j]; gdk[j] = gl[256 + 8 * s + j]; }
#pragma unroll
    for (int j = 0; j < 4; ++j) { gqr[j] = gl[64 + 4 * s + j]; gkr[j] = gl[96 + 64 + 4 * s + j]; }
    __syncthreads();
    LAS unsigned char* Vl = ldsb;
#pragma unroll 1
    for (int item = blockIdx.x; item < 5 * (MT / 64); item += gridDim.x) {
        const int type = item / (MT / 64), blk = item - type * (MT / 64);
        const int r0 = blk * 64; int b, t0, spos0, seglen; bool latent;
        if (r0 < ML) { b = r0 >> 11; spos0 = r0 & 2047; t0 = 256 + spos0; latent = true; seglen = 2048; }
        else { const int rc = r0 - ML; b = rc >> 8; spos0 = rc & 255; t0 = spos0; latent = false; seglen = 256; }
        if (type == 0) {
#pragma unroll 1
            for (int kb4 = 0; kb4 < 8; kb4 += 4) {
                float s1[4], s2[4]; u32x4 wqn[4], wkn[4]; u32x2 wqr[4], wkr[4]; f32x2 cm[4], sm[4];
#pragma unroll
            for (int k = 0; k < 4; ++k) {
                const int tl = wid * 8 + kb4 + k, r = r0 + tl, t = t0 + tl, spos = spos0 + tl;
                const bf16_t* prow = PROJ + (size_t)r * INWP;
                s1[k] = sumsq8(*(const u32x4*)(prow + O_CQ + (lane < 48 ? lane : 0) * 8)); s1[k] = lane < 48 ? s1[k] : 0.f;
                s2[k] = sumsq8(*(const u32x4*)(prow + O_CKV + (lane < 32 ? lane : 0) * 8)); s2[k] = lane < 32 ? s2[k] : 0.f;
                wqn[k] = *(const u32x4*)(QRAW + (size_t)r * 768 + hd * 96 + 8 * s);
                wqr[k] = *(const u32x2*)(QRAW + (size_t)r * 768 + hd * 96 + 64 + 4 * s);
                wkn[k] = *(const u32x4*)(KVRAW + (size_t)r * 1024 + hd * 128 + 8 * s);
                wkr[k] = *(const u32x2*)(prow + O_KR + 4 * s);
                cm[k] = *(const f32x2*)(TABM + (latent ? spos : 0) * 32 + 2 * s); sm[k] = *(const f32x2*)(TABM + (latent ? spos : 0) * 32 + 16 + 2 * s);
                cm[k][0] = latent ? cm[k][0] : 1.f; cm[k][1] = latent ? cm[k][1] : 1.f; sm[k][0] = latent ? sm[k][0] : 0.f; sm[k][1] = latent ? sm[k][1] : 0.f;
            }
#pragma unroll
            for (int k = 0; k < 4; ++k) {
                const int tl = wid * 8 + kb4 + k, r = r0 + tl, t = t0 + tl; (void)r;
                s1[k] = wave_sum(s1[k]); s2[k] = wave_sum(s2[k]);
                const float rcq = rsqrtf(s1[k] * (1.0f / 384.0f) + EPS), rckv = rsqrtf(s2[k] * (1.0f / 256.0f) + EPS);
                { float vn[8], vr[4]; unpack8(wqn[k], vn, rcq); vr[0] = bflo(wqr[k].x) * rcq; vr[1] = bfhi(wqr[k].x) * rcq; vr[2] = bflo(wqr[k].y) * rcq; vr[3] = bfhi(wqr[k].y) * rcq;
                  float ss = vr[0] * vr[0] + vr[1] * vr[1] + vr[2] * vr[2] + vr[3] * vr[3];
#pragma unroll
                  for (int j = 0; j < 8; ++j) ss += vn[j] * vn[j];
                  ss = red8(ss); const float mul = rsqrtf(ss * (1.0f / 96.0f) + EPS) * qsm;
#pragma unroll
                  for (int j = 0; j < 8; ++j) vn[j] *= mul * gqn[j];
#pragma unroll
                  for (int j = 0; j < 4; ++j) vr[j] *= mul * gqr[j];
                  const float a0 = vr[0] * cm[k][0] - vr[1] * sm[k][0], a1 = vr[1] * cm[k][0] + vr[0] * sm[k][0], a2 = vr[2] * cm[k][1] - vr[3] * sm[k][1], a3 = vr[3] * cm[k][1] + vr[2] * sm[k][1];
                  bf16_t* d = QM + ((size_t)(b * 8 + hd) * TT + t) * 96;
                  *(u32x4*)(d + 8 * s) = pack8(vn); u32x2 o; o.x = pk2(a0, a1); o.y = pk2(a2, a3); *(u32x2*)(d + 64 + 4 * s) = o; }
                { float vn[8], vr[4]; unpack8(wkn[k], vn, rckv); vr[0] = bflo(wkr[k].x); vr[1] = bfhi(wkr[k].x); vr[2] = bflo(wkr[k].y); vr[3] = bfhi(wkr[k].y);
                  float ss = vr[0] * vr[0] + vr[1] * vr[1] + vr[2] * vr[2] + vr[3] * vr[3];
#pragma unroll
                  for (int j = 0; j < 8; ++j) ss += vn[j] * vn[j];
                  ss = red8(ss); const float mul = rsqrtf(ss * (1.0f / 96.0f) + EPS);
#pragma unroll
                  for (int j = 0; j < 8; ++j) vn[j] *= mul * gkn[j];
#pragma unroll
                  for (int j = 0; j < 4; ++j) vr[j] *= mul * gkr[j];
                  const float a0 = vr[0] * cm[k][0] - vr[1] * sm[k][0], a1 = vr[1] * cm[k][0] + vr[0] * sm[k][0], a2 = vr[2] * cm[k][1] - vr[3] * sm[k][1], a3 = vr[3] * cm[k][1] + vr[2] * sm[k][1];
                  bf16_t* d = KM + ((size_t)(b * 8 + hd) * TT + t) * 96;
                  *(u32x4*)(d + 8 * s) = pack8(vn); u32x2 o; o.x = pk2(a0, a1); o.y = pk2(a2, a3); *(u32x2*)(d + 64 + 4 * s) = o; }
            }
            }
        } else if (type == 1) {
#pragma unroll 1
            for (int kb4 = 0; kb4 < 8; kb4 += 4) {
                u32x4 wdq[4], wdk[4]; f32x4 cd[4], sd[4];
#pragma unroll
                for (int k = 0; k < 4; ++k) { const int tl = wid * 8 + kb4 + k, r = r0 + tl, spos = spos0 + tl;
                    const bf16_t* prow = PROJ + (size_t)r * INWP;
                    wdq[k] = *(const u32x4*)(prow + O_DQ + lane * 8); wdk[k] = *(const u32x4*)(prow + O_DK + lane * 8);
                    cd[k] = *(const f32x4*)(TABD + (latent ? spos : 0) * 64 + 4 * s); sd[k] = *(const f32x4*)(TABD + (latent ? spos : 0) * 64 + 32 + 4 * s); }
#pragma unroll
                for (int k = 0; k < 4; ++k) { const int tl = wid * 8 + kb4 + k, t = t0 + tl;
#pragma unroll
                    for (int j = 0; j < 4; ++j) { cd[k][j] = latent ? cd[k][j] : 1.f; sd[k][j] = latent ? sd[k][j] : 0.f; }
#pragma unroll
                    for (int qk = 0; qk < 2; ++qk) { float v[8]; unpack8(qk ? wdk[k] : wdq[k], v, 1.0f); float ss = 0.f;
#pragma unroll
                      for (int j = 0; j < 8; ++j) ss += v[j] * v[j];
                      ss = red8(ss); const float mul = rsqrtf(ss * (1.0f / 64.0f) + EPS) * (qk ? 1.0f : qsd);
#pragma unroll
                      for (int j = 0; j < 8; ++j) v[j] *= mul * (qk ? gdk[j] : gdq[j]);
                      float o[8];
#pragma unroll
                      for (int jj = 0; jj < 4; ++jj) { o[2 * jj] = v[2 * jj] * cd[k][jj] - v[2 * jj + 1] * sd[k][jj]; o[2 * jj + 1] = v[2 * jj + 1] * cd[k][jj] + v[2 * jj] * sd[k][jj]; }
                      bf16_t* d = (qk ? KD : QD) + ((size_t)(b * 8 + hd) * TT + t) * 64 + 8 * s;
                      *(u32x4*)d = pack8(o); }
                }
            }
        } else if (type < 4) {
#pragma unroll 4
            for (int k = 0; k < 8; ++k) {
                const int tl = wid * 8 + k, r = r0 + tl;
                const bf16_t* prow = PROJ + (size_t)r * INWP;
                const bool mla = (type == 2);
                float s2 = sumsq8(*(const u32x4*)(prow + O_CKV + (lane < 32 ? lane : 0) * 8)); s2 = lane < 32 ? s2 : 0.f;
                const bf16_t* wsrc = mla ? KVRAW + (size_t)r * 1024 + hd * 128 + 64 + 8 * s : prow + O_DV + lane * 8;
                const u32x4 w = *(const u32x4*)wsrc;
                s2 = wave_sum(s2); const float sc = mla ? rsqrtf(s2 * (1.0f / 256.0f) + EPS) : 1.0f;
                float v[8]; unpack8(w, v, sc);
                const u32x4 o = pack8(v); const unsigned ow[4] = {o.x, o.y, o.z, o.w};
                LAS bf16_t* dl = (LAS bf16_t*)(Vl + (size_t)(hd * 64 + 8 * s) * 144) + tl;
#pragma unroll
                for (int j = 0; j < 4; ++j) { dl[(2 * j) * 72] = (bf16_t)(ow[j] & 0xffffu); dl[(2 * j + 1) * 72] = (bf16_t)(ow[j] >> 16); }
            }
            __syncthreads();
            { bf16_t* VT = type == 2 ? VTM : VTD;
#pragma unroll
              for (int kk = 0; kk < 8; ++kk) { const int row = (tid >> 3) + 64 * kk, ch = tid & 7;
                  const u32x4 w = *(LAS const u32x4*)(Vl + row * 144 + ch * 16);
                  *(u32x4*)(VT + ((size_t)(b * 512 + row) * TT + t0 + ch * 8)) = w; } }
            __syncthreads();
        } else {
            float w0[8], w1[8], w2[8];
            { const f32x4 a = *(const f32x4*)(cw + lane * 8), a2 = *(const f32x4*)(cw + lane * 8 + 4), b1 = *(const f32x4*)(cw + 512 + lane * 8), b2 = *(const f32x4*)(cw + 512 + lane * 8 + 4),
                          c1 = *(const f32x4*)(cw + 1024 + lane * 8), c2 = *(const f32x4*)(cw + 1024 + lane * 8 + 4);
#pragma unroll
              for (int j = 0; j < 4; ++j) { w0[j] = a[j]; w0[4 + j] = a2[j]; w1[j] = b1[j]; w1[4 + j] = b2[j]; w2[j] = c1[j]; w2[4 + j] = c2[j]; } }
            const int rf = r0 + wid * 8, sf = spos0 + wid * 8;
            const bf16_t* pb = PROJ + (size_t)rf * INWP + lane * 8;
            float up[8], uc[8];
#pragma unroll
            for (int j = 0; j < 8; ++j) up[j] = 0.f;
            { const bool hasp = sf > 0; const bf16_t* pp = hasp ? pb - (size_t)INWP : pb;
              float a[8], c[8]; unpack8(*(const u32x4*)(pp + O_CC), a, 1.0f); unpack8(*(const u32x4*)(pp + O_CX), c, 1.0f);
#pragma unroll
              for (int j = 0; j < 8; ++j) up[j] = hasp ? a[j] * c[j] : 0.f; }
            { float a[8], c[8]; unpack8(*(const u32x4*)(pb + O_CC), a, 1.0f); unpack8(*(const u32x4*)(pb + O_CX), c, 1.0f);
#pragma unroll
              for (int j = 0; j < 8; ++j) uc[j] = a[j] * c[j]; }
#pragma unroll
            for (int k = 0; k < 8; ++k) { const bf16_t* q = pb + (size_t)k * INWP;
                float un[8];
                { const bool hasn = sf + k + 1 < seglen; const bf16_t* qn = hasn ? q + INWP : q;
                  float a[8], c[8]; unpack8(*(const u32x4*)(qn + O_CC), a, 1.0f); unpack8(*(const u32x4*)(qn + O_CX), c, 1.0f);
#pragma unroll
                  for (int j = 0; j < 8; ++j) un[j] = hasn ? a[j] * c[j] : 0.f; }
                float cb[8]; unpack8(*(const u32x4*)(q + O_CB), cb, 1.0f);
                float y[8];
#pragma unroll
                for (int j = 0; j < 8; ++j) y[j] = cb[j] * (w0[j] * up[j] + w1[j] * uc[j] + w2[j] * un[j]);
                *(u32x4*)(Y2 + (size_t)(rf + k) * 1536 + lane * 8) = pack8(y);
#pragma unroll
                for (int j = 0; j < 8; ++j) { up[j] = uc[j]; uc[j] = un[j]; } }
        }
    }
}

DI void prep_phase(const Params& p, int l, LAS unsigned char* ldsb) {
    const float* TABM = (const float*)(p.ws + WS_TAB);
    prep_body(p, l, ldsb, (const bf16_t*)(p.ws + WS_PROJ), (const bf16_t*)(p.ws + WS_R1), (const bf16_t*)(p.ws + WS_R1 + R1_KVRAW),
              (bf16_t*)(p.ws + WS_QKV + Q_QM), (bf16_t*)(p.ws + WS_QKV + Q_KM), (bf16_t*)(p.ws + WS_QKV + Q_VTM), (bf16_t*)(p.ws + WS_QKV + Q_QD), (bf16_t*)(p.ws + WS_QKV + Q_KD), (bf16_t*)(p.ws + WS_QKV + Q_VTD),
              (bf16_t*)(p.ws + WS_Y) + 1024, TABM, TABM + 2048 * 32, p.in[22] + (size_t)l * 3 * 512);
}

template <int KC, int DS, bool DIFF>
DI void attn_item(LAS unsigned char* lds, const bf16_t* Qw  , const bf16_t* K0, const bf16_t* K1, const bf16_t* Vt, int nkeys, float cshift,
                  f32x4 (&oacc)[DS][2], float (&lsum)[2]) {
    constexpr int DK = KC * 32, KROW = DK * 2 + 32, VROW = 160, DV = DS * 16;
    constexpr int KBYTES = (DIFF ? 2 : 1) * 64 * KROW, STG = KBYTES + DV * VROW;
    const int tid = tidx(), wid = tid >> 6, lane = tid & 63, fr = lane & 15, fq = lane >> 4;
    const int comp = DIFF ? (wid >> 2) : 0;
    const int vpos = (((tid & 7) >> 2) * 32 + (tid & 1) * 16 + ((tid >> 1) & 1) * 4) * 2;
    bf16x8 qf[2][KC];
#pragma unroll
    for (int qs = 0; qs < 2; ++qs)
#pragma unroll
        for (int kc = 0; kc < KC; ++kc) qf[qs][kc] = *(const bf16x8*)(Qw + (size_t)(qs * 16 + fr) * DK + kc * 32 + fq * 8);
#pragma unroll
    for (int ds = 0; ds < DS; ++ds) { oacc[ds][0] = (f32x4){0.f, 0.f, 0.f, 0.f}; oacc[ds][1] = (f32x4){0.f, 0.f, 0.f, 0.f}; }
    lsum[0] = 0.f; lsum[1] = 0.f;
    u32x4 rk0, rk1, rv0, rv1;
    auto gload = [&](int t) {
        if constexpr (!DIFF) {
            const char* kb = (const char*)K0 + (size_t)t * 64 * DK * 2;
            rk0 = *(const u32x4*)(kb + tid * 16);
            if (tid < 256) rk1 = *(const u32x4*)(kb + (512 + tid) * 16);
            rv0 = *(const u32x4*)((const char*)Vt + (size_t)(tid >> 3) * TT * 2 + (size_t)t * 128 + (tid & 7) * 16);
        } else {
            rk0 = *(const u32x4*)((const char*)K0 + (size_t)t * 64 * DK * 2 + tid * 16);
            rk1 = *(const u32x4*)((const char*)K1 + (size_t)t * 64 * DK * 2 + tid * 16);
            rv0 = *(const u32x4*)((const char*)Vt + (size_t)(tid >> 3) * TT * 2 + (size_t)t * 128 + (tid & 7) * 16);
            rv1 = *(const u32x4*)((const char*)Vt + (size_t)(64 + (tid >> 3)) * TT * 2 + (size_t)t * 128 + (tid & 7) * 16);
        }
    };
    auto lstore = [&](int st) {
        LAS unsigned char* kb = lds + st * STG; LAS unsigned char* vb = kb + KBYTES;
        if constexpr (!DIFF) {
            { const int key = tid / 12, pc = tid - key * 12; *(LAS u32x4*)(kb + key * KROW + pc * 16) = rk0; }
            if (tid < 256) { const int c = 512 + tid, key = c / 12, pc = c - key * 12; *(LAS u32x4*)(kb + key * KROW + pc * 16) = rk1; }
            { LAS unsigned char* d = vb + (tid >> 3) * VROW + vpos; *(LAS u32x2*)d = (u32x2){rv0.x, rv0.y}; *(LAS u32x2*)(d + 16) = (u32x2){rv0.z, rv0.w}; }
        } else {
            *(LAS u32x4*)(kb + (tid >> 3) * KROW + (tid & 7) * 16) = rk0;
            *(LAS u32x4*)(kb + 64 * KROW + (tid >> 3) * KROW + (tid & 7) * 16) = rk1;
            { LAS unsigned char* d = vb + (tid >> 3) * VROW + vpos; *(LAS u32x2*)d = (u32x2){rv0.x, rv0.y}; *(LAS u32x2*)(d + 16) = (u32x2){rv0.z, rv0.w}; }
            { LAS unsigned char* d = vb + (64 + (tid >> 3)) * VROW + vpos; *(LAS u32x2*)d = (u32x2){rv1.x, rv1.y}; *(LAS u32x2*)(d + 16) = (u32x2){rv1.z, rv1.w}; }
        }
    };
    auto readK = [&](int st, int kk, bf16x8 (&kf)[2][KC]) {
        LAS const unsigned char* kb = lds + st * STG + comp * 64 * KROW;
#pragma unroll
        for (int kc = 0; kc < KC; ++kc)
#pragma unroll
            for (int ks = 0; ks < 2; ++ks) kf[ks][kc] = *(LAS const bf16x8*)(kb + ((2 * kk + ks) * 16 + fr) * KROW + (kc * 32 + fq * 8) * 2);
    };
    auto readV = [&](int st, int kk, int d0, bf16x8 (&vf)[4]) {
        LAS const unsigned char* vb = lds + st * STG + KBYTES;
#pragma unroll
        for (int i = 0; i < 4; ++i) vf[i] = *(LAS const bf16x8*)(vb + ((d0 + i) * 16 + fr) * VROW + (kk * 32 + fq * 8) * 2);
    };
    auto smma = [&](const bf16x8 (&kf)[2][KC], f32x4 (&sacc)[2][2]) {
#pragma unroll
        for (int ks = 0; ks < 2; ++ks) { sacc[ks][0] = (f32x4){-cshift, -cshift, -cshift, -cshift}; sacc[ks][1] = (f32x4){-cshift, -cshift, -cshift, -cshift}; }
#pragma unroll
        for (int kc = 0; kc < KC; ++kc)
#pragma unroll
            for (int ks = 0; ks < 2; ++ks)
#pragma unroll
                for (int qs = 0; qs < 2; ++qs) sacc[ks][qs] = __builtin_amdgcn_mfma_f32_16x16x32_bf16(kf[ks][kc], qf[qs][kc], sacc[ks][qs], 0, 0, 0);
    };
    auto softmax = [&](const f32x4 (&sacc)[2][2], bf16x8 (&pb)[2]) {
#pragma unroll
        for (int qs = 0; qs < 2; ++qs) {
            float e[8];
#pragma unroll
            for (int j = 0; j < 4; ++j) { e[j] = __builtin_amdgcn_exp2f(sacc[0][qs][j]); e[4 + j] = __builtin_amdgcn_exp2f(sacc[1][qs][j]); }
            lsum[qs] += ((e[0] + e[1]) + (e[2] + e[3])) + ((e[4] + e[5]) + (e[6] + e[7]));
            u32x4 w; w.x = pk2(e[0], e[1]); w.y = pk2(e[2], e[3]); w.z = pk2(e[4], e[5]); w.w = pk2(e[6], e[7]);
            pb[qs] = __builtin_bit_cast(bf16x8, w);
        }
    };
    auto pv4 = [&](const bf16x8 (&vf)[4], int d0, const bf16x8 (&pb)[2]) {
#pragma unroll
        for (int i = 0; i < 4; ++i)
#pragma unroll
            for (int qs = 0; qs < 2; ++qs) oacc[d0 + i][qs] = __builtin_amdgcn_mfma_f32_16x16x32_bf16(vf[i], pb[qs], oacc[d0 + i][qs], 0, 0, 0);
    };
#define SB() __builtin_amdgcn_sched_barrier(0)
    const int ntiles = nkeys >> 6;
    if constexpr (!DIFF) {
        gload(0); lstore(0); gload(1); lstore(1);
        __syncthreads();
        f32x4 sA[2][2], sB[2][2]; bf16x8 pb[2]; bf16x8 kf[2][KC]; bf16x8 vf[4];
        readK(0, 0, kf); smma(kf, sA);
        int st = 0;
        auto iter = [&](auto m1c, auto m2c, int t) {
            constexpr bool m1 = decltype(m1c)::value, m2 = decltype(m2c)::value;
            const int st1 = (st == 2) ? 0 : st + 1, st2 = (st1 == 2) ? 0 : st1 + 1;
            if constexpr (m2) gload(t + 2);
            readK(st, 1, kf); readV(st, 0, 0, vf); SB();
            smma(kf, sB); softmax(sA, pb);
            pv4(vf, 0, pb); SB();
            if constexpr (m1) readK(st1, 0, kf);
            readV(st, 1, 0, vf); SB();
            if constexpr (m1) smma(kf, sA);
            softmax(sB, pb);
            pv4(vf, 0, pb); SB();
            if constexpr (m2) lstore(st2);
            __syncthreads();
            st = st1;
        };
#pragma unroll 1
        for (int t = 0; t + 2 < ntiles; ++t) iter(std::true_type{}, std::true_type{}, t);
        iter(std::true_type{}, std::false_type{}, ntiles - 2);
        iter(std::false_type{}, std::false_type{}, ntiles - 1);
    } else {
        gload(0); lstore(0);
        __syncthreads();
        f32x4 sA[2][2]; bf16x8 pb[2]; bf16x8 kf[2][KC]; bf16x8 vf[4], vg[4];
        auto iter = [&](auto morec, int t) {
            constexpr bool more = decltype(morec)::value;
            const int st = t & 1;
            if constexpr (more) gload(t + 1);
#pragma unroll
            for (int kk = 0; kk < 2; ++kk) {
                readK(st, kk, kf); readV(st, kk, 0, vf); SB();
                smma(kf, sA); softmax(sA, pb); readV(st, kk, 4, vg);
                pv4(vf, 0, pb);
                pv4(vg, 4, pb); SB();
            }
            if constexpr (more) lstore((t + 1) & 1);
            __syncthreads();
        };
#pragma unroll 1
        for (int t = 0; t + 1 < ntiles; ++t) iter(std::true_type{}, t);
        iter(std::false_type{}, ntiles - 1);
    }
#undef SB
#pragma unroll
    for (int qs = 0; qs < 2; ++qs) { lsum[qs] += __shfl_xor(lsum[qs], 16); lsum[qs] += __shfl_xor(lsum[qs], 32); }
}

DI void attn_phase(const Params& p, int l, bool need_ctx, LAS unsigned char* lds) {
    const int tid = tidx(), wid = tid >> 6, lane = tid & 63, fr = lane & 15, fq = lane >> 4;
    const bf16_t* QM = (const bf16_t*)(p.ws + WS_QKV + Q_QM); const bf16_t* KM = (const bf16_t*)(p.ws + WS_QKV + Q_KM); const bf16_t* VTM = (const bf16_t*)(p.ws + WS_QKV + Q_VTM);
    const bf16_t* QD = (const bf16_t*)(p.ws + WS_QKV + Q_QD); const bf16_t* KD = (const bf16_t*)(p.ws + WS_QKV + Q_KD); const bf16_t* VTD = (const bf16_t*)(p.ws + WS_QKV + Q_VTD);
    bf16_t* Y0 = (bf16_t*)(p.ws + WS_Y); bf16_t* Y1 = Y0 + 512;
    float gq = 0.f, gk = 0.f;
    { const float a = lane < 48 ? fmaxf(fabsf(p.in[16][l * 96 + lane]), fabsf(p.in[16][l * 96 + 48 + lane])) : 0.f; gq = wave_max(a);
      const float b = lane < 48 ? fmaxf(fabsf(p.in[17][l * 96 + lane]), fabsf(p.in[17][l * 96 + 48 + lane])) : 0.f; gk = wave_max(b); }
    const float cs_m = gq * gk * 9.797958971132712f * LOG2E;
    { gq = wave_max(fabsf(p.in[18][l * 64 + lane])); gk = wave_max(fabsf(p.in[19][l * 64 + lane])); }
    const float cs_d = gq * gk * 8.0f * LOG2E;
    const float li = lam_init_of(l);
    float lam;
    { const float* lv = p.in[20] + (size_t)l * 256; const float s1 = wave_sum(lv[lane] * lv[64 + lane]), s2 = wave_sum(lv[128 + lane] * lv[192 + lane]); lam = expf(s1) - expf(s2) + li; }
    const float* gsub = p.in[21] + l * 128;
    const int first = need_ctx ? 0 : 128;
    for (int item = first + blockIdx.x; item < 1152; item += gridDim.x) {
        if (item < 64 || (item >= 128 && item < 640)) {
            int bh, tq0, nkeys;
            if (item < 64) { bh = item; tq0 = 0; nkeys = 256; } else { const int i = item - 128; bh = (i >> 8) * 32 + (i & 31); tq0 = 256 + ((i >> 5) & 7) * 256; nkeys = TT; }
            const int b = bh >> 3, h = bh & 7;
            f32x4 oacc[4][2]; float lsum[2];
            attn_item<3, 4, false>(lds, QM + ((size_t)bh * TT + tq0 + wid * 32) * 96, KM + (size_t)bh * TT * 96, nullptr, VTM + (size_t)bh * 64 * TT, nkeys, cs_m, oacc, lsum);
#pragma unroll
            for (int qs = 0; qs < 2; ++qs) { const float inv = 1.0f / lsum[qs]; const int tq = tq0 + wid * 32 + qs * 16 + fr;
                const size_t row = tq >= 256 ? (size_t)b * 2048 + (tq - 256) : (size_t)ML + b * 256 + tq;
#pragma unroll
                for (int ds = 0; ds < 4; ++ds) { const f32x4 o = oacc[ds][qs] * inv; u32x2 w; w.x = pk2(o[0], o[1]); w.y = pk2(o[2], o[3]);
                    *(u32x2*)(Y0 + row * 1536 + h * 64 + ds * 16 + fq * 4) = w; } }
        } else {
            int bh, tq0, nkeys;
            if (item < 128) { const int i = item - 64; bh = i & 31; tq0 = (i >> 5) * 128; nkeys = 256; } else { const int i = item - 640; bh = (i >> 8) * 16 + (i & 15); tq0 = 256 + ((i >> 4) & 15) * 128; nkeys = TT; }
            const int b = bh >> 2, h = bh & 3, comp = wid >> 2, wq = wid & 3;
            f32x4 oacc[8][2]; float lsum[2];
            const size_t kvec = (size_t)(bh * 2) * TT * 64;
            attn_item<2, 8, true>(lds, QD + ((size_t)(bh * 2 + comp) * TT + tq0 + wq * 32) * 64, KD + kvec, KD + kvec + (size_t)TT * 64, VTD + (size_t)bh * 128 * TT, nkeys, cs_d, oacc, lsum);
            LAS float* X = (LAS float*)lds;
            if (comp == 1) {
#pragma unroll
                for (int qs = 0; qs < 2; ++qs) { const float sc = lam / lsum[qs]; const int ql = wq * 32 + qs * 16 + fr;
#pragma unroll
                    for (int ds = 0; ds < 8; ++ds) *(LAS f32x4*)(X + ql * 132 + ds * 16 + fq * 4) = oacc[ds][qs] * sc; }
            }
            __syncthreads();
            if (comp == 0) {
#pragma unroll
                for (int qs = 0; qs < 2; ++qs) { const float inv = 1.0f / lsum[qs]; const int ql = wq * 32 + qs * 16 + fr; const int tq = tq0 + ql;
                    float ss = 0.f;
#pragma unroll
                    for (int ds = 0; ds < 8; ++ds) { const f32x4 o2 = *(LAS const f32x4*)(X + ql * 132 + ds * 16 + fq * 4); const f32x4 o = oacc[ds][qs] * inv - o2; oacc[ds][qs] = o;
                        ss += o[0] * o[0] + o[1] * o[1] + o[2] * o[2] + o[3] * o[3]; }
                    ss += __shfl_xor(ss, 16); ss += __shfl_xor(ss, 32);
                    const float rs = rsqrtf(ss * (1.0f / 128.0f) + EPS) * (1.0f - li);
                    const size_t row = tq >= 256 ? (size_t)b * 2048 + (tq - 256) : (size_t)ML + b * 256 + tq;
#pragma unroll
                    for (int ds = 0; ds < 8; ++ds) { const f32x4 gg = *(const f32x4*)(gsub + ds * 16 + fq * 4); const f32x4 o = oacc[ds][qs] * rs * gg;
                        u32x2 w; w.x = pk2(o[0], o[1]); w.y = pk2(o[2], o[3]);
                        *(u32x2*)(Y1 + row * 1536 + h * 128 + ds * 16 + fq * 4) = w; } }
            }
            __syncthreads();
        }
    }
}

#define XB_TMO      128
#define XB_XCNT(j)  (256  + 64 * (j))
#define XB_XSUB(j)  (1280 + 64 * (j))
#define XB_XGEN(j)  (2304 + 64 * (j))
#define XB_TOP      3328
#define XB_TOPGEN   3392
#define XCD_BAR_WORDS 3456
#define XB_SPIN_CAP (1u << 18)
DI unsigned xb_ld(unsigned* p) { return __hip_atomic_load(p, __ATOMIC_RELAXED, __HIP_MEMORY_SCOPE_AGENT); }
DI unsigned xb_add(unsigned* p, unsigned v) { return __hip_atomic_fetch_add(p, v, __ATOMIC_RELAXED, __HIP_MEMORY_SCOPE_AGENT); }
DI unsigned xb_xcc_id() { return (unsigned)__builtin_amdgcn_s_getreg((3 << 11) | 20) & 0xFu; }
#define XB_SPIN(cond, bar) do { unsigned _sp = 0; while (cond) { __builtin_amdgcn_s_sleep(1); \
    if ((++_sp & 255u) == 0u) { if (xb_ld(&(bar)[XB_TMO])) break; if (_sp > XB_SPIN_CAP) { atomicAdd(&(bar)[XB_TMO], 1u); break; } } } } while (0)
struct XcdBarrier { unsigned* bar; unsigned x; volatile LAS unsigned* st; };
DI XcdBarrier xcd_barrier_post(unsigned* bar, volatile LAS unsigned* st) {
    XcdBarrier b; b.bar = bar; b.x = xb_xcc_id(); b.st = st;
    if (threadIdx.x == 0) (void)xb_add(&bar[XB_XCNT(b.x)], 1u);
    return b;
}
DI void xcd_barrier_complete(unsigned* bar, unsigned x, unsigned& nloc, unsigned& nx) {
    const unsigned G = gridDim.x * gridDim.y * gridDim.z;
    unsigned sum, cnt, mine, sp = 0u;
    for (;;) {
        sum = 0u; cnt = 0u; mine = 0u;
#pragma unroll
        for (unsigned j = 0; j < 16; ++j) { const unsigned c = xb_ld(&bar[XB_XCNT(j)]); sum += c; cnt += (c > 0u) ? 1u : 0u; mine = (j == x) ? c : mine; }
        if (sum == G) break;
        __builtin_amdgcn_s_sleep(1);
        if ((++sp & 255u) == 0u) { if (xb_ld(&bar[XB_TMO])) break; if (sp > XB_SPIN_CAP) { atomicAdd(&bar[XB_TMO], 1u); break; } }
    }
    nloc = mine > 0u ? mine : 1u; nx = cnt > 0u ? cnt : 1u;
}
DI void xcd_barrier(const XcdBarrier& b) {
    asm volatile("s_waitcnt vmcnt(0)" ::: "memory");
    __syncthreads();
    if (threadIdx.x == 0) {
        unsigned* bar = b.bar;
        __builtin_amdgcn_s_waitcnt(0);
        unsigned nloc = b.st[0], nx = b.st[1];
        if (nloc == 0u) { xcd_barrier_complete(bar, b.x, nloc, nx); b.st[0] = nloc; b.st[1] = nx; }
        const unsigned old = xb_add(&bar[XB_XSUB(b.x)], 1u);
        const unsigned gen = old / nloc;
        if (old + 1u == (gen + 1u) * nloc) {
            __builtin_amdgcn_fence(__ATOMIC_RELEASE, "agent");
            asm volatile("s_waitcnt vmcnt(0)" ::: "memory");
            const unsigned og = xb_add(&bar[XB_TOP], 1u);
            const unsigned tg = og / nx;
            if (og + 1u == (tg + 1u) * nx) xb_add(&bar[XB_TOPGEN], 1u);
            else XB_SPIN(xb_ld(&bar[XB_TOPGEN]) == tg, bar);
            __builtin_amdgcn_fence(__ATOMIC_ACQUIRE, "agent");
            xb_add(&bar[XB_XGEN(b.x)], 1u);
            asm volatile("s_waitcnt vmcnt(0)" ::: "memory");
        } else {
            XB_SPIN(xb_ld(&bar[XB_XGEN(b.x)]) == gen, bar);
            __builtin_amdgcn_fence(__ATOMIC_ACQUIRE, "agent");
            asm volatile("s_waitcnt vmcnt(0)" ::: "memory");
        }
    }
    __syncthreads();
}

#ifndef PROBE_MASK
#define PROBE_MASK 0
#endif
#define REPS(bit) for (int rep_ = 0; rep_ < (((PROBE_MASK) >> (bit)) & 1) + 1; ++rep_)
typedef const __attribute__((address_space(4))) Params* KP;
#define PH_BEGIN KP pp_ = (KP)__builtin_amdgcn_kernarg_segment_ptr(); asm volatile("" : "+s"(pp_)); const Params& p = *(const Params*)pp_; \
    int G = gridDim.x, c = blockIdx.x; asm volatile("" : "+s"(G), "+s"(c)); \
    float* XL = p.out; float* XC = (float*)(p.ws + WS_XC); const float* modl = (const float*)(p.ws + WS_MOD) + (size_t)l * 9 * 9216; const float* ng = p.in[6] + (size_t)l * 3 * 1024; \
    bf16_t* W = (bf16_t*)(p.ws + ((l & 1) ? WS_W2 : WS_W)); bf16_t* H = (bf16_t*)(p.ws + WS_R1); bf16_t* MB = H; bf16_t* QRAW = H; bf16_t* KVRAW = (bf16_t*)(p.ws + WS_R1 + R1_KVRAW); \
    bf16_t* PROJ = (bf16_t*)(p.ws + WS_PROJ); bf16_t* ACT = PROJ; float* MACC = (float*)(p.ws + WS_QKV); float* PART = MACC; bf16_t* Y = (bf16_t*)(p.ws + WS_Y); \
    (void)G; (void)c; (void)XL; (void)XC; (void)modl; (void)ng; (void)W; (void)H; (void)MB; (void)QRAW; (void)KVRAW; (void)PROJ; (void)ACT; (void)MACC; (void)Y; (void)PART;

__global__ void __launch_bounds__(512, 2) fwd_megakernel(Params p_unused) {
    extern __shared__ __attribute__((aligned(16))) unsigned char shm[];
    LAS unsigned char* lds = (LAS unsigned char*)shm;
    cg::grid_group grid = cg::this_grid();
    volatile LAS unsigned* xst = (volatile LAS unsigned*)(lds + pg8::STAGE_BYTES);
    if (threadIdx.x < 4) xst[threadIdx.x] = 0u;
    __syncthreads();
    XcdBarrier xb;
    { KP pp_ = (KP)__builtin_amdgcn_kernarg_segment_ptr(); xb = xcd_barrier_post((unsigned*)(pp_->ws + WS_BAR), xst); }
#define GSYNC() xcd_barrier(xb)

    REPS(6) { int l = 0; PH_BEGIN; mod_phase(p, lds); }
    { int l = 0; PH_BEGIN; tab_phase(p); }
    REPS(6) { int l = 0; PH_BEGIN; conv_weights(p, 0, lds, W, c, G); }
    grid.sync();

#pragma unroll 1
    for (int lq = 0; lq < DEPTH; ++lq) {
        int l = lq; asm volatile("" : "+s"(l));
        const bool last = (l == DEPTH - 1);
        const int Mx = last ? ML : MT;
        REPS(2) { PH_BEGIN; if (l == 0) norm_phase(p.in[0], p.in[2], XL, XC, true, H, ng, modl, 0, 1, MT, PART, 0); else norm_phase(XL, XC, XL, XC, false, H, ng, modl, 0, 1, MT, PART, 4); }
        GSYNC();
        REPS(1) { PH_BEGIN; pg8::Sched S; S.init(MT, 5632, 1024, G, c); pg8::Gemm g{H, W + W_1U, 1024, 1024}; EpiSwiglu E{ACT}; pg8::gemm_phase(lds, g, S, E); }
        GSYNC();
        { PH_BEGIN; pg8::Sched S; S.init(ML, 1024, DFF, G, c); S.add_split(MC / 256, ML / 256, 4); pg8::Gemm g{ACT, W + W_1D, DFF, DFF}; EpiResid E{XL, XC, modl, 2, 0.5f, PART}; pg8::gemm_phase(lds, g, S, E); }
        GSYNC();
        REPS(2) { PH_BEGIN; norm_phase(XL, XC, XL, XC, false, H, ng + 1024, modl, 3, 4, MT, PART, 4); }
        GSYNC();
        if (!last) { REPS(1) { PH_BEGIN; pg8::Sched S; S.init(MT, INWP, 1024, G, c); pg8::Gemm g{H, W + W_IN, 1024, 1024}; EpiStore E{PROJ, INWP, O_G}; pg8::gemm_phase(lds, g, S, E); } }
        else {
            { PH_BEGIN; pg8::Sched S; S.init(ML, INWP, 1024, G, c); pg8::Gemm g{H, W + W_IN, 1024, 1024}; EpiStore E{PROJ, INWP, O_G}; pg8::gemm_phase(lds, g, S, E); }
            { PH_BEGIN; pg8::Sched S; S.init(MC, 2048, 1024, G, (c + 64) % G); pg8::Gemm g{H + (size_t)ML * 1024, W + W_IN + (size_t)256 * 1024, 1024, 1024}; EpiStore E{PROJ + (size_t)ML * INWP + 256, INWP, 1 << 30}; pg8::gemm_phase(lds, g, S, E); }
        }
        GSYNC();
        REPS(2) { PH_BEGIN; pg8::Sched S; S.init(MT, 768, 384, G, c); pg8::Gemm g{PROJ + O_CQ, W + W_UQ, INWP, 384}; EpiStore E{QRAW, 768, 1 << 30}; pg8::gemm_phase(lds, g, S, E); }
        REPS(2) { PH_BEGIN; pg8::Sched S; S.init(MT, 1024, 256, G, (c + 40) % G); pg8::Gemm g{PROJ + O_CKV, W + W_UKV, INWP, 256}; EpiStore E{KVRAW, 1024, 1 << 30}; pg8::gemm_phase(lds, g, S, E); }
        GSYNC();
        REPS(2) { PH_BEGIN; prep_phase(p, l, lds); }
        GSYNC();
        REPS(0) { PH_BEGIN; attn_phase(p, l, !last, lds); }
        GSYNC();
        { PH_BEGIN; pg8::Sched S; S.init(Mx, 1024, 512, G, c, 3, 0, 0); S.kseg = 512; pg8::Gemm g{Y, W + W_BR, 1536, 1536}; EpiMerge E{MB, PROJ}; pg8::gemm_phase(lds, g, S, E);
          { int heavy = (MT / 256) * 4 - G; if (heavy < 0 || heavy >= G) heavy = 0;
            if (!last && c >= heavy) { bf16_t* Wn = (bf16_t*)(p.ws + (((l + 1) & 1) ? WS_W2 : WS_W)); conv_weights(p, l + 1, lds, Wn, c - heavy, G - heavy); } } }
        GSYNC();
        for (int r_ = 0; r_ < 6 * (((PROBE_MASK) >> 3) & 1); ++r_) GSYNC();
        { PH_BEGIN; pg8::Sched S; S.init(ML, 1024, 1024, G, c); if (!last) S.add_split(MC / 256, ML / 256, 4); pg8::Gemm g{MB, W + W_O, 1024, 1024}; EpiResid E{XL, XC, modl, 5, 1.0f, PART}; pg8::gemm_phase(lds, g, S, E); }
        GSYNC();
        REPS(2) { PH_BEGIN; norm_phase(XL, XC, XL, XC, false, H, ng + 2048, modl, 6, 7, Mx, PART, last ? 0 : 4); }
        GSYNC();
        REPS(1) { PH_BEGIN; pg8::Sched S; S.init(Mx, 5632, 1024, G, c); pg8::Gemm g{H, W + W_2U, 1024, 1024}; EpiSwiglu E{ACT}; pg8::gemm_phase(lds, g, S, E); }
        GSYNC();
        { PH_BEGIN; pg8::Sched S; S.init(ML, 1024, DFF, G, c); if (!last) S.add_split(MC / 256, ML / 256, 4); pg8::Gemm g{ACT, W + W_2D, DFF, DFF}; EpiResid E{XL, XC, modl, 8, 0.5f, PART}; pg8::gemm_phase(lds, g, S, E); }
        GSYNC();
    }
}

extern "C" void kernel_launch(void* const* d_in, const int* in_sizes, int n_in, void* d_out, int out_size, void* d_ws, size_t ws_size, hipStream_t stream) {
    constexpr int LDS_BYTES = pg8::STAGE_BYTES + 16;
    static int grid = 0;
    if (grid == 0) {
        if (n_in != 25 || ws_size < WS_END) { fprintf(stderr, "kernel_launch: bad inputs (n_in %d, ws %zu need %zu)\n", n_in, ws_size, (size_t)WS_END); grid = -1; return; }
        int dev = 0, cus = 0, per_cu = 0;
        hipGetDevice(&dev);
        hipDeviceGetAttribute(&cus, hipDeviceAttributeMultiprocessorCount, dev);
        hipFuncSetAttribute((const void*)fwd_megakernel, hipFuncAttributeMaxDynamicSharedMemorySize, LDS_BYTES);
        hipOccupancyMaxActiveBlocksPerMultiprocessor(&per_cu, (const void*)fwd_megakernel, 512, LDS_BYTES);
        if (per_cu < 1) per_cu = 1;
        (void)hipGetLastError();
        grid = cus;
    }
    if (grid < 0) return;
    Params p{};
    for (int i = 0; i < 25; ++i) p.in[i] = (const float*)d_in[i];
    p.out = (float*)d_out; p.ws = (unsigned char*)d_ws;
    (void)hipMemsetAsync((unsigned char*)d_ws + WS_BAR, 0, XCD_BAR_WORDS * 4, stream);
    void* args[] = {&p};
    hipError_t e = hipLaunchCooperativeKernel((const void*)fwd_megakernel, dim3(grid), dim3(512), args, LDS_BYTES, stream);
    if (e != hipSuccess) fprintf(stderr, "cooperative launch failed: %s (grid %d)\n", hipGetErrorString(e), grid);
}
```

```cpp
#include <hip/hip_runtime.h>
#include <hip/hip_cooperative_groups.h>
#include <cstdio>
#include <type_traits>
namespace cg = cooperative_groups;

#define LAS __attribute__((address_space(3)))
typedef unsigned short bf16_t;
typedef short bf16x8 __attribute__((ext_vector_type(8)));
typedef float f32x4 __attribute__((ext_vector_type(4)));
typedef float f32x2 __attribute__((ext_vector_type(2)));
typedef unsigned u32x4 __attribute__((ext_vector_type(4)));
typedef unsigned u32x2 __attribute__((ext_vector_type(2)));
typedef __bf16 bf16x2_t __attribute__((ext_vector_type(2)));
#define DI __device__ __forceinline__

constexpr int D = 1024, NB = 8, SEQ = 2048, NCTX = 256, TT = 2304, DEPTH = 4;
constexpr int ML = NB * SEQ;
constexpr int MC = NB * NCTX;
constexpr int MT = ML + MC;
constexpr int DFF = 2816, INW = 6816, INWP = 6912;
constexpr int O_CQ = 0, O_CKV = 384, O_KR = 640, O_DQ = 672, O_DK = 1184, O_DV = 1696, O_CB = 2208, O_CC = 2720, O_CX = 3232, O_G = 3744;
constexpr float EPS = 1e-6f;
constexpr float LOG2E = 1.4426950408889634f;

constexpr size_t al256(size_t x) { return (x + 255) & ~(size_t)255; }
constexpr size_t WS_MOD = 0;
constexpr size_t WS_TAB = al256(WS_MOD + (size_t)4 * 9 * 9216 * 4);
constexpr size_t WS_XC = al256(WS_TAB + (size_t)2048 * 96 * 4);
constexpr size_t WS_W = al256(WS_XC + (size_t)MC * D * 4);
constexpr size_t W_1U = 0, W_1D = W_1U + (size_t)5632 * 1024, W_2U = W_1D + (size_t)1024 * 2816, W_2D = W_2U + (size_t)5632 * 1024,
                 W_IN = W_2D + (size_t)1024 * 2816, W_UQ = W_IN + (size_t)INWP * 1024, W_UKV = W_UQ + (size_t)768 * 384,
                 W_BR = W_UKV + (size_t)1024 * 256, W_O = W_BR + (size_t)3 * 1024 * 512, W_END = W_O + (size_t)1024 * 1024;
constexpr size_t WS_R1 = al256(WS_W + W_END * 2);
constexpr size_t R1_KVRAW = (size_t)MT * 768 * 2;
constexpr size_t WS_PROJ = al256(WS_R1 + (size_t)MT * (768 + 1024) * 2);
constexpr size_t WS_QKV = al256(WS_PROJ + (size_t)MT * INWP * 2);
constexpr size_t Q_QM = 0, Q_KM = Q_QM + (size_t)NB * 8 * TT * 96 * 2, Q_VTM = Q_KM + (size_t)NB * 8 * TT * 96 * 2, Q_QD = Q_VTM + (size_t)NB * 8 * 64 * TT * 2,
                 Q_KD = Q_QD + (size_t)NB * 8 * TT * 64 * 2, Q_VTD = Q_KD + (size_t)NB * 8 * TT * 64 * 2, Q_END = Q_VTD + (size_t)NB * 4 * 128 * TT * 2;
constexpr size_t WS_Y = al256(WS_QKV + Q_END);
constexpr size_t WS_BAR = al256(WS_Y + (size_t)3 * MT * 512 * 2);
constexpr size_t WS_W2 = al256(WS_BAR + 3456 * 4);
constexpr size_t WS_END = al256(WS_W2 + W_END * 2);
static_assert(Q_END >= (size_t)MT * 1024 * 4, "MACC alias");

struct Params {
    const float* in[25];
    float* out;
    unsigned char* ws;
};

DI unsigned pk2(float a, float b) { f32x2 f = {a, b}; bf16x2_t h = __builtin_convertvector(f, bf16x2_t); return __builtin_bit_cast(unsigned, h); }
DI float bflo(unsigned u) { return __uint_as_float(u << 16); }
DI float bfhi(unsigned u) { return __uint_as_float(u & 0xffff0000u); }
DI float wave_sum(float v) {
#pragma unroll
    for (int o = 32; o > 0; o >>= 1) v += __shfl_xor(v, o);
    return v;
}
DI float wave_max(float v) {
#pragma unroll
    for (int o = 32; o > 0; o >>= 1) v = fmaxf(v, __shfl_xor(v, o));
    return v;
}
DI float lam_init_of(int l) { return l == 0 ? 0.2f : (l == 1 ? 0.35550907f : (l == 2 ? 0.47071302f : 0.55605820f)); }
DI float sigmoidf_(float x) { return __builtin_amdgcn_rcpf(1.0f + __builtin_amdgcn_exp2f(-1.4426950408889634f * x)); }
DI int tidx() { int t = threadIdx.x; asm volatile("" : "+v"(t)); return t; }

namespace pg8 {
constexpr int BM = 256, BK = 64, HALF = 128, HTB = HALF * BK * 2, STAGE_BYTES = 8 * HTB, NXCD = 8, WGM = 8;
DI int lds_byte(int r, int c) { const int st = (r >> 4) * 2 + (c >> 5), rr = r & 15, cc = c & 31, ob = rr * 64 + cc * 2; return st * 1024 + (ob ^ (((ob >> 9) & 1) << 5)); }
DI void stage_rc(int b, int& R, int& C) { const int st = b / 1024, sb = b % 1024, swz = sb ^ (((sb >> 9) & 1) << 5); R = (st >> 1) * 16 + swz / 64; C = (st & 1) * 32 + (swz % 64) / 2; }
DI int perm32(int rho) { const int n = rho >> 4, i = rho & 15; return 8 * (i >> 2) + 4 * n + (i & 3); }
struct Unit { int pm, pn, k0, nt, split; };
struct Gemm { const bf16_t* A; const bf16_t* Bt; int lda, K; };

struct Sched {
    int nM, nN, nwg, G, c, rep, aStride, bStride, ntFull;
    int nSplit, P, splitPm0, nb;
    int kseg;
    DI void init(int M, int N, int K, int G_, int c_, int rep_ = 1, int as_ = 0, int bs_ = 0) { nM = M / BM; nN = N / BM; nwg = nM * nN; G = G_; c = c_; rep = rep_; aStride = as_; bStride = bs_; ntFull = K / BK;
        nSplit = 0; P = 1; splitPm0 = 0; nb = K / 128; kseg = 0; }
    DI void add_split(int tilesM, int pm0, int P_) { nSplit = tilesM * nN * P_; P = P_; splitPm0 = pm0; }
    DI bool next(int i, Unit& u) const {
        int it = i, n = 0;
        if (rep > 1) { it = i / rep; n = i - it * rep; }
        const long L = (long)it * G + c;
        if (L >= nwg) {
            const int s = (int)(L - nwg); if (s >= nSplit) return false;
            const int tile = s / P, j = s - tile * P, base = nb / P, rem = nb - base * P;
            u.pm = splitPm0 + tile / nN; u.pn = tile % nN; u.k0 = 128 * (j * base + (j < rem ? j : rem)); u.nt = 2 * (base + (j < rem ? 1 : 0)); u.split = j + 1; return true;
        }
        int wgid = (int)L; { const int q = nwg / NXCD, r = nwg % NXCD, xcd = wgid % NXCD, off = wgid / NXCD; wgid = (xcd < r ? xcd * (q + 1) : r * (q + 1) + (xcd - r) * q) + off; }
        const int nig = WGM * nN, gid = wgid / nig, fm = gid * WGM, gsz = (nM - fm) < WGM ? (nM - fm) : WGM;
        u.pm = fm + ((wgid % nig) % gsz) + n * aStride; u.pn = (wgid % nig) / gsz + n * bStride; u.k0 = 0; u.nt = ntFull; u.split = 0;
        if (kseg) { u.k0 = n * kseg; u.split = n; }
        return true;
    }
};

template <class Epi>
DI void gemm_phase(LAS unsigned char* lds, const Gemm g, const Sched& S, const Epi& E) {
    const int tid = tidx(), wid = __builtin_amdgcn_readfirstlane(tid >> 6), lane = tid & 63, wr = wid >> 2, wc = wid & 3, fr = lane & 15, fq = lane >> 4;
    const int K = g.K, lda = g.lda;
    unsigned voffA[2], voffB[2];
#pragma unroll
    for (int i = 0; i < 2; ++i) { int R, C; stage_rc(tid * 16 + i * 8192, R, C); const int Rb = Epi::PERM ? ((R & ~31) + perm32(R & 31)) : R;
        voffA[i] = (unsigned)(R * lda + C) * 2u; voffB[i] = (unsigned)(Rb * K + C) * 2u; }
    const size_t kstep = (size_t)(BK * 2);
    const size_t hstepA = (size_t)HALF * lda * 2, hstepB = (size_t)HALF * K * 2;
    const size_t tstepA = 2 * hstepA, tstepB = 2 * hstepB;
    const unsigned ldsw = (unsigned)wid * 1024u;
    const int aoff = lds_byte(wr * 64 + fr, fq * 8), boff = lds_byte(wc * 32 + fr, fq * 8);
#define PG8_SA(b, h) (((b) * 2 + (h)) * HTB)
#define PG8_SB(b, h) ((4 + (b) * 2 + (h)) * HTB)
#define PG8_STAGE(bufoff, gbase, voff) do { _Pragma("unroll") for (int _i = 0; _i < 2; ++_i) \
        __builtin_amdgcn_global_load_lds((const unsigned*)((const char*)(gbase) + (voff)[_i]), (LAS unsigned*)(lds + (bufoff) + ldsw + _i * 8192), 16, 0, 0); } while (0)
#define PG8_LDA(dst, b, h) do { _Pragma("unroll") for (int m = 0; m < 4; ++m) _Pragma("unroll") for (int k = 0; k < 2; ++k) dst[m][k] = *(const LAS bf16x8*)(lds + PG8_SA(b, h) + aoff + m * 2048 + k * 1024); } while (0)
#define PG8_LDB(dst, b, h) do { _Pragma("unroll") for (int n = 0; n < 2; ++n) _Pragma("unroll") for (int k = 0; k < 2; ++k) dst[n][k] = *(const LAS bf16x8*)(lds + PG8_SB(b, h) + boff + n * 2048 + k * 1024); } while (0)
#define PG8_MMA(ai, bj, At, Bt) do { __builtin_amdgcn_s_setprio(1); _Pragma("unroll") for (int m = 0; m < 4; ++m) _Pragma("unroll") for (int n = 0; n < 2; ++n) _Pragma("unroll") for (int k = 0; k < 2; ++k) \
        acc[ai][bj][m][n] = __builtin_amdgcn_mfma_f32_16x16x32_bf16(Bt[n][k], At[m][k], acc[ai][bj][m][n], 0, 0, 0); __builtin_amdgcn_s_setprio(0); } while (0)
#define PG8_WAIT_V(n) asm volatile("s_waitcnt vmcnt(" #n ")" ::: "memory")
#define PG8_WAIT_L(n) asm volatile("s_waitcnt lgkmcnt(" #n ")" ::: "memory")
#define PG8_BAR __builtin_amdgcn_s_barrier()
#define PG8_SCHED __builtin_amdgcn_sched_barrier(0)
    Unit cur, nxt; int ui = 0;
    if (!S.next(0, cur)) return;
    f32x4 acc[2][2][4][2];
#pragma unroll
    for (int a = 0; a < 2; ++a)
#pragma unroll
        for (int b = 0; b < 2; ++b)
#pragma unroll
            for (int m = 0; m < 4; ++m)
#pragma unroll
                for (int n = 0; n < 2; ++n) acc[a][b][m][n] = (f32x4){0.f, 0.f, 0.f, 0.f};
    bf16x8 At[4][2], B0[2][2], B1[2][2];
    const char* cA = (const char*)g.A + (size_t)cur.pm * tstepA + (size_t)cur.k0 * 2; const char* cB = (const char*)g.Bt + (size_t)cur.pn * tstepB + (size_t)cur.k0 * 2;
    PG8_STAGE(PG8_SB(0, 0), cB, voffB); PG8_STAGE(PG8_SA(0, 0), cA, voffA); PG8_STAGE(PG8_SB(0, 1), cB + hstepB, voffB); PG8_STAGE(PG8_SA(0, 1), cA + hstepA, voffA);
    if (wr == 1) PG8_BAR;
    PG8_WAIT_V(4); PG8_BAR;
    PG8_STAGE(PG8_SB(1, 0), cB + kstep, voffB); PG8_STAGE(PG8_SA(1, 0), cA + kstep, voffA); PG8_STAGE(PG8_SB(1, 1), cB + hstepB + kstep, voffB);
    PG8_WAIT_V(6); PG8_BAR;
    for (;;) {
        const bool has_next = S.next(ui + 1, nxt);
        const char* nA = has_next ? (const char*)g.A + (size_t)nxt.pm * tstepA + (size_t)nxt.k0 * 2 : cA; const char* nB = has_next ? (const char*)g.Bt + (size_t)nxt.pn * tstepB + (size_t)nxt.k0 * 2 : cB;
        const int nt = cur.nt;
        for (int t = 0; t < nt; t += 2) {
            const bool last = (t == nt - 2);
            const char* a1 = cA + (size_t)(t + 1) * kstep;
            const char* a2 = last ? nA : cA + (size_t)(t + 2) * kstep; const char* b2 = last ? nB : cB + (size_t)(t + 2) * kstep;
            const char* a3 = a2 + kstep; const char* b3 = b2 + kstep;
            PG8_LDB(B0, 0, 0); PG8_SCHED; PG8_LDA(At, 0, 0); PG8_STAGE(PG8_SA(1, 1), a1 + hstepA, voffA);
            PG8_WAIT_L(8); PG8_BAR; PG8_WAIT_L(0); PG8_MMA(0, 0, At, B0); PG8_BAR; PG8_SCHED;
            PG8_LDB(B1, 0, 1); PG8_STAGE(PG8_SB(0, 0), b2, voffB);
            PG8_BAR; PG8_WAIT_L(0); PG8_MMA(0, 1, At, B1); PG8_BAR;
            PG8_LDA(At, 0, 1); PG8_STAGE(PG8_SA(0, 0), a2, voffA);
            PG8_BAR; PG8_WAIT_L(0); PG8_MMA(1, 0, At, B0); PG8_BAR; PG8_SCHED;
            PG8_STAGE(PG8_SB(0, 1), b2 + hstepB, voffB);
            PG8_WAIT_V(6); PG8_BAR; PG8_MMA(1, 1, At, B1); PG8_BAR;
            PG8_LDB(B0, 1, 0); PG8_SCHED; PG8_LDA(At, 1, 0); PG8_STAGE(PG8_SA(0, 1), a2 + hstepA, voffA);
            PG8_WAIT_L(8); PG8_BAR; PG8_WAIT_L(0); PG8_MMA(0, 0, At, B0); PG8_BAR; PG8_SCHED;
            PG8_LDB(B1, 1, 1); PG8_STAGE(PG8_SB(1, 0), b3, voffB);
            PG8_BAR; PG8_WAIT_L(0); PG8_MMA(0, 1, At, B1); PG8_BAR;
            PG8_LDA(At, 1, 1); PG8_STAGE(PG8_SA(1, 0), a3, voffA);
            PG8_BAR; PG8_WAIT_L(0); PG8_MMA(1, 0, At, B0); PG8_BAR; PG8_SCHED;
            PG8_STAGE(PG8_SB(1, 1), b3 + hstepB, voffB);
            PG8_WAIT_V(6); PG8_BAR; PG8_MMA(1, 1, At, B1); PG8_BAR;
        }
        E(acc, cur, wr, wc, fr, fq);
        if (!has_next) break;
        if (!(Epi::CHAIN && nxt.split != 0)) {
#pragma unroll
            for (int a = 0; a < 2; ++a)
#pragma unroll
                for (int b = 0; b < 2; ++b)
#pragma unroll
                    for (int m = 0; m < 4; ++m)
#pragma unroll
                        for (int n = 0; n < 2; ++n) acc[a][b][m][n] = (f32x4){0.f, 0.f, 0.f, 0.f};
        }
        cur = nxt; cA = nA; cB = nB; ++ui;
    }
    PG8_WAIT_V(0);
    if (wr == 0) PG8_BAR;
    PG8_BAR;
#undef PG8_SA
#undef PG8_SB
#undef PG8_STAGE
#undef PG8_LDA
#undef PG8_LDB
#undef PG8_MMA
#undef PG8_WAIT_V
#undef PG8_WAIT_L
#undef PG8_BAR
#undef PG8_SCHED
}
}
using pg8::Unit;
typedef f32x4 AccT[2][2][4][2];

struct EpiStore {
    static constexpr bool PERM = true, CHAIN = false;
    bf16_t* O; int ld; int sig0;
    DI void operator()(const AccT& acc, const Unit& u, int wr, int wc, int fr, int fq) const {
        const int row0 = u.pm * 256 + wr * 64 + fr, col0 = u.pn * 256 + wc * 32 + 8 * fq;
#pragma unroll
        for (int ai = 0; ai < 2; ++ai)
#pragma unroll
            for (int m = 0; m < 4; ++m) { bf16_t* rowp = O + (size_t)(row0 + ai * 128 + m * 16) * ld + col0;
#pragma unroll
                for (int bj = 0; bj < 2; ++bj) { f32x4 v0 = acc[ai][bj][m][0], v1 = acc[ai][bj][m][1];
                    if (u.pn * 256 + bj * 128 + wc * 32 >= sig0) {
#pragma unroll
                        for (int j = 0; j < 4; ++j) { v0[j] = sigmoidf_(v0[j]); v1[j] = sigmoidf_(v1[j]); } }
                    u32x4 w; w.x = pk2(v0[0], v0[1]); w.y = pk2(v0[2], v0[3]); w.z = pk2(v1[0], v1[1]); w.w = pk2(v1[2], v1[3]);
                    *(u32x4*)(rowp + bj * 128) = w; } }
    }
};
struct EpiSwiglu {
    static constexpr bool PERM = true, CHAIN = false;
    bf16_t* O;
    DI void operator()(const AccT& acc, const Unit& u, int wr, int wc, int fr, int fq) const {
        const int row0 = u.pm * 256 + wr * 64 + fr, col0 = u.pn * 128 + (wc * 4 + fq) * 8;
#pragma unroll
        for (int ai = 0; ai < 2; ++ai)
#pragma unroll
            for (int m = 0; m < 4; ++m) { bf16_t* rowp = O + (size_t)(row0 + ai * 128 + m * 16) * DFF + col0;
                unsigned o[4];
#pragma unroll
                for (int bj = 0; bj < 2; ++bj) { const f32x4 v0 = acc[ai][bj][m][0], v1 = acc[ai][bj][m][1];
                    const float r0 = v0[0] * sigmoidf_(v0[0]) * v0[1], r1 = v0[2] * sigmoidf_(v0[2]) * v0[3];
                    const float r2 = v1[0] * sigmoidf_(v1[0]) * v1[1], r3 = v1[2] * sigmoidf_(v1[2]) * v1[3];
                    o[2 * bj] = pk2(r0, r1); o[2 * bj + 1] = pk2(r2, r3); }
                u32x4 w; w.x = o[0]; w.y = o[1]; w.z = o[2]; w.w = o[3];
                *(u32x4*)rowp = w; }
    }
};
struct EpiResid {
    static constexpr bool PERM = false, CHAIN = false;
    float* xl; float* xc; const float* modl; int midx; float coef; float* part;
    DI void operator()(const AccT& acc, const Unit& u, int wr, int wc, int fr, int fq) const {
        const int bi = u.pm < 64 ? (u.pm >> 3) : 8;
        float* base = u.pm < 64 ? xl + (size_t)u.pm * 256 * D : xc + (size_t)(u.pm - 64) * 256 * D;
        if (u.split) base = part + (size_t)(u.split - 1) * MC * D + (size_t)(u.pm - 64) * 256 * D;
        const int row0 = wr * 64 + fr, col0 = u.pn * 256 + wc * 32 + 4 * fq;
        const float* mp = modl + (size_t)bi * 9216 + midx * 1024 + col0;
#pragma unroll
        for (int bj = 0; bj < 2; ++bj) {
            f32x4 mv[2];
#pragma unroll
            for (int n = 0; n < 2; ++n) mv[n] = *(const f32x4*)(mp + bj * 128 + n * 16) * coef;
            float* cb = base + (size_t)row0 * D + col0 + bj * 128;
            f32x4 xv[2][2][4];
            if (!u.split) {
#pragma unroll
                for (int n = 0; n < 2; ++n)
#pragma unroll
                    for (int ai = 0; ai < 2; ++ai)
#pragma unroll
                        for (int m = 0; m < 4; ++m) xv[n][ai][m] = *(const f32x4*)(cb + n * 16 + (size_t)(ai * 128 + m * 16) * D);
            } else {
#pragma unroll
                for (int n = 0; n < 2; ++n)
#pragma unroll
                    for (int ai = 0; ai < 2; ++ai)
#pragma unroll
                        for (int m = 0; m < 4; ++m) xv[n][ai][m] = (f32x4){0.f, 0.f, 0.f, 0.f};
            }
#pragma unroll
            for (int n = 0; n < 2; ++n)
#pragma unroll
                for (int ai = 0; ai < 2; ++ai)
#pragma unroll
                    for (int m = 0; m < 4; ++m) *(f32x4*)(cb + n * 16 + (size_t)(ai * 128 + m * 16) * D) = xv[n][ai][m] + mv[n] * acc[ai][bj][m][n];
        }
    }
};
struct EpiMerge {
    static constexpr bool PERM = false, CHAIN = true;
    bf16_t* mb; const bf16_t* proj;
    DI void operator()(AccT& acc, const Unit& u, int wr, int wc, int fr, int fq) const {
        const int seg = u.split;
        const int row0 = u.pm * 256 + wr * 64 + fr, col0 = u.pn * 256 + wc * 32 + 4 * fq;
#pragma unroll
        for (int ai = 0; ai < 2; ++ai) {
            u32x2 ga[4][4], gb[4][4];
#pragma unroll
            for (int m = 0; m < 4; ++m) { const bf16_t* gp = proj + (size_t)(row0 + ai * 128 + m * 16) * INWP + O_G + seg * 1024 + col0;
#pragma unroll
                for (int q = 0; q < 4; ++q) { const int co = (q >> 1) * 128 + (q & 1) * 16; ga[m][q] = *(const u32x2*)(gp + co); gb[m][q] = seg < 2 ? *(const u32x2*)(gp + 1024 + co) : (u32x2){0u, 0u}; } }
#pragma unroll
            for (int m = 0; m < 4; ++m) { const size_t row = (size_t)(row0 + ai * 128 + m * 16);
#pragma unroll
                for (int q = 0; q < 4; ++q) { const int bj = q >> 1, n = q & 1, co = bj * 128 + n * 16;
                    f32x4 r; r[0] = fmaxf(bflo(ga[m][q].x), 1e-20f); r[1] = fmaxf(bfhi(ga[m][q].x), 1e-20f); r[2] = fmaxf(bflo(ga[m][q].y), 1e-20f); r[3] = fmaxf(bfhi(ga[m][q].y), 1e-20f);
                    if (seg < 2) {
                        r[0] *= __builtin_amdgcn_rcpf(fmaxf(bflo(gb[m][q].x), 1e-20f)); r[1] *= __builtin_amdgcn_rcpf(fmaxf(bfhi(gb[m][q].x), 1e-20f));
                        r[2] *= __builtin_amdgcn_rcpf(fmaxf(bflo(gb[m][q].y), 1e-20f)); r[3] *= __builtin_amdgcn_rcpf(fmaxf(bfhi(gb[m][q].y), 1e-20f));
                        acc[ai][bj][m][n] = acc[ai][bj][m][n] * r; }
                    else { const f32x4 v = acc[ai][bj][m][n] * r; u32x2 w; w.x = pk2(v[0], v[1]); w.y = pk2(v[2], v[3]); *(u32x2*)(mb + row * D + col0 + co) = w; } } }
        }
    }
};

DI void mod_phase(const Params& p, LAS unsigned char* ldsb) {
    LAS float* sc = (LAS float*)ldsb;
    LAS float* red = sc + 9216;
    const int tid = tidx(), wid = tid >> 6, lane = tid & 63;
    for (int i = tid; i < 9216; i += 512) { const int bi = i >> 10, k = i & 1023; const float cv = bi < 8 ? p.in[1][bi * 1024 + k] : p.in[3][k]; sc[i] = cv / (1.0f + expf(-cv)); }
    __syncthreads();
    float* MOD = (float*)(p.ws + WS_MOD);
    for (int item = blockIdx.x; item < 144; item += gridDim.x) {
        const int l = item / 36, j0 = (item % 36) * 256;
        const float* w = p.in[4] + ((size_t)l * 1024 + wid * 128) * 9216 + j0 + lane * 4;
        f32x4 acc[9];
#pragma unroll
        for (int b = 0; b < 9; ++b) acc[b] = (f32x4){0.f, 0.f, 0.f, 0.f};
#pragma unroll 8
        for (int kk = 0; kk < 128; ++kk) { const f32x4 wv = __builtin_nontemporal_load((const f32x4*)(w + (size_t)kk * 9216)); const int k = wid * 128 + kk;
#pragma unroll
            for (int b = 0; b < 9; ++b) acc[b] = acc[b] + wv * sc[b * 1024 + k]; }
#pragma unroll
        for (int b = 0; b < 9; ++b) *(LAS f32x4*)(red + (wid * 9 + b) * 256 + lane * 4) = acc[b];
        __syncthreads();
        for (int o = tid; o < 9 * 256; o += 512) { const int b = o >> 8, cn = o & 255; float s = 0.f;
#pragma unroll
            for (int w8 = 0; w8 < 8; ++w8) s += red[(w8 * 9 + b) * 256 + cn];
            MOD[((size_t)l * 9 + b) * 9216 + j0 + cn] = s + p.in[5][(size_t)l * 9216 + j0 + cn]; }
        __syncthreads();
    }
}
DI void tab_phase(const Params& p) {
    float* TABM = (float*)(p.ws + WS_TAB);
    float* TABD = TABM + 2048 * 32;
    const int gt = blockIdx.x * 512 + tidx(), nth = gridDim.x * 512;
    for (int i = gt; i < 2048 * 48; i += nth) {
        const int s = i / 48, a = i % 48;
        const float row = (float)(s >> 6), col = (float)(s & 63);
        float pos, invf; int idx; float* dst; int half;
        if (a < 16) { const int axis = a >> 3, f = a & 7; pos = axis ? col : row; invf = exp2f(-(float)f * (13.287712379549449f / 8.0f)); dst = TABM + s * 32; idx = a; half = 16; }
        else { const int a2 = a - 16, axis = a2 >> 4, f = a2 & 15; pos = axis ? col : row; invf = exp2f(-(float)f * (13.287712379549449f / 16.0f)); dst = TABD + s * 64; idx = a2; half = 32; }
        const float ang = pos * invf;
        float rev = ang * 0.15915494309189535f; rev -= floorf(rev);
        dst[idx] = __builtin_amdgcn_cosf(rev); dst[half + idx] = __builtin_amdgcn_sinf(rev);
    }
}

DI void convT(const float* __restrict__ src, int K, int N, bf16_t* __restrict__ dst, int mode, const float* kscale, LAS float* tile, int rot, int vid, int vcnt, int ldd = 0, int koff = 0) {
    if (ldd == 0) ldd = K;
    const int tilesN = (N + 63) >> 6, tilesK = K >> 6, nt = tilesN * tilesK, tid = tidx();
    int start = vid - (rot % vcnt); if (start < 0) start += vcnt;
    const int kr = tid >> 4, c4 = (tid & 15) * 4;
    f32x4 r0, r1;
    auto fetch = [&](int tl) {
        const int tk = tl / tilesN, tn = tl - tk * tilesN, n = tn * 64 + c4, k0 = tk * 64 + kr;
        r0 = (f32x4){0.f, 0.f, 0.f, 0.f}; r1 = r0;
        if (n < N) { r0 = __builtin_nontemporal_load((const f32x4*)(src + (size_t)k0 * N + n)); r1 = __builtin_nontemporal_load((const f32x4*)(src + (size_t)(k0 + 32) * N + n)); }
        if (kscale) { r0 = r0 * kscale[k0]; r1 = r1 * kscale[k0 + 32]; }
    };
    if (start < nt) fetch(start);
    for (int tl = start; tl < nt; tl += vcnt) {
        const int tk = tl / tilesN, tn = tl - tk * tilesN;
        { LAS float* tp = tile + kr * 65 + c4; tp[0] = r0[0]; tp[1] = r0[1]; tp[2] = r0[2]; tp[3] = r0[3];
          tp += 32 * 65; tp[0] = r1[0]; tp[1] = r1[1]; tp[2] = r1[2]; tp[3] = r1[3]; }
        if (tl + vcnt < nt) fetch(tl + vcnt);
        __syncthreads();
        { const int nl = tid >> 3, k8 = (tid & 7) * 8, n = tn * 64 + nl;
          if (n < N) { float f[8];
#pragma unroll
              for (int j = 0; j < 8; ++j) f[j] = tile[(k8 + j) * 65 + nl];
              u32x4 w; w.x = pk2(f[0], f[1]); w.y = pk2(f[2], f[3]); w.z = pk2(f[4], f[5]); w.w = pk2(f[6], f[7]);
              int drow = n;
              if (mode == 1) { const int i = n < DFF ? n : n - DFF, role = n < DFF ? 0 : 1;
                  drow = (i >> 7) * 256 + ((i >> 2) & 1) * 128 + ((i & 127) >> 3) * 8 + (i & 3) * 2 + role; }
              else if (mode == 2) { const int h = n / 96, o = n - h * 96, q = o - 64; if (o >= 64) drow = h * 96 + 64 + 2 * ((q >> 4) * 8 + (q & 7)) + ((q >> 3) & 1); }
              else if (mode == 3) { if (n >= O_KR && n < O_DQ) { const int q = n - O_KR; drow = O_KR + 2 * ((q >> 4) * 8 + (q & 7)) + ((q >> 3) & 1); }
                                    else if (n >= O_DQ && n < O_DV) { const int o = (n - O_DQ) & 63; drow = n - o + 2 * ((o >> 5) * 16 + (o & 15)) + ((o >> 4) & 1); } }
              *(u32x4*)(dst + (size_t)drow * ldd + koff + tk * 64 + k8) = w; } }
        __syncthreads();
    }
}
DI void conv_weights(const Params& p, int l, LAS unsigned char* ldsb, bf16_t* W, int vid, int vcnt) {
    LAS float* tile = (LAS float*)ldsb;
    convT(p.in[7] + (size_t)l * 1024 * 5632, 1024, 5632, W + W_1U, 1, nullptr, tile, 0, vid, vcnt);
    convT(p.in[8] + (size_t)l * 2816 * 1024, 2816, 1024, W + W_1D, 0, nullptr, tile, 128, vid, vcnt);
    convT(p.in[9] + (size_t)l * 1024 * 5632, 1024, 5632, W + W_2U, 1, nullptr, tile, 64, vid, vcnt);
    convT(p.in[10] + (size_t)l * 2816 * 1024, 2816, 1024, W + W_2D, 0, nullptr, tile, 192, vid, vcnt);
    convT(p.in[11] + (size_t)l * 1024 * INW, 1024, INW, W + W_IN, 3, nullptr, tile, 32, vid, vcnt);
    convT(p.in[13] + (size_t)l * 384 * 768, 384, 768, W + W_UQ, 2, p.in[12] + l * 384, tile, 160, vid, vcnt);
    convT(p.in[15] + (size_t)l * 256 * 1024, 256, 1024, W + W_UKV, 0, p.in[14] + l * 256, tile, 232, vid, vcnt);
    for (int n = 0; n < 3; ++n) convT(p.in[23] + ((size_t)l * 3 + n) * 512 * 1024, 512, 1024, W + W_BR, 0, nullptr, tile, 40 + n * 72, vid, vcnt, 1536, n * 512);
    convT(p.in[24] + (size_t)l * 1024 * 1024, 1024, 1024, W + W_O, 0, nullptr, tile, 96, vid, vcnt);
    { u32x4* z = (u32x4*)(W + W_IN + (size_t)INW * 1024); const int nz = (INWP - INW) * 1024 / 8;
      for (int i = vid * 512 + tidx(); i < nz; i += vcnt * 512) z[i] = (u32x4){0u, 0u, 0u, 0u}; }
}

DI void norm_phase(const float* sl, const float* sc_, float* dl, float* dc, bool copy, bf16_t* H, const float* g, const float* modl, int shift_i, int scale_i, int Mrows, const float* part, int npart) {
    const int tid_ = tidx(), lane = tid_ & 63, gw = blockIdx.x * 8 + (tid_ >> 6), nw = gridDim.x * 8;
    constexpr int R = 3;
    for (int row0 = gw; row0 < Mrows; row0 += R * nw) {
        f32x4 v[R][4]; float ss[R]; bool ok[R];
#pragma unroll
        for (int r = 0; r < R; ++r) { int row = row0 + r * nw; ok[r] = row < Mrows; row = ok[r] ? row : Mrows - 1;
            const float* src = row < ML ? sl + (size_t)row * D : sc_ + (size_t)(row - ML) * D;
#pragma unroll
            for (int i = 0; i < 4; ++i) v[r][i] = *(const f32x4*)(src + i * 256 + lane * 4); }
#pragma unroll
        for (int r = 0; r < R; ++r) { const int row = row0 + r * nw;
            if (ok[r] && npart > 0 && row >= ML) {
                f32x4 pv[4][4];
#pragma unroll
                for (int j = 0; j < 4; ++j) { const float* pp = part + (size_t)j * MC * D + (size_t)(row - ML) * D;
#pragma unroll
                    for (int i = 0; i < 4; ++i) pv[j][i] = *(const f32x4*)(pp + i * 256 + lane * 4); }
#pragma unroll
                for (int j = 0; j < 4; ++j)
#pragma unroll
                    for (int i = 0; i < 4; ++i) v[r][i] = v[r][i] + pv[j][i]; }
            float s = 0.f;
#pragma unroll
            for (int i = 0; i < 4; ++i) s += v[r][i][0] * v[r][i][0] + v[r][i][1] * v[r][i][1] + v[r][i][2] * v[r][i][2] + v[r][i][3] * v[r][i][3];
            ss[r] = s; }
#pragma unroll
        for (int o = 32; o > 0; o >>= 1) {
#pragma unroll
            for (int r = 0; r < R; ++r) ss[r] += __shfl_xor(ss[r], o); }
#pragma unroll
        for (int r = 0; r < R; ++r) { const int row = row0 + r * nw;
            if (!ok[r]) continue;
            const int bi = row < ML ? (row >> 11) : 8;
            const float rstd = rsqrtf(ss[r] * (1.0f / 1024.0f) + EPS);
            const float* mb = modl + (size_t)bi * 9216;
#pragma unroll
            for (int i = 0; i < 4; ++i) { const int col = i * 256 + lane * 4;
                const f32x4 gg = *(const f32x4*)(g + col), scv = *(const f32x4*)(mb + scale_i * 1024 + col), shv = *(const f32x4*)(mb + shift_i * 1024 + col);
                const f32x4 h = v[r][i] * rstd * gg * (scv + 1.0f) + shv;
                u32x2 w; w.x = pk2(h[0], h[1]); w.y = pk2(h[2], h[3]);
                *(u32x2*)(H + (size_t)row * D + col) = w; }
            if (copy || (npart > 0 && row >= ML)) { float* dst = row < ML ? dl + (size_t)row * D : dc + (size_t)(row - ML) * D;
#pragma unroll
                for (int i = 0; i < 4; ++i) *(f32x4*)(dst + i * 256 + lane * 4) = v[r][i]; }
        }
    }
}

template <int NV> DI void load_bf16_row(const bf16_t* src, float* v, float mul) {
#pragma unroll
    for (int i = 0; i < NV / 8; ++i) { const u32x4 w = *(const u32x4*)(src + i * 8);
        v[i * 8 + 0] = bflo(w.x) * mul; v[i * 8 + 1] = bfhi(w.x) * mul; v[i * 8 + 2] = bflo(w.y) * mul; v[i * 8 + 3] = bfhi(w.y) * mul;
        v[i * 8 + 4] = bflo(w.z) * mul; v[i * 8 + 5] = bfhi(w.z) * mul; v[i * 8 + 6] = bflo(w.w) * mul; v[i * 8 + 7] = bfhi(w.w) * mul; }
}
template <int NV> DI void store_bf16_row(bf16_t* dst, const float* v) {
#pragma unroll
    for (int i = 0; i < NV / 8; ++i) { u32x4 w; w.x = pk2(v[i * 8], v[i * 8 + 1]); w.y = pk2(v[i * 8 + 2], v[i * 8 + 3]); w.z = pk2(v[i * 8 + 4], v[i * 8 + 5]); w.w = pk2(v[i * 8 + 6], v[i * 8 + 7]);
        *(u32x4*)(dst + i * 8) = w; }
}
template <int NV> DI float sumsq_row(const bf16_t* src, float mul) {
    float ss = 0.f;
#pragma unroll
    for (int i = 0; i < NV / 8; ++i) { const u32x4 w = *(const u32x4*)(src + i * 8); const unsigned ww[4] = {w.x, w.y, w.z, w.w};
#pragma unroll
        for (int j = 0; j < 4; ++j) { const float a = bflo(ww[j]) * mul, b = bfhi(ww[j]) * mul; ss += a * a; ss += b * b; } }
    return ss;
}
template <int NV> DI void emit_plain(const bf16_t* src, float mul, const LAS float* g, bf16_t* dst) {
#pragma unroll 2
    for (int i = 0; i < NV / 8; ++i) { const u32x4 w = *(const u32x4*)(src + i * 8); const unsigned ww[4] = {w.x, w.y, w.z, w.w}; unsigned o[4];
#pragma unroll
        for (int j = 0; j < 4; ++j) o[j] = pk2(bflo(ww[j]) * mul * g[i * 8 + 2 * j], bfhi(ww[j]) * mul * g[i * 8 + 2 * j + 1]);
        u32x4 ov; ov.x = o[0]; ov.y = o[1]; ov.z = o[2]; ov.w = o[3]; *(u32x4*)(dst + i * 8) = ov; }
}
template <int QF> DI void emit_rope_axis(const bf16_t* src, float mul, const LAS float* g, const float* cp, const float* sp, bf16_t* dst) {
    float v[2 * QF];
#pragma unroll
    for (int i = 0; i < QF / 4; ++i) { const u32x4 w = *(const u32x4*)(src + i * 8); const unsigned ww[4] = {w.x, w.y, w.z, w.w};
#pragma unroll
        for (int j = 0; j < 4; ++j) { v[i * 8 + 2 * j] = bflo(ww[j]) * mul * g[i * 8 + 2 * j]; v[i * 8 + 2 * j + 1] = bfhi(ww[j]) * mul * g[i * 8 + 2 * j + 1]; } }
    if (cp) {
#pragma unroll
        for (int f = 0; f < QF; ++f) { const float c = cp[f], s = sp[f], x1 = v[f], x2 = v[QF + f]; v[f] = x1 * c - x2 * s; v[QF + f] = x2 * c + x1 * s; }
    }
#pragma unroll
    for (int i = 0; i < QF / 4; ++i) { u32x4 ov; ov.x = pk2(v[i * 8], v[i * 8 + 1]); ov.y = pk2(v[i * 8 + 2], v[i * 8 + 3]); ov.z = pk2(v[i * 8 + 4], v[i * 8 + 5]); ov.w = pk2(v[i * 8 + 6], v[i * 8 + 7]); *(u32x4*)(dst + i * 8) = ov; }
}
DI float sumsq8(u32x4 w) { const unsigned ww[4] = {w.x, w.y, w.z, w.w}; float ss = 0.f;
#pragma unroll
    for (int j = 0; j < 4; ++j) { const float a = bflo(ww[j]), b = bfhi(ww[j]); ss += a * a; ss += b * b; }
    return ss; }
DI void unpack8(u32x4 w, float* v, float mul) { const unsigned ww[4] = {w.x, w.y, w.z, w.w};
#pragma unroll
    for (int j = 0; j < 4; ++j) { v[2 * j] = bflo(ww[j]) * mul; v[2 * j + 1] = bfhi(ww[j]) * mul; } }
DI u32x4 pack8(const float* v) { u32x4 o; o.x = pk2(v[0], v[1]); o.y = pk2(v[2], v[3]); o.z = pk2(v[4], v[5]); o.w = pk2(v[6], v[7]); return o; }
DI float red8(float v) { v += __shfl_xor(v, 1); v += __shfl_xor(v, 2); v += __shfl_xor(v, 4); return v; }

DI void prep_body(const Params& p, int l, LAS unsigned char* ldsb,
                  const bf16_t* __restrict__ PROJ, const bf16_t* __restrict__ QRAW, const bf16_t* __restrict__ KVRAW,
                  bf16_t* __restrict__ QM, bf16_t* __restrict__ KM, bf16_t* __restrict__ VTM, bf16_t* __restrict__ QD, bf16_t* __restrict__ KD, bf16_t* __restrict__ VTD, bf16_t* __restrict__ Y2,
                  const float* __restrict__ TABM, const float* __restrict__ TABD, const float* __restrict__ cw) {
    const int tid = tidx(), wid = tid >> 6, lane = tid & 63, hd = lane >> 3, s = lane & 7;
    const float qsm = 0.10206207261596577f * LOG2E, qsd = 0.125f * LOG2E;
    LAS float* gl = (LAS float*)ldsb;
    if (tid < 96) { const int q = tid - 64, pp = q >> 1, hh = q & 1; const int orig = tid < 64 ? tid : 64 + 16 * (pp >> 3) + 8 * hh + (pp & 7);
        gl[tid] = p.in[16][l * 96 + orig]; gl[96 + tid] = p.in[17][l * 96 + orig]; }
    if (tid < 64) { const int pp = tid >> 1, hh = tid & 1, orig = 32 * (pp >> 4) + 16 * hh + (pp & 15);
        gl[192 + tid] = p.in[18][l * 64 + orig]; gl[256 + tid] = p.in[19][l * 64 + orig]; }
    __syncthreads();
    float gqn[8], gqr[4], gkn[8], gkr[4], gdq[8], gdk[8];
#pragma unroll
    for (int j = 0; j < 8; ++j) { gqn[j] = gl[8 * s + j]; gkn[j] = gl[96 + 8 * s + j]; gdq[j] = gl[192 + 8 * s + j]; gdk[j] = gl[256 + 8 * s + j]; }
#pragma unroll
    for (int j = 0; j < 4; ++j) { gqr[j] = gl[64 + 4 * s + j]; gkr[j] = gl[96 + 64 + 4 * s + j]; }
    __syncthreads();
    LAS unsigned char* Vl = ldsb;
#pragma unroll 1
    for (int item = blockIdx.x; item < 5 * (MT / 64); item += gridDim.x) {
        const int type = item / (MT / 64), blk = item - type * (MT / 64);
        const int r0 = blk * 64; int b, t0, spos0, seglen; bool latent;
        if (r0 < ML) { b = r0 >> 11; spos0 = r0 & 2047; t0 = 256 + spos0; latent = true; seglen = 2048; }
        else { const int rc = r0 - ML; b = rc >> 8; spos0 = rc & 255; t0 = spos0; latent = false; seglen = 256; }
        if (type == 0) {
#pragma unroll 1
            for (int kb4 = 0; kb4 < 8; kb4 += 4) {
                float s1[4], s2[4]; u32x4 wqn[4], wkn[4]; u32x2 wqr[4], wkr[4]; f32x2 cm[4], sm[4];
#pragma unroll
            for (int k = 0; k < 4; ++k) {
                const int tl = wid * 8 + kb4 + k, r = r0 + tl, t = t0 + tl, spos = spos0 + tl;
                const bf16_t* prow = PROJ + (size_t)r * INWP;
                s1[k] = sumsq8(*(const u32x4*)(prow + O_CQ + (lane < 48 ? lane : 0) * 8)); s1[k] = lane < 48 ? s1[k] : 0.f;
                s2[k] = sumsq8(*(const u32x4*)(prow + O_CKV + (lane < 32 ? lane : 0) * 8)); s2[k] = lane < 32 ? s2[k] : 0.f;
                wqn[k] = *(const u32x4*)(QRAW + (size_t)r * 768 + hd * 96 + 8 * s);
                wqr[k] = *(const u32x2*)(QRAW + (size_t)r * 768 + hd * 96 + 64 + 4 * s);
                wkn[k] = *(const u32x4*)(KVRAW + (size_t)r * 1024 + hd * 128 + 8 * s);
                wkr[k] = *(const u32x2*)(prow + O_KR + 4 * s);
                cm[k] = *(const f32x2*)(TABM + (latent ? spos : 0) * 32 + 2 * s); sm[k] = *(const f32x2*)(TABM + (latent ? spos : 0) * 32 + 16 + 2 * s);
                cm[k][0] = latent ? cm[k][0] : 1.f; cm[k][1] = latent ? cm[k][1] : 1.f; sm[k][0] = latent ? sm[k][0] : 0.f; sm[k][1] = latent ? sm[k][1] : 0.f;
            }
#pragma unroll
            for (int k = 0; k < 4; ++k) {
                const int tl = wid * 8 + kb4 + k, r = r0 + tl, t = t0 + tl; (void)r;
                s1[k] = wave_sum(s1[k]); s2[k] = wave_sum(s2[k]);
                const float rcq = rsqrtf(s1[k] * (1.0f / 384.0f) + EPS), rckv = rsqrtf(s2[k] * (1.0f / 256.0f) + EPS);
                { float vn[8], vr[4]; unpack8(wqn[k], vn, rcq); vr[0] = bflo(wqr[k].x) * rcq; vr[1] = bfhi(wqr[k].x) * rcq; vr[2] = bflo(wqr[k].y) * rcq; vr[3] = bfhi(wqr[k].y) * rcq;
                  float ss = vr[0] * vr[0] + vr[1] * vr[1] + vr[2] * vr[2] + vr[3] * vr[3];
#pragma unroll
                  for (int j = 0; j < 8; ++j) ss += vn[j] * vn[j];
                  ss = red8(ss); const float mul = rsqrtf(ss * (1.0f / 96.0f) + EPS) * qsm;
#pragma unroll
                  for (int j = 0; j < 8; ++j) vn[j] *= mul * gqn[j];
#pragma unroll
                  for (int j = 0; j < 4; ++j) vr[j] *= mul * gqr[j];
                  const float a0 = vr[0] * cm[k][0] - vr[1] * sm[k][0], a1 = vr[1] * cm[k][0] + vr[0] * sm[k][0], a2 = vr[2] * cm[k][1] - vr[3] * sm[k][1], a3 = vr[3] * cm[k][1] + vr[2] * sm[k][1];
                  bf16_t* d = QM + ((size_t)(b * 8 + hd) * TT + t) * 96;
                  *(u32x4*)(d + 8 * s) = pack8(vn); u32x2 o; o.x = pk2(a0, a1); o.y = pk2(a2, a3); *(u32x2*)(d + 64 + 4 * s) = o; }
                { float vn[8], vr[4]; unpack8(wkn[k], vn, rckv); vr[0] = bflo(wkr[k].x); vr[1] = bfhi(wkr[k].x); vr[2] = bflo(wkr[k].y); vr[3] = bfhi(wkr[k].y);
                  float ss = vr[0] * vr[0] + vr[1] * vr[1] + vr[2] * vr[2] + vr[3] * vr[3];
#pragma unroll
                  for (int j = 0; j < 8; ++j) ss += vn[j] * vn[j];
                  ss = red8(ss); const float mul = rsqrtf(ss * (1.0f / 96.0f) + EPS);
#pragma unroll
                  for (int j = 0; j < 8; ++j) vn[j] *= mul * gkn[j];
#pragma unroll
                  for (int j = 0; j < 4; ++j) vr[j] *= mul * gkr[j];
                  const float a0 = vr[0] * cm[k][0] - vr[1] * sm[k][0], a1 = vr[1] * cm[k][0] + vr[0] * sm[k][0], a2 = vr[2] * cm[k][1] - vr[3] * sm[k][1], a3 = vr[3] * cm[k][1] + vr[2] * sm[k][1];
                  bf16_t* d = KM + ((size_t)(b * 8 + hd) * TT + t) * 96;
                  *(u32x4*)(d + 8 * s) = pack8(vn); u32x2 o; o.x = pk2(a0, a1); o.y = pk2(a2, a3); *(u32x2*)(d + 64 + 4 * s) = o; }
            }
            }
        } else if (type == 1) {
#pragma unroll 1
            for (int kb4 = 0; kb4 < 8; kb4 += 4) {
                u32x4 wdq[4], wdk[4]; f32x4 cd[4], sd[4];
#pragma unroll
                for (int k = 0; k < 4; ++k) { const int tl = wid * 8 + kb4 + k, r = r0 + tl, spos = spos0 + tl;
                    const bf16_t* prow = PROJ + (size_t)r * INWP;
                    wdq[k] = *(const u32x4*)(prow + O_DQ + lane * 8); wdk[k] = *(const u32x4*)(prow + O_DK + lane * 8);
                    cd[k] = *(const f32x4*)(TABD + (latent ? spos : 0) * 64 + 4 * s); sd[k] = *(const f32x4*)(TABD + (latent ? spos : 0) * 64 + 32 + 4 * s); }
#pragma unroll
                for (int k = 0; k < 4; ++k) { const int tl = wid * 8 + kb4 + k, t = t0 + tl;
#pragma unroll
                    for (int j = 0; j < 4; ++j) { cd[k][j] = latent ? cd[k][j] : 1.f; sd[k][j] = latent ? sd[k][j] : 0.f; }
#pragma unroll
                    for (int qk = 0; qk < 2; ++qk) { float v[8]; unpack8(qk ? wdk[k] : wdq[k], v, 1.0f); float ss = 0.f;
#pragma unroll
                      for (int j = 0; j < 8; ++j) ss += v[j] * v[j];
                      ss = red8(ss); const float mul = rsqrtf(ss * (1.0f / 64.0f) + EPS) * (qk ? 1.0f : qsd);
#pragma unroll
                      for (int j = 0; j < 8; ++j) v[j] *= mul * (qk ? gdk[j] : gdq[j]);
                      float o[8];
#pragma unroll
                      for (int jj = 0; jj < 4; ++jj) { o[2 * jj] = v[2 * jj] * cd[k][jj] - v[2 * jj + 1] * sd[k][jj]; o[2 * jj + 1] = v[2 * jj + 1] * cd[k][jj] + v[2 * jj] * sd[k][jj]; }
                      bf16_t* d = (qk ? KD : QD) + ((size_t)(b * 8 + hd) * TT + t) * 64 + 8 * s;
                      *(u32x4*)d = pack8(o); }
                }
            }
        } else if (type < 4) {
#pragma unroll 4
            for (int k = 0; k < 8; ++k) {
                const int tl = wid * 8 + k, r = r0 + tl;
                const bf16_t* prow = PROJ + (size_t)r * INWP;
                const bool mla = (type == 2);
                float s2 = sumsq8(*(const u32x4*)(prow + O_CKV + (lane < 32 ? lane : 0) * 8)); s2 = lane < 32 ? s2 : 0.f;
                const bf16_t* wsrc = mla ? KVRAW + (size_t)r * 1024 + hd * 128 + 64 + 8 * s : prow + O_DV + lane * 8;
                const u32x4 w = *(const u32x4*)wsrc;
                s2 = wave_sum(s2); const float sc = mla ? rsqrtf(s2 * (1.0f / 256.0f) + EPS) : 1.0f;
                float v[8]; unpack8(w, v, sc);
                const u32x4 o = pack8(v); const unsigned ow[4] = {o.x, o.y, o.z, o.w};
                LAS bf16_t* dl = (LAS bf16_t*)(Vl + (size_t)(hd * 64 + 8 * s) * 144) + tl;
#pragma unroll
                for (int j = 0; j < 4; ++j) { dl[(2 * j) * 72] = (bf16_t)(ow[j] & 0xffffu); dl[(2 * j + 1) * 72] = (bf16_t)(ow[j] >> 16); }
            }
            __syncthreads();
            { bf16_t* VT = type == 2 ? VTM : VTD;
#pragma unroll
              for (int kk = 0; kk < 8; ++kk) { const int row = (tid >> 3) + 64 * kk, ch = tid & 7;
                  const u32x4 w = *(LAS const u32x4*)(Vl + row * 144 + ch * 16);
                  *(u32x4*)(VT + ((size_t)(b * 512 + row) * TT + t0 + ch * 8)) = w; } }
            __syncthreads();
        } else {
            float w0[8], w1[8], w2[8];
            { const f32x4 a = *(const f32x4*)(cw + lane * 8), a2 = *(const f32x4*)(cw + lane * 8 + 4), b1 = *(const f32x4*)(cw + 512 + lane * 8), b2 = *(const f32x4*)(cw + 512 + lane * 8 + 4),
                          c1 = *(const f32x4*)(cw + 1024 + lane * 8), c2 = *(const f32x4*)(cw + 1024 + lane * 8 + 4);
#pragma unroll
              for (int j = 0; j < 4; ++j) { w0[j] = a[j]; w0[4 + j] = a2[j]; w1[j] = b1[j]; w1[4 + j] = b2[j]; w2[j] = c1[j]; w2[4 + j] = c2[j]; } }
            const int rf = r0 + wid * 8, sf = spos0 + wid * 8;
            const bf16_t* pb = PROJ + (size_t)rf * INWP + lane * 8;
            float up[8], uc[8];
#pragma unroll
            for (int j = 0; j < 8; ++j) up[j] = 0.f;
            { const bool hasp = sf > 0; const bf16_t* pp = hasp ? pb - (size_t)INWP : pb;
              float a[8], c[8]; unpack8(*(const u32x4*)(pp + O_CC), a, 1.0f); unpack8(*(const u32x4*)(pp + O_CX), c, 1.0f);
#pragma unroll
              for (int j = 0; j < 8; ++j) up[j] = hasp ? a[j] * c[j] : 0.f; }
            { float a[8], c[8]; unpack8(*(const u32x4*)(pb + O_CC), a, 1.0f); unpack8(*(const u32x4*)(pb + O_CX), c, 1.0f);
#pragma unroll
              for (int j = 0; j < 8; ++j) uc[j] = a[j] * c[j]; }
#pragma unroll
            for (int k = 0; k < 8; ++k) { const bf16_t* q = pb + (size_t)k * INWP;
                float un[8];
                { const bool hasn = sf + k + 1 < seglen; const bf16_t* qn = hasn ? q + INWP : q;
                  float a[8], c[8]; unpack8(*(const u32x4*)(qn + O_CC), a, 1.0f); unpack8(*(const u32x4*)(qn + O_CX), c, 1.0f);
#pragma unroll
                  for (int j = 0; j < 8; ++j) un[j] = hasn ? a[j] * c[j] : 0.f; }
                float cb[8]; unpack8(*(const u32x4*)(q + O_CB), cb, 1.0f);
                float y[8];
#pragma unroll
                for (int j = 0; j < 8; ++j) y[j] = cb[j] * (w0[j] * up[j] + w1[j] * uc[j] + w2[j] * un[j]);
                *(u32x4*)(Y2 + (size_t)(rf + k) * 1536 + lane * 8) = pack8(y);
#pragma unroll
                for (int j = 0; j < 8; ++j) { up[j] = uc[j]; uc[j] = un[j]; } }
        }
    }
}

DI void prep_phase(const Params& p, int l, LAS unsigned char* ldsb) {
    const float* TABM = (const float*)(p.ws + WS_TAB);
    prep_body(p, l, ldsb, (const bf16_t*)(p.ws + WS_PROJ), (const bf16_t*)(p.ws + WS_R1), (const bf16_t*)(p.ws + WS_R1 + R1_KVRAW),
              (bf16_t*)(p.ws + WS_QKV + Q_QM), (bf16_t*)(p.ws + WS_QKV + Q_KM), (bf16_t*)(p.ws + WS_QKV + Q_VTM), (bf16_t*)(p.ws + WS_QKV + Q_QD), (bf16_t*)(p.ws + WS_QKV + Q_KD), (bf16_t*)(p.ws + WS_QKV + Q_VTD),
              (bf16_t*)(p.ws + WS_Y) + 1024, TABM, TABM + 2048 * 32, p.in[22] + (size_t)l * 3 * 512);
}

template <int KC, int DS, bool DIFF>
DI void attn_item(LAS unsigned char* lds, const bf16_t* Qw  , const bf16_t* K0, const bf16_t* K1, const bf16_t* Vt, int nkeys, float cshift,
                  f32x4 (&oacc)[DS][2], float (&lsum)[2]) {
    constexpr int DK = KC * 32, KROW = DK * 2 + 32, VROW = 160, DV = DS * 16;
    constexpr int KBYTES = (DIFF ? 2 : 1) * 64 * KROW, STG = KBYTES + DV * VROW;
    const int tid = tidx(), wid = tid >> 6, lane = tid & 63, fr = lane & 15, fq = lane >> 4;
    const int comp = DIFF ? (wid >> 2) : 0;
    const int vpos = (((tid & 7) >> 2) * 32 + (tid & 1) * 16 + ((tid >> 1) & 1) * 4) * 2;
    bf16x8 qf[2][KC];
#pragma unroll
    for (int qs = 0; qs < 2; ++qs)
#pragma unroll
        for (int kc = 0; kc < KC; ++kc) qf[qs][kc] = *(const bf16x8*)(Qw + (size_t)(qs * 16 + fr) * DK + kc * 32 + fq * 8);
#pragma unroll
    for (int ds = 0; ds < DS; ++ds) { oacc[ds][0] = (f32x4){0.f, 0.f, 0.f, 0.f}; oacc[ds][1] = (f32x4){0.f, 0.f, 0.f, 0.f}; }
    lsum[0] = 0.f; lsum[1] = 0.f;
    u32x4 rk0, rk1, rv0, rv1;
    auto gload = [&](int t) {
        if constexpr (!DIFF) {
            const char* kb = (const char*)K0 + (size_t)t * 64 * DK * 2;
            rk0 = *(const u32x4*)(kb + tid * 16);
            if (tid < 256) rk1 = *(const u32x4*)(kb + (512 + tid) * 16);
            rv0 = *(const u32x4*)((const char*)Vt + (size_t)(tid >> 3) * TT * 2 + (size_t)t * 128 + (tid & 7) * 16);
        } else {
            rk0 = *(const u32x4*)((const char*)K0 + (size_t)t * 64 * DK * 2 + tid * 16);
            rk1 = *(const u32x4*)((const char*)K1 + (size_t)t * 64 * DK * 2 + tid * 16);
            rv0 = *(const u32x4*)((const char*)Vt + (size_t)(tid >> 3) * TT * 2 + (size_t)t * 128 + (tid & 7) * 16);
            rv1 = *(const u32x4*)((const char*)Vt + (size_t)(64 + (tid >> 3)) * TT * 2 + (size_t)t * 128 + (tid & 7) * 16);
        }
    };
    auto lstore = [&](int st) {
        LAS unsigned char* kb = lds + st * STG; LAS unsigned char* vb = kb + KBYTES;
        if constexpr (!DIFF) {
            { const int key = tid / 12, pc = tid - key * 12; *(LAS u32x4*)(kb + key * KROW + pc * 16) = rk0; }
            if (tid < 256) { const int c = 512 + tid, key = c / 12, pc = c - key * 12; *(LAS u32x4*)(kb + key * KROW + pc * 16) = rk1; }
            { LAS unsigned char* d = vb + (tid >> 3) * VROW + vpos; *(LAS u32x2*)d = (u32x2){rv0.x, rv0.y}; *(LAS u32x2*)(d + 16) = (u32x2){rv0.z, rv0.w}; }
        } else {
            *(LAS u32x4*)(kb + (tid >> 3) * KROW + (tid & 7) * 16) = rk0;
            *(LAS u32x4*)(kb + 64 * KROW + (tid >> 3) * KROW + (tid & 7) * 16) = rk1;
            { LAS unsigned char* d = vb + (tid >> 3) * VROW + vpos; *(LAS u32x2*)d = (u32x2){rv0.x, rv0.y}; *(LAS u32x2*)(d + 16) = (u32x2){rv0.z, rv0.w}; }
            { LAS unsigned char* d = vb + (64 + (tid >> 3)) * VROW + vpos; *(LAS u32x2*)d = (u32x2){rv1.x, rv1.y}; *(LAS u32x2*)(d + 16) = (u32x2){rv1.z, rv1.w}; }
        }
    };
    auto readK = [&](int st, int kk, bf16x8 (&kf)[2][KC]) {
        LAS const unsigned char* kb = lds + st * STG + comp * 64 * KROW;
#pragma unroll
        for (int kc = 0; kc < KC; ++kc)
#pragma unroll
            for (int ks = 0; ks < 2; ++ks) kf[ks][kc] = *(LAS const bf16x8*)(kb + ((2 * kk + ks) * 16 + fr) * KROW + (kc * 32 + fq * 8) * 2);
    };
    auto readV = [&](int st, int kk, int d0, bf16x8 (&vf)[4]) {
        LAS const unsigned char* vb = lds + st * STG + KBYTES;
#pragma unroll
        for (int i = 0; i < 4; ++i) vf[i] = *(LAS const bf16x8*)(vb + ((d0 + i) * 16 + fr) * VROW + (kk * 32 + fq * 8) * 2);
    };
    auto smma = [&](const bf16x8 (&kf)[2][KC], f32x4 (&sacc)[2][2]) {
#pragma unroll
        for (int ks = 0; ks < 2; ++ks) { sacc[ks][0] = (f32x4){-cshift, -cshift, -cshift, -cshift}; sacc[ks][1] = (f32x4){-cshift, -cshift, -cshift, -cshift}; }
#pragma unroll
        for (int kc = 0; kc < KC; ++kc)
#pragma unroll
            for (int ks = 0; ks < 2; ++ks)
#pragma unroll
                for (int qs = 0; qs < 2; ++qs) sacc[ks][qs] = __builtin_amdgcn_mfma_f32_16x16x32_bf16(kf[ks][kc], qf[qs][kc], sacc[ks][qs], 0, 0, 0);
    };
    auto softmax = [&](const f32x4 (&sacc)[2][2], bf16x8 (&pb)[2]) {
#pragma unroll
        for (int qs = 0; qs < 2; ++qs) {
            float e[8];
#pragma unroll
            for (int j = 0; j < 4; ++j) { e[j] = __builtin_amdgcn_exp2f(sacc[0][qs][j]); e[4 + j] = __builtin_amdgcn_exp2f(sacc[1][qs][j]); }
            lsum[qs] += ((e[0] + e[1]) + (e[2] + e[3])) + ((e[4] + e[5]) + (e[6] + e[7]));
            u32x4 w; w.x = pk2(e[0], e[1]); w.y = pk2(e[2], e[3]); w.z = pk2(e[4], e[5]); w.w = pk2(e[6], e[7]);
            pb[qs] = __builtin_bit_cast(bf16x8, w);
        }
    };
    auto pv4 = [&](const bf16x8 (&vf)[4], int d0, const bf16x8 (&pb)[2]) {
#pragma unroll
        for (int i = 0; i < 4; ++i)
#pragma unroll
            for (int qs = 0; qs < 2; ++qs) oacc[d0 + i][qs] = __builtin_amdgcn_mfma_f32_16x16x32_bf16(vf[i], pb[qs], oacc[d0 + i][qs], 0, 0, 0);
    };
#define SB() __builtin_amdgcn_sched_barrier(0)
    const int ntiles = nkeys >> 6;
    if constexpr (!DIFF) {
        gload(0); lstore(0); gload(1); lstore(1);
        __syncthreads();
        f32x4 sA[2][2], sB[2][2]; bf16x8 pb[2]; bf16x8 kf[2][KC]; bf16x8 vf[4];
        readK(0, 0, kf); smma(kf, sA);
        int st = 0;
        auto iter = [&](auto m1c, auto m2c, int t) {
            constexpr bool m1 = decltype(m1c)::value, m2 = decltype(m2c)::value;
            const int st1 = (st == 2) ? 0 : st + 1, st2 = (st1 == 2) ? 0 : st1 + 1;
            if constexpr (m2) gload(t + 2);
            readK(st, 1, kf); readV(st, 0, 0, vf); SB();
            smma(kf, sB); softmax(sA, pb);
            pv4(vf, 0, pb); SB();
            if constexpr (m1) readK(st1, 0, kf);
            readV(st, 1, 0, vf); SB();
            if constexpr (m1) smma(kf, sA);
            softmax(sB, pb);
            pv4(vf, 0, pb); SB();
            if constexpr (m2) lstore(st2);
            __syncthreads();
            st = st1;
        };
#pragma unroll 1
        for (int t = 0; t + 2 < ntiles; ++t) iter(std::true_type{}, std::true_type{}, t);
        iter(std::true_type{}, std::false_type{}, ntiles - 2);
        iter(std::false_type{}, std::false_type{}, ntiles - 1);
    } else {
        gload(0); lstore(0);
        __syncthreads();
        f32x4 sA[2][2]; bf16x8 pb[2]; bf16x8 kf[2][KC]; bf16x8 vf[4], vg[4];
        auto iter = [&](auto morec, int t) {
            constexpr bool more = decltype(morec)::value;
            const int st = t & 1;
            if constexpr (more) gload(t + 1);
#pragma unroll
            for (int kk = 0; kk < 2; ++kk) {
                readK(st, kk, kf); readV(st, kk, 0, vf); SB();
                smma(kf, sA); softmax(sA, pb); readV(st, kk, 4, vg);
                pv4(vf, 0, pb);
                pv4(vg, 4, pb); SB();
            }
            if constexpr (more) lstore((t + 1) & 1);
            __syncthreads();
        };
#pragma unroll 1
        for (int t = 0; t + 1 < ntiles; ++t) iter(std::true_type{}, t);
        iter(std::false_type{}, ntiles - 1);
    }
#undef SB
#pragma unroll
    for (int qs = 0; qs < 2; ++qs) { lsum[qs] += __shfl_xor(lsum[qs], 16); lsum[qs] += __shfl_xor(lsum[qs], 32); }
}

DI void attn_phase(const Params& p, int l, bool need_ctx, LAS unsigned char* lds) {
    const int tid = tidx(), wid = tid >> 6, lane = tid & 63, fr = lane & 15, fq = lane >> 4;
    const bf16_t* QM = (const bf16_t*)(p.ws + WS_QKV + Q_QM); const bf16_t* KM = (const bf16_t*)(p.ws + WS_QKV + Q_KM); const bf16_t* VTM = (const bf16_t*)(p.ws + WS_QKV + Q_VTM);
    const bf16_t* QD = (const bf16_t*)(p.ws + WS_QKV + Q_QD); const bf16_t* KD = (const bf16_t*)(p.ws + WS_QKV + Q_KD); const bf16_t* VTD = (const bf16_t*)(p.ws + WS_QKV + Q_VTD);
    bf16_t* Y0 = (bf16_t*)(p.ws + WS_Y); bf16_t* Y1 = Y0 + 512;
    float gq = 0.f, gk = 0.f;
    { const float a = lane < 48 ? fmaxf(fabsf(p.in[16][l * 96 + lane]), fabsf(p.in[16][l * 96 + 48 + lane])) : 0.f; gq = wave_max(a);
      const float b = lane < 48 ? fmaxf(fabsf(p.in[17][l * 96 + lane]), fabsf(p.in[17][l * 96 + 48 + lane])) : 0.f; gk = wave_max(b); }
    const float cs_m = gq * gk * 9.797958971132712f * LOG2E;
    { gq = wave_max(fabsf(p.in[18][l * 64 + lane])); gk = wave_max(fabsf(p.in[19][l * 64 + lane])); }
    const float cs_d = gq * gk * 8.0f * LOG2E;
    const float li = lam_init_of(l);
    float lam;
    { const float* lv = p.in[20] + (size_t)l * 256; const float s1 = wave_sum(lv[lane] * lv[64 + lane]), s2 = wave_sum(lv[128 + lane] * lv[192 + lane]); lam = expf(s1) - expf(s2) + li; }
    const float* gsub = p.in[21] + l * 128;
    const int first = need_ctx ? 0 : 128;
    for (int item = first + blockIdx.x; item < 1152; item += gridDim.x) {
        if (item < 64 || (item >= 128 && item < 640)) {
            int bh, tq0, nkeys;
            if (item < 64) { bh = item; tq0 = 0; nkeys = 256; } else { const int i = item - 128; bh = (i >> 8) * 32 + (i & 31); tq0 = 256 + ((i >> 5) & 7) * 256; nkeys = TT; }
            const int b = bh >> 3, h = bh & 7;
            f32x4 oacc[4][2]; float lsum[2];
            attn_item<3, 4, false>(lds, QM + ((size_t)bh * TT + tq0 + wid * 32) * 96, KM + (size_t)bh * TT * 96, nullptr, VTM + (size_t)bh * 64 * TT, nkeys, cs_m, oacc, lsum);
#pragma unroll
            for (int qs = 0; qs < 2; ++qs) { const float inv = 1.0f / lsum[qs]; const int tq = tq0 + wid * 32 + qs * 16 + fr;
                const size_t row = tq >= 256 ? (size_t)b * 2048 + (tq - 256) : (size_t)ML + b * 256 + tq;
#pragma unroll
                for (int ds = 0; ds < 4; ++ds) { const f32x4 o = oacc[ds][qs] * inv; u32x2 w; w.x = pk2(o[0], o[1]); w.y = pk2(o[2], o[3]);
                    *(u32x2*)(Y0 + row * 1536 + h * 64 + ds * 16 + fq * 4) = w; } }
        } else {
            int bh, tq0, nkeys;
            if (item < 128) { const int i = item - 64; bh = i & 31; tq0 = (i >> 5) * 128; nkeys = 256; } else { const int i = item - 640; bh = (i >> 8) * 16 + (i & 15); tq0 = 256 + ((i >> 4) & 15) * 128; nkeys = TT; }
            const int b = bh >> 2, h = bh & 3, comp = wid >> 2, wq = wid & 3;
            f32x4 oacc[8][2]; float lsum[2];
            const size_t kvec = (size_t)(bh * 2) * TT * 64;
            attn_item<2, 8, true>(lds, QD + ((size_t)(bh * 2 + comp) * TT + tq0 + wq * 32) * 64, KD + kvec, KD + kvec + (size_t)TT * 64, VTD + (size_t)bh * 128 * TT, nkeys, cs_d, oacc, lsum);
            LAS float* X = (LAS float*)lds;
            if (comp == 1) {
#pragma unroll
                for (int qs = 0; qs < 2; ++qs) { const float sc = lam / lsum[qs]; const int ql = wq * 32 + qs * 16 + fr;
#pragma unroll
                    for (int ds = 0; ds < 8; ++ds) *(LAS f32x4*)(X + ql * 132 + ds * 16 + fq * 4) = oacc[ds][qs] * sc; }
            }
            __syncthreads();
            if (comp == 0) {
#pragma unroll
                for (int qs = 0; qs < 2; ++qs) { const float inv = 1.0f / lsum[qs]; const int ql = wq * 32 + qs * 16 + fr; const int tq = tq0 + ql;
                    float ss = 0.f;
#pragma unroll
                    for (int ds = 0; ds < 8; ++ds) { const f32x4 o2 = *(LAS const f32x4*)(X + ql * 132 + ds * 16 + fq * 4); const f32x4 o = oacc[ds][qs] * inv - o2; oacc[ds][qs] = o;
                        ss += o[0] * o[0] + o[1] * o[1] + o[2] * o[2] + o[3] * o[3]; }
                    ss += __shfl_xor(ss, 16); ss += __shfl_xor(ss, 32);
                    const float rs = rsqrtf(ss * (1.0f / 128.0f) + EPS) * (1.0f - li);
                    const size_t row = tq >= 256 ? (size_t)b * 2048 + (tq - 256) : (size_t)ML + b * 256 + tq;
#pragma unroll
                    for (int ds = 0; ds < 8; ++ds) { const f32x4 gg = *(const f32x4*)(gsub + ds * 16 + fq * 4); const f32x4 o = oacc[ds][qs] * rs * gg;
                        u32x2 w; w.x = pk2(o[0], o[1]); w.y = pk2(o[2], o[3]);
                        *(u32x2*)(Y1 + row * 1536 + h * 128 + ds * 16 + fq * 4) = w; } }
            }
            __syncthreads();
        }
    }
}

#define XB_TMO      128
#define XB_XCNT(j)  (256  + 64 * (j))
#define XB_XSUB(j)  (1280 + 64 * (j))
#define XB_XGEN(j)  (2304 + 64 * (j))
#define XB_TOP      3328
#define XB_TOPGEN   3392
#define XCD_BAR_WORDS 3456
#define XB_SPIN_CAP (1u << 18)
DI unsigned xb_ld(unsigned* p) { return __hip_atomic_load(p, __ATOMIC_RELAXED, __HIP_MEMORY_SCOPE_AGENT); }
DI unsigned xb_add(unsigned* p, unsigned v) { return __hip_atomic_fetch_add(p, v, __ATOMIC_RELAXED, __HIP_MEMORY_SCOPE_AGENT); }
DI unsigned xb_xcc_id() { return (unsigned)__builtin_amdgcn_s_getreg((3 << 11) | 20) & 0xFu; }
#define XB_SPIN(cond, bar) do { unsigned _sp = 0; while (cond) { __builtin_amdgcn_s_sleep(1); \
    if ((++_sp & 255u) == 0u) { if (xb_ld(&(bar)[XB_TMO])) break; if (_sp > XB_SPIN_CAP) { atomicAdd(&(bar)[XB_TMO], 1u); break; } } } } while (0)
struct XcdBarrier { unsigned* bar; unsigned x; volatile LAS unsigned* st; };
DI XcdBarrier xcd_barrier_post(unsigned* bar, volatile LAS unsigned* st) {
    XcdBarrier b; b.bar = bar; b.x = xb_xcc_id(); b.st = st;
    if (threadIdx.x == 0) (void)xb_add(&bar[XB_XCNT(b.x)], 1u);
    return b;
}
DI void xcd_barrier_complete(unsigned* bar, unsigned x, unsigned& nloc, unsigned& nx) {
    const unsigned G = gridDim.x * gridDim.y * gridDim.z;
    unsigned sum, cnt, mine, sp = 0u;
    for (;;) {
        sum = 0u; cnt = 0u; mine = 0u;
#pragma unroll
        for (unsigned j = 0; j < 16; ++j) { const unsigned c = xb_ld(&bar[XB_XCNT(j)]); sum += c; cnt += (c > 0u) ? 1u : 0u; mine = (j == x) ? c : mine; }
        if (sum == G) break;
        __builtin_amdgcn_s_sleep(1);
        if ((++sp & 255u) == 0u) { if (xb_ld(&bar[XB_TMO])) break; if (sp > XB_SPIN_CAP) { atomicAdd(&bar[XB_TMO], 1u); break; } }
    }
    nloc = mine > 0u ? mine : 1u; nx = cnt > 0u ? cnt : 1u;
}
DI void xcd_barrier(const XcdBarrier& b) {
    asm volatile("s_waitcnt vmcnt(0)" ::: "memory");
    __syncthreads();
    if (threadIdx.x == 0) {
        unsigned* bar = b.bar;
        __builtin_amdgcn_s_waitcnt(0);
        unsigned nloc = b.st[0], nx = b.st[1];
        if (nloc == 0u) { xcd_barrier_complete(bar, b.x, nloc, nx); b.st[0] = nloc; b.st[1] = nx; }
        const unsigned old = xb_add(&bar[XB_XSUB(b.x)], 1u);
        const unsigned gen = old / nloc;
        if (old + 1u == (gen + 1u) * nloc) {
            __builtin_amdgcn_fence(__ATOMIC_RELEASE, "agent");
            asm volatile("s_waitcnt vmcnt(0)" ::: "memory");
            const unsigned og = xb_add(&bar[XB_TOP], 1u);
            const unsigned tg = og / nx;
            if (og + 1u == (tg + 1u) * nx) xb_add(&bar[XB_TOPGEN], 1u);
            else XB_SPIN(xb_ld(&bar[XB_TOPGEN]) == tg, bar);
            __builtin_amdgcn_fence(__ATOMIC_ACQUIRE, "agent");
            xb_add(&bar[XB_XGEN(b.x)], 1u);
            asm volatile("s_waitcnt vmcnt(0)" ::: "memory");
        } else {
            XB_SPIN(xb_ld(&bar[XB_XGEN(b.x)]) == gen, bar);
            __builtin_amdgcn_fence(__ATOMIC_ACQUIRE, "agent");
            asm volatile("s_waitcnt vmcnt(0)" ::: "memory");
        }
    }
    __syncthreads();
}

#ifndef PROBE_MASK
#define PROBE_MASK 0
#endif
#define REPS(bit) for (int rep_ = 0; rep_ < (((PROBE_MASK) >> (bit)) & 1) + 1; ++rep_)
typedef const __attribute__((address_space(4))) Params* KP;
#define PH_BEGIN KP pp_ = (KP)__builtin_amdgcn_kernarg_segment_ptr(); asm volatile("" : "+s"(pp_)); const Params& p = *(const Params*)pp_; \
    int G = gridDim.x, c = blockIdx.x; asm volatile("" : "+s"(G), "+s"(c)); \
    float* XL = p.out; float* XC = (float*)(p.ws + WS_XC); const float* modl = (const float*)(p.ws + WS_MOD) + (size_t)l * 9 * 9216; const float* ng = p.in[6] + (size_t)l * 3 * 1024; \
    bf16_t* W = (bf16_t*)(p.ws + ((l & 1) ? WS_W2 : WS_W)); bf16_t* H = (bf16_t*)(p.ws + WS_R1); bf16_t* MB = H; bf16_t* QRAW = H; bf16_t* KVRAW = (bf16_t*)(p.ws + WS_R1 + R1_KVRAW); \
    bf16_t* PROJ = (bf16_t*)(p.ws + WS_PROJ); bf16_t* ACT = PROJ; float* MACC = (float*)(p.ws + WS_QKV); float* PART = MACC; bf16_t* Y = (bf16_t*)(p.ws + WS_Y); \
    (void)G; (void)c; (void)XL; (void)XC; (void)modl; (void)ng; (void)W; (void)H; (void)MB; (void)QRAW; (void)KVRAW; (void)PROJ; (void)ACT; (void)MACC; (void)Y; (void)PART;

__global__ void __launch_bounds__(512, 2) fwd_megakernel(Params p_unused) {
    extern __shared__ __attribute__((aligned(16))) unsigned char shm[];
    LAS unsigned char* lds = (LAS unsigned char*)shm;
    cg::grid_group grid = cg::this_grid();
    volatile LAS unsigned* xst = (volatile LAS unsigned*)(lds + pg8::STAGE_BYTES);
    if (threadIdx.x < 4) xst[threadIdx.x] = 0u;
    __syncthreads();
    XcdBarrier xb;
    { KP pp_ = (KP)__builtin_amdgcn_kernarg_segment_ptr(); xb = xcd_barrier_post((unsigned*)(pp_->ws + WS_BAR), xst); }
#define GSYNC() xcd_barrier(xb)

    REPS(6) { int l = 0; PH_BEGIN; mod_phase(p, lds); }
    { int l = 0; PH_BEGIN; tab_phase(p); }
    REPS(6) { int l = 0; PH_BEGIN; conv_weights(p, 0, lds, W, c, G); }
    grid.sync();

#pragma unroll 1
    for (int lq = 0; lq < DEPTH; ++lq) {
        int l = lq; asm volatile("" : "+s"(l));
        const bool last = (l == DEPTH - 1);
        const int Mx = last ? ML : MT;
        REPS(2) { PH_BEGIN; if (l == 0) norm_phase(p.in[0], p.in[2], XL, XC, true, H, ng, modl, 0, 1, MT, PART, 0); else norm_phase(XL, XC, XL, XC, false, H, ng, modl, 0, 1, MT, PART, 4); }
        GSYNC();
        REPS(1) { PH_BEGIN; pg8::Sched S; S.init(MT, 5632, 1024, G, c); pg8::Gemm g{H, W + W_1U, 1024, 1024}; EpiSwiglu E{ACT}; pg8::gemm_phase(lds, g, S, E); }
        GSYNC();
        { PH_BEGIN; pg8::Sched S; S.init(ML, 1024, DFF, G, c); S.add_split(MC / 256, ML / 256, 4); pg8::Gemm g{ACT, W + W_1D, DFF, DFF}; EpiResid E{XL, XC, modl, 2, 0.5f, PART}; pg8::gemm_phase(lds, g, S, E); }
        GSYNC();
        REPS(2) { PH_BEGIN; norm_phase(XL, XC, XL, XC, false, H, ng + 1024, modl, 3, 4, MT, PART, 4); }
        GSYNC();
        if (!last) { REPS(1) { PH_BEGIN; pg8::Sched S; S.init(MT, INWP, 1024, G, c); pg8::Gemm g{H, W + W_IN, 1024, 1024}; EpiStore E{PROJ, INWP, O_G}; pg8::gemm_phase(lds, g, S, E); } }
        else {
            { PH_BEGIN; pg8::Sched S; S.init(ML, INWP, 1024, G, c); pg8::Gemm g{H, W + W_IN, 1024, 1024}; EpiStore E{PROJ, INWP, O_G}; pg8::gemm_phase(lds, g, S, E); }
            { PH_BEGIN; pg8::Sched S; S.init(MC, 2048, 1024, G, (c + 64) % G); pg8::Gemm g{H + (size_t)ML * 1024, W + W_IN + (size_t)256 * 1024, 1024, 1024}; EpiStore E{PROJ + (size_t)ML * INWP + 256, INWP, 1 << 30}; pg8::gemm_phase(lds, g, S, E); }
        }
        GSYNC();
        REPS(2) { PH_BEGIN; pg8::Sched S; S.init(MT, 768, 384, G, c); pg8::Gemm g{PROJ + O_CQ, W + W_UQ, INWP, 384}; EpiStore E{QRAW, 768, 1 << 30}; pg8::gemm_phase(lds, g, S, E); }
        REPS(2) { PH_BEGIN; pg8::Sched S; S.init(MT, 1024, 256, G, (c + 40) % G); pg8::Gemm g{PROJ + O_CKV, W + W_UKV, INWP, 256}; EpiStore E{KVRAW, 1024, 1 << 30}; pg8::gemm_phase(lds, g, S, E); }
        GSYNC();
        REPS(2) { PH_BEGIN; prep_phase(p, l, lds); }
        GSYNC();
        REPS(0) { PH_BEGIN; attn_phase(p, l, !last, lds); }
        GSYNC();
        { PH_BEGIN; pg8::Sched S; S.init(Mx, 1024, 512, G, c, 3, 0, 0); S.kseg = 512; pg8::Gemm g{Y, W + W_BR, 1536, 1536}; EpiMerge E{MB, PROJ}; pg8::gemm_phase(lds, g, S, E);
          { int heavy = (MT / 256) * 4 - G; if (heavy < 0 || heavy >= G) heavy = 0;
            if (!last && c >= heavy) { bf16_t* Wn = (bf16_t*)(p.ws + (((l + 1) & 1) ? WS_W2 : WS_W)); conv_weights(p, l + 1, lds, Wn, c - heavy, G - heavy); } } }
        GSYNC();
        for (int r_ = 0; r_ < 6 * (((PROBE_MASK) >> 3) & 1); ++r_) GSYNC();
        { PH_BEGIN; pg8::Sched S; S.init(ML, 1024, 1024, G, c); if (!last) S.add_split(MC / 256, ML / 256, 4); pg8::Gemm g{MB, W + W_O, 1024, 1024}; EpiResid E{XL, XC, modl, 5, 1.0f, PART}; pg8::gemm_phase(lds, g, S, E); }
        GSYNC();
        REPS(2) { PH_BEGIN; norm_phase(XL, XC, XL, XC, false, H, ng + 2048, modl, 6, 7, Mx, PART, last ? 0 : 4); }
        GSYNC();
        REPS(1) { PH_BEGIN; pg8::Sched S; S.init(Mx, 5632, 1024, G, c); pg8::Gemm g{H, W + W_2U, 1024, 1024}; EpiSwiglu E{ACT}; pg8::gemm_phase(lds, g, S, E); }
        GSYNC();
        { PH_BEGIN; pg8::Sched S; S.init(ML, 1024, DFF, G, c); if (!last) S.add_split(MC / 256, ML / 256, 4); pg8::Gemm g{ACT, W + W_2D, DFF, DFF}; EpiResid E{XL, XC, modl, 8, 0.5f, PART}; pg8::gemm_phase(lds, g, S, E); }
        GSYNC();
    }
}

extern "C" void kernel_launch(void* const* d_in, const int* in_sizes, int n_in, void* d_out, int out_size, void* d_ws, size_t ws_size, hipStream_t stream) {
    constexpr int LDS_BYTES = pg8::STAGE_BYTES + 16;
    static int grid = 0;
    if (grid == 0) {
        if (n_in != 25 || ws_size < WS_END) { fprintf(stderr, "kernel_launch: bad inputs (n_in %d, ws %zu need %zu)\n", n_in, ws_size, (size_t)WS_END); grid = -1; return; }
        int dev = 0, cus = 0, per_cu = 0;
        hipGetDevice(&dev);
        hipDeviceGetAttribute(&cus, hipDeviceAttributeMultiprocessorCount, dev);
        hipFuncSetAttribute((const void*)fwd_megakernel, hipFuncAttributeMaxDynamicSharedMemorySize, LDS_BYTES);
        hipOccupancyMaxActiveBlocksPerMultiprocessor(&per_cu, (const void*)fwd_megakernel, 512, LDS_BYTES);
        if (per_cu < 1) per_cu = 1;
        (void)hipGetLastError();
        grid = cus;
    }
    if (grid < 0) return;
    Params p{};
    for (int i = 0; i < 25; ++i) p.in[i] = (const float*)d_in[i];
    p.out = (float*)d_out; p.ws = (unsigned char*)d_ws;
    (void)hipMemsetAsync((unsigned char*)d_ws + WS_BAR, 0, XCD_BAR_WORDS * 4, stream);
    void* args[] = {&p};
    hipError_t e = hipLaunchCooperativeKernel((const void*)fwd_megakernel, dim3(grid), dim3(512), args, LDS_BYTES, stream);
    if (e != hipSuccess) fprintf(stderr, "cooperative launch failed: %s (grid %d)\n", hipGetErrorString(e), grid);
}
```

```cpp
#include <hip/hip_runtime.h>
#include <hip/hip_cooperative_groups.h>
#include <cstdio>
#include <type_traits>
namespace cg = cooperative_groups;

#define LAS __attribute__((address_space(3)))
typedef unsigned short bf16_t;
typedef short bf16x8 __attribute__((ext_vector_type(8)));
typedef float f32x4 __attribute__((ext_vector_type(4)));
typedef float f32x2 __attribute__((ext_vector_type(2)));
typedef unsigned u32x4 __attribute__((ext_vector_type(4)));
typedef unsigned u32x2 __attribute__((ext_vector_type(2)));
typedef __bf16 bf16x2_t __attribute__((ext_vector_type(2)));
#define DI __device__ __forceinline__

constexpr int D = 1024, NB = 8, SEQ = 2048, NCTX = 256, TT = 2304, DEPTH = 4;
constexpr int ML = NB * SEQ;
constexpr int MC = NB * NCTX;
constexpr int MT = ML + MC;
constexpr int DFF = 2816, INW = 6816, INWP = 6912;
constexpr int O_CQ = 0, O_CKV = 384, O_KR = 640, O_DQ = 672, O_DK = 1184, O_DV = 1696, O_CB = 2208, O_CC = 2720, O_CX = 3232, O_G = 3744;
constexpr float EPS = 1e-6f;
constexpr float LOG2E = 1.4426950408889634f;

constexpr size_t al256(size_t x) { return (x + 255) & ~(size_t)255; }
constexpr size_t WS_MOD = 0;
constexpr size_t WS_TAB = al256(WS_MOD + (size_t)4 * 9 * 9216 * 4);
constexpr size_t WS_XC = al256(WS_TAB + (size_t)2048 * 96 * 4);
constexpr size_t WS_W = al256(WS_XC + (size_t)MC * D * 4);
constexpr size_t W_1U = 0, W_1D = W_1U + (size_t)5632 * 1024, W_2U = W_1D + (size_t)1024 * 2816, W_2D = W_2U + (size_t)5632 * 1024,
                 W_IN = W_2D + (size_t)1024 * 2816, W_UQ = W_IN + (size_t)INWP * 1024, W_UKV = W_UQ + (size_t)768 * 384,
                 W_BR = W_UKV + (size_t)1024 * 256, W_O = W_BR + (size_t)3 * 1024 * 512, W_END = W_O + (size_t)1024 * 1024;
constexpr size_t WS_R1 = al256(WS_W + W_END * 2);
constexpr size_t R1_KVRAW = (size_t)MT * 768 * 2;
constexpr size_t WS_PROJ = al256(WS_R1 + (size_t)MT * (768 + 1024) * 2);
constexpr size_t WS_QKV = al256(WS_PROJ + (size_t)MT * INWP * 2);
constexpr size_t Q_QM = 0, Q_KM = Q_QM + (size_t)NB * 8 * TT * 96 * 2, Q_VTM = Q_KM + (size_t)NB * 8 * TT * 96 * 2, Q_QD = Q_VTM + (size_t)NB * 8 * 64 * TT * 2,
                 Q_KD = Q_QD + (size_t)NB * 8 * TT * 64 * 2, Q_VTD = Q_KD + (size_t)NB * 8 * TT * 64 * 2, Q_END = Q_VTD + (size_t)NB * 4 * 128 * TT * 2;
constexpr size_t WS_Y = al256(WS_QKV + Q_END);
constexpr size_t WS_BAR = al256(WS_Y + (size_t)3 * MT * 512 * 2);
constexpr size_t WS_W2 = al256(WS_BAR + 3456 * 4);
constexpr size_t WS_END = al256(WS_W2 + W_END * 2);
static_assert(Q_END >= (size_t)MT * 1024 * 4, "MACC alias");

struct Params {
    const float* in[25];
    float* out;
    unsigned char* ws;
};

DI unsigned pk2(float a, float b) { f32x2 f = {a, b}; bf16x2_t h = __builtin_convertvector(f, bf16x2_t); return __builtin_bit_cast(unsigned, h); }
DI float bflo(unsigned u) { return __uint_as_float(u << 16); }
DI float bfhi(unsigned u) { return __uint_as_float(u & 0xffff0000u); }
DI float wave_sum(float v) {
#pragma unroll
    for (int o = 32; o > 0; o >>= 1) v += __shfl_xor(v, o);
    return v;
}
DI float wave_max(float v) {
#pragma unroll
    for (int o = 32; o > 0; o >>= 1) v = fmaxf(v, __shfl_xor(v, o));
    return v;
}
DI float lam_init_of(int l) { return l == 0 ? 0.2f : (l == 1 ? 0.35550907f : (l == 2 ? 0.47071302f : 0.55605820f)); }
DI float sigmoidf_(float x) { return __builtin_amdgcn_rcpf(1.0f + __builtin_amdgcn_exp2f(-1.4426950408889634f * x)); }
DI int tidx() { int t = threadIdx.x; asm volatile("" : "+v"(t)); return t; }

namespace pg8 {
constexpr int BM = 256, BK = 64, HALF = 128, HTB = HALF * BK * 2, STAGE_BYTES = 8 * HTB, NXCD = 8, WGM = 8;
DI int lds_byte(int r, int c) { const int st = (r >> 4) * 2 + (c >> 5), rr = r & 15, cc = c & 31, ob = rr * 64 + cc * 2; return st * 1024 + (ob ^ (((ob >> 9) & 1) << 5)); }
DI void stage_rc(int b, int& R, int& C) { const int st = b / 1024, sb = b % 1024, swz = sb ^ (((sb >> 9) & 1) << 5); R = (st >> 1) * 16 + swz / 64; C = (st & 1) * 32 + (swz % 64) / 2; }
DI int perm32(int rho) { const int n = rho >> 4, i = rho & 15; return 8 * (i >> 2) + 4 * n + (i & 3); }
struct Unit { int pm, pn, k0, nt, split; };
struct Gemm { const bf16_t* A; const bf16_t* Bt; int lda, K; };

struct Sched {
    int nM, nN, nwg, G, c, rep, aStride, bStride, ntFull;
    int nSplit, P, splitPm0, nb;
    int kseg;
    DI void init(int M, int N, int K, int G_, int c_, int rep_ = 1, int as_ = 0, int bs_ = 0) { nM = M / BM; nN = N / BM; nwg = nM * nN; G = G_; c = c_; rep = rep_; aStride = as_; bStride = bs_; ntFull = K / BK;
        nSplit = 0; P = 1; splitPm0 = 0; nb = K / 128; kseg = 0; }
    DI void add_split(int tilesM, int pm0, int P_) { nSplit = tilesM * nN * P_; P = P_; splitPm0 = pm0; }
    DI bool next(int i, Unit& u) const {
        int it = i, n = 0;
        if (rep > 1) { it = i / rep; n = i - it * rep; }
        const long L = (long)it * G + c;
        if (L >= nwg) {
            const int s = (int)(L - nwg); if (s >= nSplit) return false;
            const int tile = s / P, j = s - tile * P, base = nb / P, rem = nb - base * P;
            u.pm = splitPm0 + tile / nN; u.pn = tile % nN; u.k0 = 128 * (j * base + (j < rem ? j : rem)); u.nt = 2 * (base + (j < rem ? 1 : 0)); u.split = j + 1; return true;
        }
        int wgid = (int)L; { const int q = nwg / NXCD, r = nwg % NXCD, xcd = wgid % NXCD, off = wgid / NXCD; wgid = (xcd < r ? xcd * (q + 1) : r * (q + 1) + (xcd - r) * q) + off; }
        const int nig = WGM * nN, gid = wgid / nig, fm = gid * WGM, gsz = (nM - fm) < WGM ? (nM - fm) : WGM;
        u.pm = fm + ((wgid % nig) % gsz) + n * aStride; u.pn = (wgid % nig) / gsz + n * bStride; u.k0 = 0; u.nt = ntFull; u.split = 0;
        if (kseg) { u.k0 = n * kseg; u.split = n; }
        return true;
    }
};

template <class Epi>
DI void gemm_phase(LAS unsigned char* lds, const Gemm g, const Sched& S, const Epi& E) {
    const int tid = tidx(), wid = __builtin_amdgcn_readfirstlane(tid >> 6), lane = tid & 63, wr = wid >> 2, wc = wid & 3, fr = lane & 15, fq = lane >> 4;
    const int K = g.K, lda = g.lda;
    unsigned voffA[2], voffB[2];
#pragma unroll
    for (int i = 0; i < 2; ++i) { int R, C; stage_rc(tid * 16 + i * 8192, R, C); const int Rb = Epi::PERM ? ((R & ~31) + perm32(R & 31)) : R;
        voffA[i] = (unsigned)(R * lda + C) * 2u; voffB[i] = (unsigned)(Rb * K + C) * 2u; }
    const size_t kstep = (size_t)(BK * 2);
    const size_t hstepA = (size_t)HALF * lda * 2, hstepB = (size_t)HALF * K * 2;
    const size_t tstepA = 2 * hstepA, tstepB = 2 * hstepB;
    const unsigned ldsw = (unsigned)wid * 1024u;
    const int aoff = lds_byte(wr * 64 + fr, fq * 8), boff = lds_byte(wc * 32 + fr, fq * 8);
#define PG8_SA(b, h) (((b) * 2 + (h)) * HTB)
#define PG8_SB(b, h) ((4 + (b) * 2 + (h)) * HTB)
#define PG8_STAGE(bufoff, gbase, voff) do { _Pragma("unroll") for (int _i = 0; _i < 2; ++_i) \
        __builtin_amdgcn_global_load_lds((const unsigned*)((const char*)(gbase) + (voff)[_i]), (LAS unsigned*)(lds + (bufoff) + ldsw + _i * 8192), 16, 0, 0); } while (0)
#define PG8_LDA(dst, b, h) do { _Pragma("unroll") for (int m = 0; m < 4; ++m) _Pragma("unroll") for (int k = 0; k < 2; ++k) dst[m][k] = *(const LAS bf16x8*)(lds + PG8_SA(b, h) + aoff + m * 2048 + k * 1024); } while (0)
#define PG8_LDB(dst, b, h) do { _Pragma("unroll") for (int n = 0; n < 2; ++n) _Pragma("unroll") for (int k = 0; k < 2; ++k) dst[n][k] = *(const LAS bf16x8*)(lds + PG8_SB(b, h) + boff + n * 2048 + k * 1024); } while (0)
#define PG8_MMA(ai, bj, At, Bt) do { __builtin_amdgcn_s_setprio(1); _Pragma("unroll") for (int m = 0; m < 4; ++m) _Pragma("unroll") for (int n = 0; n < 2; ++n) _Pragma("unroll") for (int k = 0; k < 2; ++k) \
        acc[ai][bj][m][n] = __builtin_amdgcn_mfma_f32_16x16x32_bf16(Bt[n][k], At[m][k], acc[ai][bj][m][n], 0, 0, 0); __builtin_amdgcn_s_setprio(0); } while (0)
#define PG8_WAIT_V(n) asm volatile("s_waitcnt vmcnt(" #n ")" ::: "memory")
#define PG8_WAIT_L(n) asm volatile("s_waitcnt lgkmcnt(" #n ")" ::: "memory")
#define PG8_BAR __builtin_amdgcn_s_barrier()
#define PG8_SCHED __builtin_amdgcn_sched_barrier(0)
    Unit cur, nxt; int ui = 0;
    if (!S.next(0, cur)) return;
    f32x4 acc[2][2][4][2];
#pragma unroll
    for (int a = 0; a < 2; ++a)
#pragma unroll
        for (int b = 0; b < 2; ++b)
#pragma unroll
            for (int m = 0; m < 4; ++m)
#pragma unroll
                for (int n = 0; n < 2; ++n) acc[a][b][m][n] = (f32x4){0.f, 0.f, 0.f, 0.f};
    bf16x8 At[4][2], B0[2][2], B1[2][2];
    const char* cA = (const char*)g.A + (size_t)cur.pm * tstepA + (size_t)cur.k0 * 2; const char* cB = (const char*)g.Bt + (size_t)cur.pn * tstepB + (size_t)cur.k0 * 2;
    PG8_STAGE(PG8_SB(0, 0), cB, voffB); PG8_STAGE(PG8_SA(0, 0), cA, voffA); PG8_STAGE(PG8_SB(0, 1), cB + hstepB, voffB); PG8_STAGE(PG8_SA(0, 1), cA + hstepA, voffA);
    if (wr == 1) PG8_BAR;
    PG8_WAIT_V(4); PG8_BAR;
    PG8_STAGE(PG8_SB(1, 0), cB + kstep, voffB); PG8_STAGE(PG8_SA(1, 0), cA + kstep, voffA); PG8_STAGE(PG8_SB(1, 1), cB + hstepB + kstep, voffB);
    PG8_WAIT_V(6); PG8_BAR;
    for (;;) {
        const bool has_next = S.next(ui + 1, nxt);
        const char* nA = has_next ? (const char*)g.A + (size_t)nxt.pm * tstepA + (size_t)nxt.k0 * 2 : cA; const char* nB = has_next ? (const char*)g.Bt + (size_t)nxt.pn * tstepB + (size_t)nxt.k0 * 2 : cB;
        const int nt = cur.nt;
        for (int t = 0; t < nt; t += 2) {
            const bool last = (t == nt - 2);
            const char* a1 = cA + (size_t)(t + 1) * kstep;
            const char* a2 = last ? nA : cA + (size_t)(t + 2) * kstep; const char* b2 = last ? nB : cB + (size_t)(t + 2) * kstep;
            const char* a3 = a2 + kstep; const char* b3 = b2 + kstep;
            PG8_LDB(B0, 0, 0); PG8_SCHED; PG8_LDA(At, 0, 0); PG8_STAGE(PG8_SA(1, 1), a1 + hstepA, voffA);
            PG8_WAIT_L(8); PG8_BAR; PG8_WAIT_L(0); PG8_MMA(0, 0, At, B0); PG8_BAR; PG8_SCHED;
            PG8_LDB(B1, 0, 1); PG8_STAGE(PG8_SB(0, 0), b2, voffB);
            PG8_BAR; PG8_WAIT_L(0); PG8_MMA(0, 1, At, B1); PG8_BAR;
            PG8_LDA(At, 0, 1); PG8_STAGE(PG8_SA(0, 0), a2, voffA);
            PG8_BAR; PG8_WAIT_L(0); PG8_MMA(1, 0, At, B0); PG8_BAR; PG8_SCHED;
            PG8_STAGE(PG8_SB(0, 1), b2 + hstepB, voffB);
            PG8_WAIT_V(6); PG8_BAR; PG8_MMA(1, 1, At, B1); PG8_BAR;
            PG8_LDB(B0, 1, 0); PG8_SCHED; PG8_LDA(At, 1, 0); PG8_STAGE(PG8_SA(0, 1), a2 + hstepA, voffA);
            PG8_WAIT_L(8); PG8_BAR; PG8_WAIT_L(0); PG8_MMA(0, 0, At, B0); PG8_BAR; PG8_SCHED;
            PG8_LDB(B1, 1, 1); PG8_STAGE(PG8_SB(1, 0), b3, voffB);
            PG8_BAR; PG8_WAIT_L(0); PG8_MMA(0, 1, At, B1); PG8_BAR;
            PG8_LDA(At, 1, 1); PG8_STAGE(PG8_SA(1, 0), a3, voffA);
            PG8_BAR; PG8_WAIT_L(0); PG8_MMA(1, 0, At, B0); PG8_BAR; PG8_SCHED;
            PG8_STAGE(PG8_SB(1, 1), b3 + hstepB, voffB);
            PG8_WAIT_V(6); PG8_BAR; PG8_MMA(1, 1, At, B1); PG8_BAR;
        }
        E(acc, cur, wr, wc, fr, fq);
        if (!has_next) break;
        if (!(Epi::CHAIN && nxt.split != 0)) {
#pragma unroll
            for (int a = 0; a < 2; ++a)
#pragma unroll
                for (int b = 0; b < 2; ++b)
#pragma unroll
                    for (int m = 0; m < 4; ++m)
#pragma unroll
                        for (int n = 0; n < 2; ++n) acc[a][b][m][n] = (f32x4){0.f, 0.f, 0.f, 0.f};
        }
        cur = nxt; cA = nA; cB = nB; ++ui;
    }
    PG8_WAIT_V(0);
    if (wr == 0) PG8_BAR;
    PG8_BAR;
#undef PG8_SA
#undef PG8_SB
#undef PG8_STAGE
#undef PG8_LDA
#undef PG8_LDB
#undef PG8_MMA
#undef PG8_WAIT_V
#undef PG8_WAIT_L
#undef PG8_BAR
#undef PG8_SCHED
}
}
using pg8::Unit;
typedef f32x4 AccT[2][2][4][2];

struct EpiStore {
    static constexpr bool PERM = true, CHAIN = false;
    bf16_t* O; int ld; int sig0;
    DI void operator()(const AccT& acc, const Unit& u, int wr, int wc, int fr, int fq) const {
        const int row0 = u.pm * 256 + wr * 64 + fr, col0 = u.pn * 256 + wc * 32 + 8 * fq;
#pragma unroll
        for (int ai = 0; ai < 2; ++ai)
#pragma unroll
            for (int m = 0; m < 4; ++m) { bf16_t* rowp = O + (size_t)(row0 + ai * 128 + m * 16) * ld + col0;
#pragma unroll
                for (int bj = 0; bj < 2; ++bj) { f32x4 v0 = acc[ai][bj][m][0], v1 = acc[ai][bj][m][1];
                    if (u.pn * 256 + bj * 128 + wc * 32 >= sig0) {
#pragma unroll
                        for (int j = 0; j < 4; ++j) { v0[j] = sigmoidf_(v0[j]); v1[j] = sigmoidf_(v1[j]); } }
                    u32x4 w; w.x = pk2(v0[0], v0[1]); w.y = pk2(v0[2], v0[3]); w.z = pk2(v1[0], v1[1]); w.w = pk2(v1[2], v1[3]);
                    *(u32x4*)(rowp + bj * 128) = w; } }
    }
};
struct EpiSwiglu {
    static constexpr bool PERM = true, CHAIN = false;
    bf16_t* O;
    DI void operator()(const AccT& acc, const Unit& u, int wr, int wc, int fr, int fq) const {
        const int row0 = u.pm * 256 + wr * 64 + fr, col0 = u.pn * 128 + (wc * 4 + fq) * 8;
#pragma unroll
        for (int ai = 0; ai < 2; ++ai)
#pragma unroll
            for (int m = 0; m < 4; ++m) { bf16_t* rowp = O + (size_t)(row0 + ai * 128 + m * 16) * DFF + col0;
                unsigned o[4];
#pragma unroll
                for (int bj = 0; bj < 2; ++bj) { const f32x4 v0 = acc[ai][bj][m][0], v1 = acc[ai][bj][m][1];
                    const float r0 = v0[0] * sigmoidf_(v0[0]) * v0[1], r1 = v0[2] * sigmoidf_(v0[2]) * v0[3];
                    const float r2 = v1[0] * sigmoidf_(v1[0]) * v1[1], r3 = v1[2] * sigmoidf_(v1[2]) * v1[3];
                    o[2 * bj] = pk2(r0, r1); o[2 * bj + 1] = pk2(r2, r3); }
                u32x4 w; w.x = o[0]; w.y = o[1]; w.z = o[2]; w.w = o[3];
                *(u32x4*)rowp = w; }
    }
};
struct EpiResid {
    static constexpr bool PERM = false, CHAIN = false;
    float* xl; float* xc; const float* modl; int midx; float coef; float* part;
    DI void operator()(const AccT& acc, const Unit& u, int wr, int wc, int fr, int fq) const {
        const int bi = u.pm < 64 ? (u.pm >> 3) : 8;
        float* base = u.pm < 64 ? xl + (size_t)u.pm * 256 * D : xc + (size_t)(u.pm - 64) * 256 * D;
        if (u.split) base = part + (size_t)(u.split - 1) * MC * D + (size_t)(u.pm - 64) * 256 * D;
        const int row0 = wr * 64 + fr, col0 = u.pn * 256 + wc * 32 + 4 * fq;
        const float* mp = modl + (size_t)bi * 9216 + midx * 1024 + col0;
#pragma unroll
        for (int bj = 0; bj < 2; ++bj) {
            f32x4 mv[2];
#pragma unroll
            for (int n = 0; n < 2; ++n) mv[n] = *(const f32x4*)(mp + bj * 128 + n * 16) * coef;
            float* cb = base + (size_t)row0 * D + col0 + bj * 128;
            f32x4 xv[2][2][4];
            if (!u.split) {
#pragma unroll
                for (int n = 0; n < 2; ++n)
#pragma unroll
                    for (int ai = 0; ai < 2; ++ai)
#pragma unroll
                        for (int m = 0; m < 4; ++m) xv[n][ai][m] = *(const f32x4*)(cb + n * 16 + (size_t)(ai * 128 + m * 16) * D);
            } else {
#pragma unroll
                for (int n = 0; n < 2; ++n)
#pragma unroll
                    for (int ai = 0; ai < 2; ++ai)
#pragma unroll
                        for (int m = 0; m < 4; ++m) xv[n][ai][m] = (f32x4){0.f, 0.f, 0.f, 0.f};
            }
#pragma unroll
            for (int n = 0; n < 2; ++n)
#pragma unroll
                for (int ai = 0; ai < 2; ++ai)
#pragma unroll
                    for (int m = 0; m < 4; ++m) *(f32x4*)(cb + n * 16 + (size_t)(ai * 128 + m * 16) * D) = xv[n][ai][m] + mv[n] * acc[ai][bj][m][n];
        }
    }
};
struct EpiMerge {
    static constexpr bool PERM = true, CHAIN = true;
    bf16_t* mb; const bf16_t* proj;
    DI void operator()(AccT& acc, const Unit& u, int wr, int wc, int fr, int fq) const {
        const int seg = u.split;
        const int row0 = u.pm * 256 + wr * 64 + fr, col0 = u.pn * 256 + wc * 32 + 8 * fq;
#pragma unroll
        for (int ai = 0; ai < 2; ++ai) {
            u32x4 ga[4][2], gb[4][2];
#pragma unroll
            for (int m = 0; m < 4; ++m) { const bf16_t* gp = proj + (size_t)(row0 + ai * 128 + m * 16) * INWP + O_G + seg * 1024 + col0;
#pragma unroll
                for (int bj = 0; bj < 2; ++bj) { ga[m][bj] = *(const u32x4*)(gp + bj * 128); gb[m][bj] = seg < 2 ? *(const u32x4*)(gp + 1024 + bj * 128) : (u32x4){0u, 0u, 0u, 0u}; } }
#pragma unroll
            for (int m = 0; m < 4; ++m) { const size_t row = (size_t)(row0 + ai * 128 + m * 16);
#pragma unroll
                for (int bj = 0; bj < 2; ++bj) {
                    const unsigned aw[4] = {ga[m][bj].x, ga[m][bj].y, ga[m][bj].z, ga[m][bj].w}, bw[4] = {gb[m][bj].x, gb[m][bj].y, gb[m][bj].z, gb[m][bj].w};
                    float r[8];
#pragma unroll
                    for (int j = 0; j < 4; ++j) { r[2 * j] = fmaxf(bflo(aw[j]), 1e-20f); r[2 * j + 1] = fmaxf(bfhi(aw[j]), 1e-20f); }
                    if (seg < 2) {
#pragma unroll
                        for (int j = 0; j < 4; ++j) { r[2 * j] *= __builtin_amdgcn_rcpf(fmaxf(bflo(bw[j]), 1e-20f)); r[2 * j + 1] *= __builtin_amdgcn_rcpf(fmaxf(bfhi(bw[j]), 1e-20f)); }
#pragma unroll
                        for (int n = 0; n < 2; ++n) { f32x4 rv; rv[0] = r[4 * n]; rv[1] = r[4 * n + 1]; rv[2] = r[4 * n + 2]; rv[3] = r[4 * n + 3]; acc[ai][bj][m][n] = acc[ai][bj][m][n] * rv; }
                    } else {
                        const f32x4 v0 = acc[ai][bj][m][0], v1 = acc[ai][bj][m][1];
                        u32x4 w; w.x = pk2(v0[0] * r[0], v0[1] * r[1]); w.y = pk2(v0[2] * r[2], v0[3] * r[3]); w.z = pk2(v1[0] * r[4], v1[1] * r[5]); w.w = pk2(v1[2] * r[6], v1[3] * r[7]);
                        *(u32x4*)(mb + row * D + col0 + bj * 128) = w; } } }
        }
    }
};

DI void mod_phase(const Params& p, LAS unsigned char* ldsb) {
    LAS float* sc = (LAS float*)ldsb;
    LAS float* red = sc + 9216;
    const int tid = tidx(), wid = tid >> 6, lane = tid & 63;
    for (int i = tid; i < 9216; i += 512) { const int bi = i >> 10, k = i & 1023; const float cv = bi < 8 ? p.in[1][bi * 1024 + k] : p.in[3][k]; sc[i] = cv / (1.0f + expf(-cv)); }
    __syncthreads();
    float* MOD = (float*)(p.ws + WS_MOD);
    for (int item = blockIdx.x; item < 144; item += gridDim.x) {
        const int l = item / 36, j0 = (item % 36) * 256;
        const float* w = p.in[4] + ((size_t)l * 1024 + wid * 128) * 9216 + j0 + lane * 4;
        f32x4 acc[9];
#pragma unroll
        for (int b = 0; b < 9; ++b) acc[b] = (f32x4){0.f, 0.f, 0.f, 0.f};
#pragma unroll 8
        for (int kk = 0; kk < 128; ++kk) { const f32x4 wv = __builtin_nontemporal_load((const f32x4*)(w + (size_t)kk * 9216)); const int k = wid * 128 + kk;
#pragma unroll
            for (int b = 0; b < 9; ++b) acc[b] = acc[b] + wv * sc[b * 1024 + k]; }
#pragma unroll
        for (int b = 0; b < 9; ++b) *(LAS f32x4*)(red + (wid * 9 + b) * 256 + lane * 4) = acc[b];
        __syncthreads();
        for (int o = tid; o < 9 * 256; o += 512) { const int b = o >> 8, cn = o & 255; float s = 0.f;
#pragma unroll
            for (int w8 = 0; w8 < 8; ++w8) s += red[(w8 * 9 + b) * 256 + cn];
            MOD[((size_t)l * 9 + b) * 9216 + j0 + cn] = s + p.in[5][(size_t)l * 9216 + j0 + cn]; }
        __syncthreads();
    }
}
DI void tab_phase(const Params& p) {
    float* TABM = (float*)(p.ws + WS_TAB);
    float* TABD = TABM + 2048 * 32;
    const int gt = blockIdx.x * 512 + tidx(), nth = gridDim.x * 512;
    for (int i = gt; i < 2048 * 48; i += nth) {
        const int s = i / 48, a = i % 48;
        const float row = (float)(s >> 6), col = (float)(s & 63);
        float pos, invf; int idx; float* dst; int half;
        if (a < 16) { const int axis = a >> 3, f = a & 7; pos = axis ? col : row; invf = exp2f(-(float)f * (13.287712379549449f / 8.0f)); dst = TABM + s * 32; idx = a; half = 16; }
        else { const int a2 = a - 16, axis = a2 >> 4, f = a2 & 15; pos = axis ? col : row; invf = exp2f(-(float)f * (13.287712379549449f / 16.0f)); dst = TABD + s * 64; idx = a2; half = 32; }
        const float ang = pos * invf;
        float rev = ang * 0.15915494309189535f; rev -= floorf(rev);
        dst[idx] = __builtin_amdgcn_cosf(rev); dst[half + idx] = __builtin_amdgcn_sinf(rev);
    }
}

DI void convT(const float* __restrict__ src, int K, int N, bf16_t* __restrict__ dst, int mode, const float* kscale, LAS float* tile, int rot, int vid, int vcnt, int ldd = 0, int koff = 0) {
    if (ldd == 0) ldd = K;
    const int tilesN = (N + 63) >> 6, tilesK = K >> 6, nt = tilesN * tilesK, tid = tidx();
    int start = vid - (rot % vcnt); if (start < 0) start += vcnt;
    const int kr = tid >> 4, c4 = (tid & 15) * 4;
    f32x4 r0, r1;
    auto fetch = [&](int tl) {
        const int tk = tl / tilesN, tn = tl - tk * tilesN, n = tn * 64 + c4, k0 = tk * 64 + kr;
        r0 = (f32x4){0.f, 0.f, 0.f, 0.f}; r1 = r0;
        if (n < N) { r0 = __builtin_nontemporal_load((const f32x4*)(src + (size_t)k0 * N + n)); r1 = __builtin_nontemporal_load((const f32x4*)(src + (size_t)(k0 + 32) * N + n)); }
        if (kscale) { r0 = r0 * kscale[k0]; r1 = r1 * kscale[k0 + 32]; }
    };
    if (start < nt) fetch(start);
    for (int tl = start; tl < nt; tl += vcnt) {
        const int tk = tl / tilesN, tn = tl - tk * tilesN;
        { LAS float* tp = tile + kr * 65 + c4; tp[0] = r0[0]; tp[1] = r0[1]; tp[2] = r0[2]; tp[3] = r0[3];
          tp += 32 * 65; tp[0] = r1[0]; tp[1] = r1[1]; tp[2] = r1[2]; tp[3] = r1[3]; }
        if (tl + vcnt < nt) fetch(tl + vcnt);
        __syncthreads();
        { const int nl = tid >> 3, k8 = (tid & 7) * 8, n = tn * 64 + nl;
          if (n < N) { float f[8];
#pragma unroll
              for (int j = 0; j < 8; ++j) f[j] = tile[(k8 + j) * 65 + nl];
              u32x4 w; w.x = pk2(f[0], f[1]); w.y = pk2(f[2], f[3]); w.z = pk2(f[4], f[5]); w.w = pk2(f[6], f[7]);
              int drow = n;
              if (mode == 1) { const int i = n < DFF ? n : n - DFF, role = n < DFF ? 0 : 1;
                  drow = (i >> 7) * 256 + ((i >> 2) & 1) * 128 + ((i & 127) >> 3) * 8 + (i & 3) * 2 + role; }
              else if (mode == 2) { const int h = n / 96, o = n - h * 96, q = o - 64; if (o >= 64) drow = h * 96 + 64 + 2 * ((q >> 4) * 8 + (q & 7)) + ((q >> 3) & 1); }
              else if (mode == 3) { if (n >= O_KR && n < O_DQ) { const int q = n - O_KR; drow = O_KR + 2 * ((q >> 4) * 8 + (q & 7)) + ((q >> 3) & 1); }
                                    else if (n >= O_DQ && n < O_DV) { const int o = (n - O_DQ) & 63; drow = n - o + 2 * ((o >> 5) * 16 + (o & 15)) + ((o >> 4) & 1); } }
              *(u32x4*)(dst + (size_t)drow * ldd + koff + tk * 64 + k8) = w; } }
        __syncthreads();
    }
}
DI void conv_weights(const Params& p, int l, LAS unsigned char* ldsb, bf16_t* W, int vid, int vcnt) {
    LAS float* tile = (LAS float*)ldsb;
    convT(p.in[7] + (size_t)l * 1024 * 5632, 1024, 5632, W + W_1U, 1, nullptr, tile, 0, vid, vcnt);
    convT(p.in[8] + (size_t)l * 2816 * 1024, 2816, 1024, W + W_1D, 0, nullptr, tile, 128, vid, vcnt);
    convT(p.in[9] + (size_t)l * 1024 * 5632, 1024, 5632, W + W_2U, 1, nullptr, tile, 64, vid, vcnt);
    convT(p.in[10] + (size_t)l * 2816 * 1024, 2816, 1024, W + W_2D, 0, nullptr, tile, 192, vid, vcnt);
    convT(p.in[11] + (size_t)l * 1024 * INW, 1024, INW, W + W_IN, 3, nullptr, tile, 32, vid, vcnt);
    convT(p.in[13] + (size_t)l * 384 * 768, 384, 768, W + W_UQ, 2, p.in[12] + l * 384, tile, 160, vid, vcnt);
    convT(p.in[15] + (size_t)l * 256 * 1024, 256, 1024, W + W_UKV, 0, p.in[14] + l * 256, tile, 232, vid, vcnt);
    for (int n = 0; n < 3; ++n) convT(p.in[23] + ((size_t)l * 3 + n) * 512 * 1024, 512, 1024, W + W_BR, 0, nullptr, tile, 40 + n * 72, vid, vcnt, 1536, n * 512);
    convT(p.in[24] + (size_t)l * 1024 * 1024, 1024, 1024, W + W_O, 0, nullptr, tile, 96, vid, vcnt);
    { u32x4* z = (u32x4*)(W + W_IN + (size_t)INW * 1024); const int nz = (INWP - INW) * 1024 / 8;
      for (int i = vid * 512 + tidx(); i < nz; i += vcnt * 512) z[i] = (u32x4){0u, 0u, 0u, 0u}; }
}

DI void norm_phase(const float* sl, const float* sc_, float* dl, float* dc, bool copy, bf16_t* H, const float* g, const float* modl, int shift_i, int scale_i, int Mrows, const float* part, int npart) {
    const int tid_ = tidx(), lane = tid_ & 63, gw = blockIdx.x * 8 + (tid_ >> 6), nw = gridDim.x * 8;
    constexpr int R = 3;
    for (int row0 = gw; row0 < Mrows; row0 += R * nw) {
        f32x4 v[R][4]; float ss[R]; bool ok[R];
#pragma unroll
        for (int r = 0; r < R; ++r) { int row = row0 + r * nw; ok[r] = row < Mrows; row = ok[r] ? row : Mrows - 1;
            const float* src = row < ML ? sl + (size_t)row * D : sc_ + (size_t)(row - ML) * D;
#pragma unroll
            for (int i = 0; i < 4; ++i) v[r][i] = *(const f32x4*)(src + i * 256 + lane * 4); }
#pragma unroll
        for (int r = 0; r < R; ++r) { const int row = row0 + r * nw;
            if (ok[r] && npart > 0 && row >= ML) {
                f32x4 pv[4][4];
#pragma unroll
                for (int j = 0; j < 4; ++j) { const float* pp = part + (size_t)j * MC * D + (size_t)(row - ML) * D;
#pragma unroll
                    for (int i = 0; i < 4; ++i) pv[j][i] = *(const f32x4*)(pp + i * 256 + lane * 4); }
#pragma unroll
                for (int j = 0; j < 4; ++j)
#pragma unroll
                    for (int i = 0; i < 4; ++i) v[r][i] = v[r][i] + pv[j][i]; }
            float s = 0.f;
#pragma unroll
            for (int i = 0; i < 4; ++i) s += v[r][i][0] * v[r][i][0] + v[r][i][1] * v[r][i][1] + v[r][i][2] * v[r][i][2] + v[r][i][3] * v[r][i][3];
            ss[r] = s; }
#pragma unroll
        for (int o = 32; o > 0; o >>= 1) {
#pragma unroll
            for (int r = 0; r < R; ++r) ss[r] += __shfl_xor(ss[r], o); }
#pragma unroll
        for (int r = 0; r < R; ++r) { const int row = row0 + r * nw;
            if (!ok[r]) continue;
            const int bi = row < ML ? (row >> 11) : 8;
            const float rstd = rsqrtf(ss[r] * (1.0f / 1024.0f) + EPS);
            const float* mb = modl + (size_t)bi * 9216;
#pragma unroll
            for (int i = 0; i < 4; ++i) { const int col = i * 256 + lane * 4;
                const f32x4 gg = *(const f32x4*)(g + col), scv = *(const f32x4*)(mb + scale_i * 1024 + col), shv = *(const f32x4*)(mb + shift_i * 1024 + col);
                const f32x4 h = v[r][i] * rstd * gg * (scv + 1.0f) + shv;
                u32x2 w; w.x = pk2(h[0], h[1]); w.y = pk2(h[2], h[3]);
                *(u32x2*)(H + (size_t)row * D + col) = w; }
            if (copy || (npart > 0 && row >= ML)) { float* dst = row < ML ? dl + (size_t)row * D : dc + (size_t)(row - ML) * D;
#pragma unroll
                for (int i = 0; i < 4; ++i) *(f32x4*)(dst + i * 256 + lane * 4) = v[r][i]; }
        }
    }
}

template <int NV> DI void load_bf16_row(const bf16_t* src, float* v, float mul) {
#pragma unroll
    for (int i = 0; i < NV / 8; ++i) { const u32x4 w = *(const u32x4*)(src + i * 8);
        v[i * 8 + 0] = bflo(w.x) * mul; v[i * 8 + 1] = bfhi(w.x) * mul; v[i * 8 + 2] = bflo(w.y) * mul; v[i * 8 + 3] = bfhi(w.y) * mul;
        v[i * 8 + 4] = bflo(w.z) * mul; v[i * 8 + 5] = bfhi(w.z) * mul; v[i * 8 + 6] = bflo(w.w) * mul; v[i * 8 + 7] = bfhi(w.w) * mul; }
}
template <int NV> DI void store_bf16_row(bf16_t* dst, const float* v) {
#pragma unroll
    for (int i = 0; i < NV / 8; ++i) { u32x4 w; w.x = pk2(v[i * 8], v[i * 8 + 1]); w.y = pk2(v[i * 8 + 2], v[i * 8 + 3]); w.z = pk2(v[i * 8 + 4], v[i * 8 + 5]); w.w = pk2(v[i * 8 + 6], v[i * 8 + 7]);
        *(u32x4*)(dst + i * 8) = w; }
}
template <int NV> DI float sumsq_row(const bf16_t* src, float mul) {
    float ss = 0.f;
#pragma unroll
    for (int i = 0; i < NV / 8; ++i) { const u32x4 w = *(const u32x4*)(src + i * 8); const unsigned ww[4] = {w.x, w.y, w.z, w.w};
#pragma unroll
        for (int j = 0; j < 4; ++j) { const float a = bflo(ww[j]) * mul, b = bfhi(ww[j]) * mul; ss += a * a; ss += b * b; } }
    return ss;
}
template <int NV> DI void emit_plain(const bf16_t* src, float mul, const LAS float* g, bf16_t* dst) {
#pragma unroll 2
    for (int i = 0; i < NV / 8; ++i) { const u32x4 w = *(const u32x4*)(src + i * 8); const unsigned ww[4] = {w.x, w.y, w.z, w.w}; unsigned o[4];
#pragma unroll
        for (int j = 0; j < 4; ++j) o[j] = pk2(bflo(ww[j]) * mul * g[i * 8 + 2 * j], bfhi(ww[j]) * mul * g[i * 8 + 2 * j + 1]);
        u32x4 ov; ov.x = o[0]; ov.y = o[1]; ov.z = o[2]; ov.w = o[3]; *(u32x4*)(dst + i * 8) = ov; }
}
template <int QF> DI void emit_rope_axis(const bf16_t* src, float mul, const LAS float* g, const float* cp, const float* sp, bf16_t* dst) {
    float v[2 * QF];
#pragma unroll
    for (int i = 0; i < QF / 4; ++i) { const u32x4 w = *(const u32x4*)(src + i * 8); const unsigned ww[4] = {w.x, w.y, w.z, w.w};
#pragma unroll
        for (int j = 0; j < 4; ++j) { v[i * 8 + 2 * j] = bflo(ww[j]) * mul * g[i * 8 + 2 * j]; v[i * 8 + 2 * j + 1] = bfhi(ww[j]) * mul * g[i * 8 + 2 * j + 1]; } }
    if (cp) {
#pragma unroll
        for (int f = 0; f < QF; ++f) { const float c = cp[f], s = sp[f], x1 = v[f], x2 = v[QF + f]; v[f] = x1 * c - x2 * s; v[QF + f] = x2 * c + x1 * s; }
    }
#pragma unroll
    for (int i = 0; i < QF / 4; ++i) { u32x4 ov; ov.x = pk2(v[i * 8], v[i * 8 + 1]); ov.y = pk2(v[i * 8 + 2], v[i * 8 + 3]); ov.z = pk2(v[i * 8 + 4], v[i * 8 + 5]); ov.w = pk2(v[i * 8 + 6], v[i * 8 + 7]); *(u32x4*)(dst + i * 8) = ov; }
}
DI float sumsq8(u32x4 w) { const unsigned ww[4] = {w.x, w.y, w.z, w.w}; float ss = 0.f;
#pragma unroll
    for (int j = 0; j < 4; ++j) { const float a = bflo(ww[j]), b = bfhi(ww[j]); ss += a * a; ss += b * b; }
    return ss; }
DI void unpack8(u32x4 w, float* v, float mul) { const unsigned ww[4] = {w.x, w.y, w.z, w.w};
#pragma unroll
    for (int j = 0; j < 4; ++j) { v[2 * j] = bflo(ww[j]) * mul; v[2 * j + 1] = bfhi(ww[j]) * mul; } }
DI u32x4 pack8(const float* v) { u32x4 o; o.x = pk2(v[0], v[1]); o.y = pk2(v[2], v[3]); o.z = pk2(v[4], v[5]); o.w = pk2(v[6], v[7]); return o; }
DI float red8(float v) { v += __shfl_xor(v, 1); v += __shfl_xor(v, 2); v += __shfl_xor(v, 4); return v; }

DI void prep_body(const Params& p, int l, LAS unsigned char* ldsb,
                  const bf16_t* __restrict__ PROJ, const bf16_t* __restrict__ QRAW, const bf16_t* __restrict__ KVRAW,
                  bf16_t* __restrict__ QM, bf16_t* __restrict__ KM, bf16_t* __restrict__ VTM, bf16_t* __restrict__ QD, bf16_t* __restrict__ KD, bf16_t* __restrict__ VTD, bf16_t* __restrict__ Y2,
                  const float* __restrict__ TABM, const float* __restrict__ TABD, const float* __restrict__ cw) {
    const int tid = tidx(), wid = tid >> 6, lane = tid & 63, hd = lane >> 3, s = lane & 7;
    const float qsm = 0.10206207261596577f * LOG2E, qsd = 0.125f * LOG2E;
    LAS float* gl = (LAS float*)ldsb;
    if (tid < 96) { const int q = tid - 64, pp = q >> 1, hh = q & 1; const int orig = tid < 64 ? tid : 64 + 16 * (pp >> 3) + 8 * hh + (pp & 7);
        gl[tid] = p.in[16][l * 96 + orig]; gl[96 + tid] = p.in[17][l * 96 + orig]; }
    if (tid < 64) { const int pp = tid >> 1, hh = tid & 1, orig = 32 * (pp >> 4) + 16 * hh + (pp & 15);
        gl[192 + tid] = p.in[18][l * 64 + orig]; gl[256 + tid] = p.in[19][l * 64 + orig]; }
    __syncthreads();
    float gqn[8], gqr[4], gkn[8], gkr[4], gdq[8], gdk[8];
#pragma unroll
    for (int j = 0; j < 8; ++j) { gqn[j] = gl[8 * s + j]; gkn[j] = gl[96 + 8 * s + j]; gdq[j] = gl[192 + 8 * s + j]; gdk[j] = gl[256 + 8 * s + j]; }
#pragma unroll
    for (int j = 0; j < 4; ++j) { gqr[j] = gl[64 + 4 * s + j]; gkr[j] = gl[96 + 64 + 4 * s + j]; }
    __syncthreads();
    LAS unsigned char* Vl = ldsb;
#pragma unroll 1
    for (int item = blockIdx.x; item < 5 * (MT / 64); item += gridDim.x) {
        const int type = item / (MT / 64), blk = item - type * (MT / 64);
        const int r0 = blk * 64; int b, t0, spos0, seglen; bool latent;
        if (r0 < ML) { b = r0 >> 11; spos0 = r0 & 2047; t0 = 256 + spos0; latent = true; seglen = 2048; }
        else { const int rc = r0 - ML; b = rc >> 8; spos0 = rc & 255; t0 = spos0; latent = false; seglen = 256; }
        if (type == 0) {
#pragma unroll 1
            for (int kb4 = 0; kb4 < 8; kb4 += 4) {
                float s1[4], s2[4]; u32x4 wqn[4], wkn[4]; u32x2 wqr[4], wkr[4]; f32x2 cm[4], sm[4];
#pragma unroll
            for (int k = 0; k < 4; ++k) {
                const int tl = wid * 8 + kb4 + k, r = r0 + tl, t = t0 + tl, spos = spos0 + tl;
                const bf16_t* prow = PROJ + (size_t)r * INWP;
                s1[k] = sumsq8(*(const u32x4*)(prow + O_CQ + (lane < 48 ? lane : 0) * 8)); s1[k] = lane < 48 ? s1[k] : 0.f;
                s2[k] = sumsq8(*(const u32x4*)(prow + O_CKV + (lane < 32 ? lane : 0) * 8)); s2[k] = lane < 32 ? s2[k] : 0.f;
                wqn[k] = *(const u32x4*)(QRAW + (size_t)r * 768 + hd * 96 + 8 * s);
                wqr[k] = *(const u32x2*)(QRAW + (size_t)r * 768 + hd * 96 + 64 + 4 * s);
                wkn[k] = *(const u32x4*)(KVRAW + (size_t)r * 1024 + hd * 128 + 8 * s);
                wkr[k] = *(const u32x2*)(prow + O_KR + 4 * s);
                cm[k] = *(const f32x2*)(TABM + (latent ? spos : 0) * 32 + 2 * s); sm[k] = *(const f32x2*)(TABM + (latent ? spos : 0) * 32 + 16 + 2 * s);
                cm[k][0] = latent ? cm[k][0] : 1.f; cm[k][1] = latent ? cm[k][1] : 1.f; sm[k][0] = latent ? sm[k][0] : 0.f; sm[k][1] = latent ? sm[k][1] : 0.f;
            }
#pragma unroll
            for (int k = 0; k < 4; ++k) {
                const int tl = wid * 8 + kb4 + k, r = r0 + tl, t = t0 + tl; (void)r;
                s1[k] = wave_sum(s1[k]); s2[k] = wave_sum(s2[k]);
                const float rcq = rsqrtf(s1[k] * (1.0f / 384.0f) + EPS), rckv = rsqrtf(s2[k] * (1.0f / 256.0f) + EPS);
                { float vn[8], vr[4]; unpack8(wqn[k], vn, rcq); vr[0] = bflo(wqr[k].x) * rcq; vr[1] = bfhi(wqr[k].x) * rcq; vr[2] = bflo(wqr[k].y) * rcq; vr[3] = bfhi(wqr[k].y) * rcq;
                  float ss = vr[0] * vr[0] + vr[1] * vr[1] + vr[2] * vr[2] + vr[3] * vr[3];
#pragma unroll
                  for (int j = 0; j < 8; ++j) ss += vn[j] * vn[j];
                  ss = red8(ss); const float mul = rsqrtf(ss * (1.0f / 96.0f) + EPS) * qsm;
#pragma unroll
                  for (int j = 0; j < 8; ++j) vn[j] *= mul * gqn[j];
#pragma unroll
                  for (int j = 0; j < 4; ++j) vr[j] *= mul * gqr[j];
                  const float a0 = vr[0] * cm[k][0] - vr[1] * sm[k][0], a1 = vr[1] * cm[k][0] + vr[0] * sm[k][0], a2 = vr[2] * cm[k][1] - vr[3] * sm[k][1], a3 = vr[3] * cm[k][1] + vr[2] * sm[k][1];
                  bf16_t* d = QM + ((size_t)(b * 8 + hd) * TT + t) * 96;
                  *(u32x4*)(d + 8 * s) = pack8(vn); u32x2 o; o.x = pk2(a0, a1); o.y = pk2(a2, a3); *(u32x2*)(d + 64 + 4 * s) = o; }
                { float vn[8], vr[4]; unpack8(wkn[k], vn, rckv); vr[0] = bflo(wkr[k].x); vr[1] = bfhi(wkr[k].x); vr[2] = bflo(wkr[k].y); vr[3] = bfhi(wkr[k].y);
                  float ss = vr[0] * vr[0] + vr[1] * vr[1] + vr[2] * vr[2] + vr[3] * vr[3];
#pragma unroll
                  for (int j = 0; j < 8; ++j) ss += vn[j] * vn[j];
                  ss = red8(ss); const float mul = rsqrtf(ss * (1.0f / 96.0f) + EPS);
#pragma unroll
                  for (int j = 0; j < 8; ++j) vn[j] *= mul * gkn[j];
#pragma unroll
                  for (int j = 0; j < 4; ++j) vr[j] *= mul * gkr[j];
                  const float a0 = vr[0] * cm[k][0] - vr[1] * sm[k][0], a1 = vr[1] * cm[k][0] + vr[0] * sm[k][0], a2 = vr[2] * cm[k][1] - vr[3] * sm[k][1], a3 = vr[3] * cm[k][1] + vr[2] * sm[k][1];
                  bf16_t* d = KM + ((size_t)(b * 8 + hd) * TT + t) * 96;
                  *(u32x4*)(d + 8 * s) = pack8(vn); u32x2 o; o.x = pk2(a0, a1); o.y = pk2(a2, a3); *(u32x2*)(d + 64 + 4 * s) = o; }
            }
            }
        } else if (type == 1) {
#pragma unroll 1
            for (int kb4 = 0; kb4 < 8; kb4 += 4) {
                u32x4 wdq[4], wdk[4]; f32x4 cd[4], sd[4];
#pragma unroll
                for (int k = 0; k < 4; ++k) { const int tl = wid * 8 + kb4 + k, r = r0 + tl, spos = spos0 + tl;
                    const bf16_t* prow = PROJ + (size_t)r * INWP;
                    wdq[k] = *(const u32x4*)(prow + O_DQ + lane * 8); wdk[k] = *(const u32x4*)(prow + O_DK + lane * 8);
                    cd[k] = *(const f32x4*)(TABD + (latent ? spos : 0) * 64 + 4 * s); sd[k] = *(const f32x4*)(TABD + (latent ? spos : 0) * 64 + 32 + 4 * s); }
#pragma unroll
                for (int k = 0; k < 4; ++k) { const int tl = wid * 8 + kb4 + k, t = t0 + tl;
#pragma unroll
                    for (int j = 0; j < 4; ++j) { cd[k][j] = latent ? cd[k][j] : 1.f; sd[k][j] = latent ? sd[k][j] : 0.f; }
#pragma unroll
                    for (int qk = 0; qk < 2; ++qk) { float v[8]; unpack8(qk ? wdk[k] : wdq[k], v, 1.0f); float ss = 0.f;
#pragma unroll
                      for (int j = 0; j < 8; ++j) ss += v[j] * v[j];
                      ss = red8(ss); const float mul = rsqrtf(ss * (1.0f / 64.0f) + EPS) * (qk ? 1.0f : qsd);
#pragma unroll
                      for (int j = 0; j < 8; ++j) v[j] *= mul * (qk ? gdk[j] : gdq[j]);
                      float o[8];
#pragma unroll
                      for (int jj = 0; jj < 4; ++jj) { o[2 * jj] = v[2 * jj] * cd[k][jj] - v[2 * jj + 1] * sd[k][jj]; o[2 * jj + 1] = v[2 * jj + 1] * cd[k][jj] + v[2 * jj] * sd[k][jj]; }
                      bf16_t* d = (qk ? KD : QD) + ((size_t)(b * 8 + hd) * TT + t) * 64 + 8 * s;
                      *(u32x4*)d = pack8(o); }
                }
            }
        } else if (type < 4) {
#pragma unroll 4
            for (int k = 0; k < 8; ++k) {
                const int tl = wid * 8 + k, r = r0 + tl;
                const bf16_t* prow = PROJ + (size_t)r * INWP;
                const bool mla = (type == 2);
                float s2 = sumsq8(*(const u32x4*)(prow + O_CKV + (lane < 32 ? lane : 0) * 8)); s2 = lane < 32 ? s2 : 0.f;
                const bf16_t* wsrc = mla ? KVRAW + (size_t)r * 1024 + hd * 128 + 64 + 8 * s : prow + O_DV + lane * 8;
                const u32x4 w = *(const u32x4*)wsrc;
                s2 = wave_sum(s2); const float sc = mla ? rsqrtf(s2 * (1.0f / 256.0f) + EPS) : 1.0f;
                float v[8]; unpack8(w, v, sc);
                const u32x4 o = pack8(v); const unsigned ow[4] = {o.x, o.y, o.z, o.w};
                LAS bf16_t* dl = (LAS bf16_t*)(Vl + (size_t)(hd * 64 + 8 * s) * 144) + tl;
#pragma unroll
                for (int j = 0; j < 4; ++j) { dl[(2 * j) * 72] = (bf16_t)(ow[j] & 0xffffu); dl[(2 * j + 1) * 72] = (bf16_t)(ow[j] >> 16); }
            }
            __syncthreads();
            { bf16_t* VT = type == 2 ? VTM : VTD;
#pragma unroll
              for (int kk = 0; kk < 8; ++kk) { const int row = (tid >> 3) + 64 * kk, ch = tid & 7;
                  const u32x4 w = *(LAS const u32x4*)(Vl + row * 144 + ch * 16);
                  *(u32x4*)(VT + ((size_t)(b * 512 + row) * TT + t0 + ch * 8)) = w; } }
            __syncthreads();
        } else {
            float w0[8], w1[8], w2[8];
            { const f32x4 a = *(const f32x4*)(cw + lane * 8), a2 = *(const f32x4*)(cw + lane * 8 + 4), b1 = *(const f32x4*)(cw + 512 + lane * 8), b2 = *(const f32x4*)(cw + 512 + lane * 8 + 4),
                          c1 = *(const f32x4*)(cw + 1024 + lane * 8), c2 = *(const f32x4*)(cw + 1024 + lane * 8 + 4);
#pragma unroll
              for (int j = 0; j < 4; ++j) { w0[j] = a[j]; w0[4 + j] = a2[j]; w1[j] = b1[j]; w1[4 + j] = b2[j]; w2[j] = c1[j]; w2[4 + j] = c2[j]; } }
            const int rf = r0 + wid * 8, sf = spos0 + wid * 8;
            const bf16_t* pb = PROJ + (size_t)rf * INWP + lane * 8;
            float up[8], uc[8];
#pragma unroll
            for (int j = 0; j < 8; ++j) up[j] = 0.f;
            { const bool hasp = sf > 0; const bf16_t* pp = hasp ? pb - (size_t)INWP : pb;
              float a[8], c[8]; unpack8(*(const u32x4*)(pp + O_CC), a, 1.0f); unpack8(*(const u32x4*)(pp + O_CX), c, 1.0f);
#pragma unroll
              for (int j = 0; j < 8; ++j) up[j] = hasp ? a[j] * c[j] : 0.f; }
            { float a[8], c[8]; unpack8(*(const u32x4*)(pb + O_CC), a, 1.0f); unpack8(*(const u32x4*)(pb + O_CX), c, 1.0f);
#pragma unroll
              for (int j = 0; j < 8; ++j) uc[j] = a[j] * c[j]; }
#pragma unroll
            for (int k = 0; k < 8; ++k) { const bf16_t* q = pb + (size_t)k * INWP;
                float un[8];
                { const bool hasn = sf + k + 1 < seglen; const bf16_t* qn = hasn ? q + INWP : q;
                  float a[8], c[8]; unpack8(*(const u32x4*)(qn + O_CC), a, 1.0f); unpack8(*(const u32x4*)(qn + O_CX), c, 1.0f);
#pragma unroll
                  for (int j = 0; j < 8; ++j) un[j] = hasn ? a[j] * c[j] : 0.f; }
                float cb[8]; unpack8(*(const u32x4*)(q + O_CB), cb, 1.0f);
                float y[8];
#pragma unroll
                for (int j = 0; j < 8; ++j) y[j] = cb[j] * (w0[j] * up[j] + w1[j] * uc[j] + w2[j] * un[j]);
                *(u32x4*)(Y2 + (size_t)(rf + k) * 1536 + lane * 8) = pack8(y);
#pragma unroll
                for (int j = 0; j < 8; ++j) { up[j] = uc[j]; uc[j] = un[j]; } }
        }
    }
}

DI void prep_phase(const Params& p, int l, LAS unsigned char* ldsb) {
    const float* TABM = (const float*)(p.ws + WS_TAB);
    prep_body(p, l, ldsb, (const bf16_t*)(p.ws + WS_PROJ), (const bf16_t*)(p.ws + WS_R1), (const bf16_t*)(p.ws + WS_R1 + R1_KVRAW),
              (bf16_t*)(p.ws + WS_QKV + Q_QM), (bf16_t*)(p.ws + WS_QKV + Q_KM), (bf16_t*)(p.ws + WS_QKV + Q_VTM), (bf16_t*)(p.ws + WS_QKV + Q_QD), (bf16_t*)(p.ws + WS_QKV + Q_KD), (bf16_t*)(p.ws + WS_QKV + Q_VTD),
              (bf16_t*)(p.ws + WS_Y) + 1024, TABM, TABM + 2048 * 32, p.in[22] + (size_t)l * 3 * 512);
}

template <int KC, int DS, bool DIFF>
DI void attn_item(LAS unsigned char* lds, const bf16_t* Qw  , const bf16_t* K0, const bf16_t* K1, const bf16_t* Vt, int nkeys, float cshift,
                  f32x4 (&oacc)[DS][2], float (&lsum)[2]) {
    constexpr int DK = KC * 32, KROW = DK * 2 + 32, VROW = 160, DV = DS * 16;
    constexpr int KBYTES = (DIFF ? 2 : 1) * 64 * KROW, STG = KBYTES + DV * VROW;
    const int tid = tidx(), wid = tid >> 6, lane = tid & 63, fr = lane & 15, fq = lane >> 4;
    const int comp = DIFF ? (wid >> 2) : 0;
    const int vpos = (((tid & 7) >> 2) * 32 + (tid & 1) * 16 + ((tid >> 1) & 1) * 4) * 2;
    bf16x8 qf[2][KC];
#pragma unroll
    for (int qs = 0; qs < 2; ++qs)
#pragma unroll
        for (int kc = 0; kc < KC; ++kc) qf[qs][kc] = *(const bf16x8*)(Qw + (size_t)(qs * 16 + fr) * DK + kc * 32 + fq * 8);
#pragma unroll
    for (int ds = 0; ds < DS; ++ds) { oacc[ds][0] = (f32x4){0.f, 0.f, 0.f, 0.f}; oacc[ds][1] = (f32x4){0.f, 0.f, 0.f, 0.f}; }
    lsum[0] = 0.f; lsum[1] = 0.f;
    u32x4 rk0, rk1, rv0, rv1;
    auto gload = [&](int t) {
        if constexpr (!DIFF) {
            const char* kb = (const char*)K0 + (size_t)t * 64 * DK * 2;
            rk0 = *(const u32x4*)(kb + tid * 16);
            if (tid < 256) rk1 = *(const u32x4*)(kb + (512 + tid) * 16);
            rv0 = *(const u32x4*)((const char*)Vt + (size_t)(tid >> 3) * TT * 2 + (size_t)t * 128 + (tid & 7) * 16);
        } else {
            rk0 = *(const u32x4*)((const char*)K0 + (size_t)t * 64 * DK * 2 + tid * 16);
            rk1 = *(const u32x4*)((const char*)K1 + (size_t)t * 64 * DK * 2 + tid * 16);
            rv0 = *(const u32x4*)((const char*)Vt + (size_t)(tid >> 3) * TT * 2 + (size_t)t * 128 + (tid & 7) * 16);
            rv1 = *(const u32x4*)((const char*)Vt + (size_t)(64 + (tid >> 3)) * TT * 2 + (size_t)t * 128 + (tid & 7) * 16);
        }
    };
    auto lstore = [&](int st) {
        LAS unsigned char* kb = lds + st * STG; LAS unsigned char* vb = kb + KBYTES;
        if constexpr (!DIFF) {
            { const int key = tid / 12, pc = tid - key * 12; *(LAS u32x4*)(kb + key * KROW + pc * 16) = rk0; }
            if (tid < 256) { const int c = 512 + tid, key = c / 12, pc = c - key * 12; *(LAS u32x4*)(kb + key * KROW + pc * 16) = rk1; }
            { LAS unsigned char* d = vb + (tid >> 3) * VROW + vpos; *(LAS u32x2*)d = (u32x2){rv0.x, rv0.y}; *(LAS u32x2*)(d + 16) = (u32x2){rv0.z, rv0.w}; }
        } else {
            *(LAS u32x4*)(kb + (tid >> 3) * KROW + (tid & 7) * 16) = rk0;
            *(LAS u32x4*)(kb + 64 * KROW + (tid >> 3) * KROW + (tid & 7) * 16) = rk1;
            { LAS unsigned char* d = vb + (tid >> 3) * VROW + vpos; *(LAS u32x2*)d = (u32x2){rv0.x, rv0.y}; *(LAS u32x2*)(d + 16) = (u32x2){rv0.z, rv0.w}; }
            { LAS unsigned char* d = vb + (64 + (tid >> 3)) * VROW + vpos; *(LAS u32x2*)d = (u32x2){rv1.x, rv1.y}; *(LAS u32x2*)(d + 16) = (u32x2){rv1.z, rv1.w}; }
        }
    };
    auto readK = [&](int st, int kk, bf16x8 (&kf)[2][KC]) {
        LAS const unsigned char* kb = lds + st * STG + comp * 64 * KROW;
#pragma unroll
        for (int kc = 0; kc < KC; ++kc)
#pragma unroll
            for (int ks = 0; ks < 2; ++ks) kf[ks][kc] = *(LAS const bf16x8*)(kb + ((2 * kk + ks) * 16 + fr) * KROW + (kc * 32 + fq * 8) * 2);
    };
    auto readV = [&](int st, int kk, int d0, bf16x8 (&vf)[4]) {
        LAS const unsigned char* vb = lds + st * STG + KBYTES;
#pragma unroll
        for (int i = 0; i < 4; ++i) vf[i] = *(LAS const bf16x8*)(vb + ((d0 + i) * 16 + fr) * VROW + (kk * 32 + fq * 8) * 2);
    };
    auto smma = [&](const bf16x8 (&kf)[2][KC], f32x4 (&sacc)[2][2]) {
#pragma unroll
        for (int ks = 0; ks < 2; ++ks) { sacc[ks][0] = (f32x4){-cshift, -cshift, -cshift, -cshift}; sacc[ks][1] = (f32x4){-cshift, -cshift, -cshift, -cshift}; }
#pragma unroll
        for (int kc = 0; kc < KC; ++kc)
#pragma unroll
            for (int ks = 0; ks < 2; ++ks)
#pragma unroll
                for (int qs = 0; qs < 2; ++qs) sacc[ks][qs] = __builtin_amdgcn_mfma_f32_16x16x32_bf16(kf[ks][kc], qf[qs][kc], sacc[ks][qs], 0, 0, 0);
    };
    auto softmax = [&](const f32x4 (&sacc)[2][2], bf16x8 (&pb)[2]) {
#pragma unroll
        for (int qs = 0; qs < 2; ++qs) {
            float e[8];
#pragma unroll
            for (int j = 0; j < 4; ++j) { e[j] = __builtin_amdgcn_exp2f(sacc[0][qs][j]); e[4 + j] = __builtin_amdgcn_exp2f(sacc[1][qs][j]); }
            lsum[qs] += ((e[0] + e[1]) + (e[2] + e[3])) + ((e[4] + e[5]) + (e[6] + e[7]));
            u32x4 w; w.x = pk2(e[0], e[1]); w.y = pk2(e[2], e[3]); w.z = pk2(e[4], e[5]); w.w = pk2(e[6], e[7]);
            pb[qs] = __builtin_bit_cast(bf16x8, w);
        }
    };
    auto pv4 = [&](const bf16x8 (&vf)[4], int d0, const bf16x8 (&pb)[2]) {
#pragma unroll
        for (int i = 0; i < 4; ++i)
#pragma unroll
            for (int qs = 0; qs < 2; ++qs) oacc[d0 + i][qs] = __builtin_amdgcn_mfma_f32_16x16x32_bf16(vf[i], pb[qs], oacc[d0 + i][qs], 0, 0, 0);
    };
#define SB() __builtin_amdgcn_sched_barrier(0)
    const int ntiles = nkeys >> 6;
    if constexpr (!DIFF) {
        gload(0); lstore(0); gload(1); lstore(1);
        __syncthreads();
        f32x4 sA[2][2], sB[2][2]; bf16x8 pb[2]; bf16x8 kf[2][KC]; bf16x8 vf[4];
        readK(0, 0, kf); smma(kf, sA);
        int st = 0;
        auto iter = [&](auto m1c, auto m2c, int t) {
            constexpr bool m1 = decltype(m1c)::value, m2 = decltype(m2c)::value;
            const int st1 = (st == 2) ? 0 : st + 1, st2 = (st1 == 2) ? 0 : st1 + 1;
            if constexpr (m2) gload(t + 2);
            readK(st, 1, kf); readV(st, 0, 0, vf); SB();
            smma(kf, sB); softmax(sA, pb);
            pv4(vf, 0, pb); SB();
            if constexpr (m1) readK(st1, 0, kf);
            readV(st, 1, 0, vf); SB();
            if constexpr (m1) smma(kf, sA);
            softmax(sB, pb);
            pv4(vf, 0, pb); SB();
            if constexpr (m2) lstore(st2);
            __syncthreads();
            st = st1;
        };
#pragma unroll 1
        for (int t = 0; t + 2 < ntiles; ++t) iter(std::true_type{}, std::true_type{}, t);
        iter(std::true_type{}, std::false_type{}, ntiles - 2);
        iter(std::false_type{}, std::false_type{}, ntiles - 1);
    } else {
        gload(0); lstore(0);
        __syncthreads();
        f32x4 sA[2][2]; bf16x8 pb[2]; bf16x8 kf[2][KC]; bf16x8 vf[4], vg[4];
        auto iter = [&](auto morec, int t) {
            constexpr bool more = decltype(morec)::value;
            const int st = t & 1;
            if constexpr (more) gload(t + 1);
#pragma unroll
            for (int kk = 0; kk < 2; ++kk) {
                readK(st, kk, kf); readV(st, kk, 0, vf); SB();
                smma(kf, sA); softmax(sA, pb); readV(st, kk, 4, vg);
                pv4(vf, 0, pb);
                pv4(vg, 4, pb); SB();
            }
            if constexpr (more) lstore((t + 1) & 1);
            __syncthreads();
        };
#pragma unroll 1
        for (int t = 0; t + 1 < ntiles; ++t) iter(std::true_type{}, t);
        iter(std::false_type{}, ntiles - 1);
    }
#undef SB
#pragma unroll
    for (int qs = 0; qs < 2; ++qs) { lsum[qs] += __shfl_xor(lsum[qs], 16); lsum[qs] += __shfl_xor(lsum[qs], 32); }
}

DI void attn_phase(const Params& p, int l, bool need_ctx, LAS unsigned char* lds) {
    const int tid = tidx(), wid = tid >> 6, lane = tid & 63, fr = lane & 15, fq = lane >> 4;
    const bf16_t* QM = (const bf16_t*)(p.ws + WS_QKV + Q_QM); const bf16_t* KM = (const bf16_t*)(p.ws + WS_QKV + Q_KM); const bf16_t* VTM = (const bf16_t*)(p.ws + WS_QKV + Q_VTM);
    const bf16_t* QD = (const bf16_t*)(p.ws + WS_QKV + Q_QD); const bf16_t* KD = (const bf16_t*)(p.ws + WS_QKV + Q_KD); const bf16_t* VTD = (const bf16_t*)(p.ws + WS_QKV + Q_VTD);
    bf16_t* Y0 = (bf16_t*)(p.ws + WS_Y); bf16_t* Y1 = Y0 + 512;
    float gq = 0.f, gk = 0.f;
    { const float a = lane < 48 ? fmaxf(fabsf(p.in[16][l * 96 + lane]), fabsf(p.in[16][l * 96 + 48 + lane])) : 0.f; gq = wave_max(a);
      const float b = lane < 48 ? fmaxf(fabsf(p.in[17][l * 96 + lane]), fabsf(p.in[17][l * 96 + 48 + lane])) : 0.f; gk = wave_max(b); }
    const float cs_m = gq * gk * 9.797958971132712f * LOG2E;
    { gq = wave_max(fabsf(p.in[18][l * 64 + lane])); gk = wave_max(fabsf(p.in[19][l * 64 + lane])); }
    const float cs_d = gq * gk * 8.0f * LOG2E;
    const float li = lam_init_of(l);
    float lam;
    { const float* lv = p.in[20] + (size_t)l * 256; const float s1 = wave_sum(lv[lane] * lv[64 + lane]), s2 = wave_sum(lv[128 + lane] * lv[192 + lane]); lam = expf(s1) - expf(s2) + li; }
    const float* gsub = p.in[21] + l * 128;
    const int first = need_ctx ? 0 : 128;
    for (int item = first + blockIdx.x; item < 1152; item += gridDim.x) {
        if (item < 64 || (item >= 128 && item < 640)) {
            int bh, tq0, nkeys;
            if (item < 64) { bh = item; tq0 = 0; nkeys = 256; } else { const int i = item - 128; bh = (i >> 8) * 32 + (i & 31); tq0 = 256 + ((i >> 5) & 7) * 256; nkeys = TT; }
            const int b = bh >> 3, h = bh & 7;
            f32x4 oacc[4][2]; float lsum[2];
            attn_item<3, 4, false>(lds, QM + ((size_t)bh * TT + tq0 + wid * 32) * 96, KM + (size_t)bh * TT * 96, nullptr, VTM + (size_t)bh * 64 * TT, nkeys, cs_m, oacc, lsum);
#pragma unroll
            for (int qs = 0; qs < 2; ++qs) { const float inv = 1.0f / lsum[qs]; const int tq = tq0 + wid * 32 + qs * 16 + fr;
                const size_t row = tq >= 256 ? (size_t)b * 2048 + (tq - 256) : (size_t)ML + b * 256 + tq;
#pragma unroll
                for (int ds = 0; ds < 4; ++ds) { const f32x4 o = oacc[ds][qs] * inv; u32x2 w; w.x = pk2(o[0], o[1]); w.y = pk2(o[2], o[3]);
                    *(u32x2*)(Y0 + row * 1536 + h * 64 + ds * 16 + fq * 4) = w; } }
        } else {
            int bh, tq0, nkeys;
            if (item < 128) { const int i = item - 64; bh = i & 31; tq0 = (i >> 5) * 128; nkeys = 256; } else { const int i = item - 640; bh = (i >> 8) * 16 + (i & 15); tq0 = 256 + ((i >> 4) & 15) * 128; nkeys = TT; }
            const int b = bh >> 2, h = bh & 3, comp = wid >> 2, wq = wid & 3;
            f32x4 oacc[8][2]; float lsum[2];
            const size_t kvec = (size_t)(bh * 2) * TT * 64;
            attn_item<2, 8, true>(lds, QD + ((size_t)(bh * 2 + comp) * TT + tq0 + wq * 32) * 64, KD + kvec, KD + kvec + (size_t)TT * 64, VTD + (size_t)bh * 128 * TT, nkeys, cs_d, oacc, lsum);
            LAS float* X = (LAS float*)lds;
            if (comp == 1) {
#pragma unroll
                for (int qs = 0; qs < 2; ++qs) { const float sc = lam / lsum[qs]; const int ql = wq * 32 + qs * 16 + fr;
#pragma unroll
                    for (int ds = 0; ds < 8; ++ds) *(LAS f32x4*)(X + ql * 132 + ds * 16 + fq * 4) = oacc[ds][qs] * sc; }
            }
            __syncthreads();
            if (comp == 0) {
#pragma unroll
                for (int qs = 0; qs < 2; ++qs) { const float inv = 1.0f / lsum[qs]; const int ql = wq * 32 + qs * 16 + fr; const int tq = tq0 + ql;
                    float ss = 0.f;
#pragma unroll
                    for (int ds = 0; ds < 8; ++ds) { const f32x4 o2 = *(LAS const f32x4*)(X + ql * 132 + ds * 16 + fq * 4); const f32x4 o = oacc[ds][qs] * inv - o2; oacc[ds][qs] = o;
                        ss += o[0] * o[0] + o[1] * o[1] + o[2] * o[2] + o[3] * o[3]; }
                    ss += __shfl_xor(ss, 16); ss += __shfl_xor(ss, 32);
                    const float rs = rsqrtf(ss * (1.0f / 128.0f) + EPS) * (1.0f - li);
                    const size_t row = tq >= 256 ? (size_t)b * 2048 + (tq - 256) : (size_t)ML + b * 256 + tq;
#pragma unroll
                    for (int ds = 0; ds < 8; ++ds) { const f32x4 gg = *(const f32x4*)(gsub + ds * 16 + fq * 4); const f32x4 o = oacc[ds][qs] * rs * gg;
                        u32x2 w; w.x = pk2(o[0], o[1]); w.y = pk2(o[2], o[3]);
                        *(u32x2*)(Y1 + row * 1536 + h * 128 + ds * 16 + fq * 4) = w; } }
            }
            __syncthreads();
        }
    }
}

#define XB_TMO      128
#define XB_XCNT(j)  (256  + 64 * (j))
#define XB_XSUB(j)  (1280 + 64 * (j))
#define XB_XGEN(j)  (2304 + 64 * (j))
#define XB_TOP      3328
#define XB_TOPGEN   3392
#define XCD_BAR_WORDS 3456
#define XB_SPIN_CAP (1u << 18)
DI unsigned xb_ld(unsigned* p) { return __hip_atomic_load(p, __ATOMIC_RELAXED, __HIP_MEMORY_SCOPE_AGENT); }
DI unsigned xb_add(unsigned* p, unsigned v) { return __hip_atomic_fetch_add(p, v, __ATOMIC_RELAXED, __HIP_MEMORY_SCOPE_AGENT); }
DI unsigned xb_xcc_id() { return (unsigned)__builtin_amdgcn_s_getreg((3 << 11) | 20) & 0xFu; }
#define XB_SPIN(cond, bar) do { unsigned _sp = 0; while (cond) { __builtin_amdgcn_s_sleep(1); \
    if ((++_sp & 255u) == 0u) { if (xb_ld(&(bar)[XB_TMO])) break; if (_sp > XB_SPIN_CAP) { atomicAdd(&(bar)[XB_TMO], 1u); break; } } } } while (0)
struct XcdBarrier { unsigned* bar; unsigned x; volatile LAS unsigned* st; };
DI XcdBarrier xcd_barrier_post(unsigned* bar, volatile LAS unsigned* st) {
    XcdBarrier b; b.bar = bar; b.x = xb_xcc_id(); b.st = st;
    if (threadIdx.x == 0) (void)xb_add(&bar[XB_XCNT(b.x)], 1u);
    return b;
}
DI void xcd_barrier_complete(unsigned* bar, unsigned x, unsigned& nloc, unsigned& nx) {
    const unsigned G = gridDim.x * gridDim.y * gridDim.z;
    unsigned sum, cnt, mine, sp = 0u;
    for (;;) {
        sum = 0u; cnt = 0u; mine = 0u;
#pragma unroll
        for (unsigned j = 0; j < 16; ++j) { const unsigned c = xb_ld(&bar[XB_XCNT(j)]); sum += c; cnt += (c > 0u) ? 1u : 0u; mine = (j == x) ? c : mine; }
        if (sum == G) break;
        __builtin_amdgcn_s_sleep(1);
        if ((++sp & 255u) == 0u) { if (xb_ld(&bar[XB_TMO])) break; if (sp > XB_SPIN_CAP) { atomicAdd(&bar[XB_TMO], 1u); break; } }
    }
    nloc = mine > 0u ? mine : 1u; nx = cnt > 0u ? cnt : 1u;
}
DI void xcd_barrier(const XcdBarrier& b) {
    asm volatile("s_waitcnt vmcnt(0)" ::: "memory");
    __syncthreads();
    if (threadIdx.x == 0) {
        unsigned* bar = b.bar;
        __builtin_amdgcn_s_waitcnt(0);
        unsigned nloc = b.st[0], nx = b.st[1];
        if (nloc == 0u) { xcd_barrier_complete(bar, b.x, nloc, nx); b.st[0] = nloc; b.st[1] = nx; }
        const unsigned old = xb_add(&bar[XB_XSUB(b.x)], 1u);
        const unsigned gen = old / nloc;
        if (old + 1u == (gen + 1u) * nloc) {
            __builtin_amdgcn_fence(__ATOMIC_RELEASE, "agent");
            asm volatile("s_waitcnt vmcnt(0)" ::: "memory");
            const unsigned og = xb_add(&bar[XB_TOP], 1u);
            const unsigned tg = og / nx;
            if (og + 1u == (tg + 1u) * nx) xb_add(&bar[XB_TOPGEN], 1u);
            else XB_SPIN(xb_ld(&bar[XB_TOPGEN]) == tg, bar);
            __builtin_amdgcn_fence(__ATOMIC_ACQUIRE, "agent");
            xb_add(&bar[XB_XGEN(b.x)], 1u);
            asm volatile("s_waitcnt vmcnt(0)" ::: "memory");
        } else {
            XB_SPIN(xb_ld(&bar[XB_XGEN(b.x)]) == gen, bar);
            __builtin_amdgcn_fence(__ATOMIC_ACQUIRE, "agent");
            asm volatile("s_waitcnt vmcnt(0)" ::: "memory");
        }
    }
    __syncthreads();
}

#ifndef PROBE_MASK
#define PROBE_MASK 0
#endif
#define REPS(bit) for (int rep_ = 0; rep_ < (((PROBE_MASK) >> (bit)) & 1) + 1; ++rep_)
typedef const __attribute__((address_space(4))) Params* KP;
#define PH_BEGIN KP pp_ = (KP)__builtin_amdgcn_kernarg_segment_ptr(); asm volatile("" : "+s"(pp_)); const Params& p = *(const Params*)pp_; \
    int G = gridDim.x, c = blockIdx.x; asm volatile("" : "+s"(G), "+s"(c)); \
    float* XL = p.out; float* XC = (float*)(p.ws + WS_XC); const float* modl = (const float*)(p.ws + WS_MOD) + (size_t)l * 9 * 9216; const float* ng = p.in[6] + (size_t)l * 3 * 1024; \
    bf16_t* W = (bf16_t*)(p.ws + ((l & 1) ? WS_W2 : WS_W)); bf16_t* H = (bf16_t*)(p.ws + WS_R1); bf16_t* MB = H; bf16_t* QRAW = H; bf16_t* KVRAW = (bf16_t*)(p.ws + WS_R1 + R1_KVRAW); \
    bf16_t* PROJ = (bf16_t*)(p.ws + WS_PROJ); bf16_t* ACT = PROJ; float* MACC = (float*)(p.ws + WS_QKV); float* PART = MACC; bf16_t* Y = (bf16_t*)(p.ws + WS_Y); \
    (void)G; (void)c; (void)XL; (void)XC; (void)modl; (void)ng; (void)W; (void)H; (void)MB; (void)QRAW; (void)KVRAW; (void)PROJ; (void)ACT; (void)MACC; (void)Y; (void)PART;

__global__ void __launch_bounds__(512, 2) fwd_megakernel(Params p_unused) {
    extern __shared__ __attribute__((aligned(16))) unsigned char shm[];
    LAS unsigned char* lds = (LAS unsigned char*)shm;
    cg::grid_group grid = cg::this_grid();
    volatile LAS unsigned* xst = (volatile LAS unsigned*)(lds + pg8::STAGE_BYTES);
    if (threadIdx.x < 4) xst[threadIdx.x] = 0u;
    __syncthreads();
    XcdBarrier xb;
    { KP pp_ = (KP)__builtin_amdgcn_kernarg_segment_ptr(); xb = xcd_barrier_post((unsigned*)(pp_->ws + WS_BAR), xst); }
#define GSYNC() xcd_barrier(xb)

    REPS(6) { int l = 0; PH_BEGIN; mod_phase(p, lds); }
    { int l = 0; PH_BEGIN; tab_phase(p); }
    REPS(6) { int l = 0; PH_BEGIN; conv_weights(p, 0, lds, W, c, G); }
    grid.sync();

#pragma unroll 1
    for (int lq = 0; lq < DEPTH; ++lq) {
        int l = lq; asm volatile("" : "+s"(l));
        const bool last = (l == DEPTH - 1);
        const int Mx = last ? ML : MT;
        REPS(2) { PH_BEGIN; if (l == 0) norm_phase(p.in[0], p.in[2], XL, XC, true, H, ng, modl, 0, 1, MT, PART, 0); else norm_phase(XL, XC, XL, XC, false, H, ng, modl, 0, 1, MT, PART, 4); }
        GSYNC();
        REPS(1) { PH_BEGIN; pg8::Sched S; S.init(MT, 5632, 1024, G, c); pg8::Gemm g{H, W + W_1U, 1024, 1024}; EpiSwiglu E{ACT}; pg8::gemm_phase(lds, g, S, E); }
        GSYNC();
        { PH_BEGIN; pg8::Sched S; S.init(ML, 1024, DFF, G, c); S.add_split(MC / 256, ML / 256, 4); pg8::Gemm g{ACT, W + W_1D, DFF, DFF}; EpiResid E{XL, XC, modl, 2, 0.5f, PART}; pg8::gemm_phase(lds, g, S, E); }
        GSYNC();
        REPS(2) { PH_BEGIN; norm_phase(XL, XC, XL, XC, false, H, ng + 1024, modl, 3, 4, MT, PART, 4); }
        GSYNC();
        if (!last) { REPS(1) { PH_BEGIN; pg8::Sched S; S.init(MT, INWP, 1024, G, c); pg8::Gemm g{H, W + W_IN, 1024, 1024}; EpiStore E{PROJ, INWP, O_G}; pg8::gemm_phase(lds, g, S, E); } }
        else {
            { PH_BEGIN; pg8::Sched S; S.init(ML, INWP, 1024, G, c); pg8::Gemm g{H, W + W_IN, 1024, 1024}; EpiStore E{PROJ, INWP, O_G}; pg8::gemm_phase(lds, g, S, E); }
            { PH_BEGIN; pg8::Sched S; S.init(MC, 2048, 1024, G, (c + 64) % G); pg8::Gemm g{H + (size_t)ML * 1024, W + W_IN + (size_t)256 * 1024, 1024, 1024}; EpiStore E{PROJ + (size_t)ML * INWP + 256, INWP, 1 << 30}; pg8::gemm_phase(lds, g, S, E); }
        }
        GSYNC();
        REPS(2) { PH_BEGIN; pg8::Sched S; S.init(MT, 768, 384, G, c); pg8::Gemm g{PROJ + O_CQ, W + W_UQ, INWP, 384}; EpiStore E{QRAW, 768, 1 << 30}; pg8::gemm_phase(lds, g, S, E); }
        REPS(2) { PH_BEGIN; pg8::Sched S; S.init(MT, 1024, 256, G, (c + 40) % G); pg8::Gemm g{PROJ + O_CKV, W + W_UKV, INWP, 256}; EpiStore E{KVRAW, 1024, 1 << 30}; pg8::gemm_phase(lds, g, S, E); }
        GSYNC();
        REPS(2) { PH_BEGIN; prep_phase(p, l, lds); }
        GSYNC();
        REPS(0) { PH_BEGIN; attn_phase(p, l, !last, lds); }
        GSYNC();
        { PH_BEGIN; pg8::Sched S; S.init(Mx, 1024, 512, G, c, 3, 0, 0); S.kseg = 512; pg8::Gemm g{Y, W + W_BR, 1536, 1536}; EpiMerge E{MB, PROJ}; pg8::gemm_phase(lds, g, S, E);
          { int heavy = (MT / 256) * 4 - G; if (heavy < 0 || heavy >= G) heavy = 0;
            if (!last && c >= heavy) { bf16_t* Wn = (bf16_t*)(p.ws + (((l + 1) & 1) ? WS_W2 : WS_W)); conv_weights(p, l + 1, lds, Wn, c - heavy, G - heavy); } } }
        GSYNC();
        for (int r_ = 0; r_ < 6 * (((PROBE_MASK) >> 3) & 1); ++r_) GSYNC();
        { PH_BEGIN; pg8::Sched S; S.init(ML, 1024, 1024, G, c); if (!last) S.add_split(MC / 256, ML / 256, 4); pg8::Gemm g{MB, W + W_O, 1024, 1024}; EpiResid E{XL, XC, modl, 5, 1.0f, PART}; pg8::gemm_phase(lds, g, S, E); }
        GSYNC();
        REPS(2) { PH_BEGIN; norm_phase(XL, XC, XL, XC, false, H, ng + 2048, modl, 6, 7, Mx, PART, last ? 0 : 4); }
        GSYNC();
        REPS(1) { PH_BEGIN; pg8::Sched S; S.init(Mx, 5632, 1024, G, c); pg8::Gemm g{H, W + W_2U, 1024, 1024}; EpiSwiglu E{ACT}; pg8::gemm_phase(lds, g, S, E); }
        GSYNC();
        { PH_BEGIN; pg8::Sched S; S.init(ML, 1024, DFF, G, c); if (!last) S.add_split(MC / 256, ML / 256, 4); pg8::Gemm g{ACT, W + W_2D, DFF, DFF}; EpiResid E{XL, XC, modl, 8, 0.5f, PART}; pg8::gemm_phase(lds, g, S, E); }
        GSYNC();
    }
}

extern "C" void kernel_launch(void* const* d_in, const int* in_sizes, int n_in, void* d_out, int out_size, void* d_ws, size_t ws_size, hipStream_t stream) {
    constexpr int LDS_BYTES = pg8::STAGE_BYTES + 16;
    static int grid = 0;
    if (grid == 0) {
        if (n_in != 25 || ws_size < WS_END) { fprintf(stderr, "kernel_launch: bad inputs (n_in %d, ws %zu need %zu)\n", n_in, ws_size, (size_t)WS_END); grid = -1; return; }
        int dev = 0, cus = 0, per_cu = 0;
        hipGetDevice(&dev);
        hipDeviceGetAttribute(&cus, hipDeviceAttributeMultiprocessorCount, dev);
        hipFuncSetAttribute((const void*)fwd_megakernel, hipFuncAttributeMaxDynamicSharedMemorySize, LDS_BYTES);
        hipOccupancyMaxActiveBlocksPerMultiprocessor(&per_cu, (const void*)fwd_megakernel, 512, LDS_BYTES);
        if (per_cu < 1) per_cu = 1;
        (void)hipGetLastError();
        grid = cus;
    }
    if (grid < 0) return;
    Params p{};
    for (int i = 0; i < 25; ++i) p.in[i] = (const float*)d_in[i];
    p.out = (float*)d_out; p.ws = (unsigned char*)d_ws;
    (void)hipMemsetAsync((unsigned char*)d_ws + WS_BAR, 0, XCD_BAR_WORDS * 4, stream);
    void* args[] = {&p};
    hipError_t e = hipLaunchCooperativeKernel((const void*)fwd_megakernel, dim3(grid), dim3(512), args, LDS_BYTES, stream);
    if (e != hipSuccess) fprintf(stderr, "cooperative launch failed: %s (grid %d)\n", hipGetErrorString(e), grid);
}
```

```cpp
#include <hip/hip_runtime.h>
#include <hip/hip_cooperative_groups.h>
#include <cstdio>
#include <type_traits>
namespace cg = cooperative_groups;

#define LAS __attribute__((address_space(3)))
typedef unsigned short bf16_t;
typedef short bf16x8 __attribute__((ext_vector_type(8)));
typedef float f32x4 __attribute__((ext_vector_type(4)));
typedef float f32x2 __attribute__((ext_vector_type(2)));
typedef unsigned u32x4 __attribute__((ext_vector_type(4)));
typedef unsigned u32x2 __attribute__((ext_vector_type(2)));
typedef __bf16 bf16x2_t __attribute__((ext_vector_type(2)));
#define DI __device__ __forceinline__

constexpr int D = 1024, NB = 8, SEQ = 2048, NCTX = 256, TT = 2304, DEPTH = 4;
constexpr int ML = NB * SEQ;
constexpr int MC = NB * NCTX;
constexpr int MT = ML + MC;
constexpr int DFF = 2816, INW = 6816, INWP = 6912;
constexpr int O_CQ = 0, O_CKV = 384, O_KR = 640, O_DQ = 672, O_DK = 1184, O_DV = 1696, O_CB = 2208, O_CC = 2720, O_CX = 3232, O_G = 3744;
constexpr float EPS = 1e-6f;
constexpr float LOG2E = 1.4426950408889634f;

constexpr size_t al256(size_t x) { return (x + 255) & ~(size_t)255; }
constexpr size_t WS_MOD = 0;
constexpr size_t WS_TAB = al256(WS_MOD + (size_t)4 * 9 * 9216 * 4);
constexpr size_t WS_XC = al256(WS_TAB + (size_t)2048 * 96 * 4);
constexpr size_t WS_W = al256(WS_XC + (size_t)MC * D * 4);
constexpr size_t W_1U = 0, W_1D = W_1U + (size_t)5632 * 1024, W_2U = W_1D + (size_t)1024 * 2816, W_2D = W_2U + (size_t)5632 * 1024,
                 W_IN = W_2D + (size_t)1024 * 2816, W_UQ = W_IN + (size_t)INWP * 1024, W_UKV = W_UQ + (size_t)768 * 384,
                 W_BR = W_UKV + (size_t)1024 * 256, W_O = W_BR + (size_t)3 * 1024 * 512, W_END = W_O + (size_t)1024 * 1024;
constexpr size_t WS_R1 = al256(WS_W + W_END * 2);
constexpr size_t R1_KVRAW = (size_t)MT * 768 * 2;
constexpr size_t WS_PROJ = al256(WS_R1 + (size_t)MT * (768 + 1024) * 2);
constexpr size_t WS_QKV = al256(WS_PROJ + (size_t)MT * INWP * 2);
constexpr size_t Q_QM = 0, Q_KM = Q_QM + (size_t)NB * 8 * TT * 96 * 2, Q_VTM = Q_KM + (size_t)NB * 8 * TT * 96 * 2, Q_QD = Q_VTM + (size_t)NB * 8 * 64 * TT * 2,
                 Q_KD = Q_QD + (size_t)NB * 8 * TT * 64 * 2, Q_VTD = Q_KD + (size_t)NB * 8 * TT * 64 * 2, Q_END = Q_VTD + (size_t)NB * 4 * 128 * TT * 2;
constexpr size_t WS_Y = al256(WS_QKV + Q_END);
constexpr size_t WS_BAR = al256(WS_Y + (size_t)3 * MT * 512 * 2);
constexpr size_t WS_W2 = al256(WS_BAR + 3456 * 4);
constexpr size_t WS_END = al256(WS_W2 + W_END * 2);
static_assert(Q_END >= (size_t)MT * 1024 * 4, "MACC alias");

struct Params {
    const float* in[25];
    float* out;
    unsigned char* ws;
};

DI unsigned pk2(float a, float b) { f32x2 f = {a, b}; bf16x2_t h = __builtin_convertvector(f, bf16x2_t); return __builtin_bit_cast(unsigned, h); }
DI float bflo(unsigned u) { return __uint_as_float(u << 16); }
DI float bfhi(unsigned u) { return __uint_as_float(u & 0xffff0000u); }
DI float wave_sum(float v) {
#pragma unroll
    for (int o = 32; o > 0; o >>= 1) v += __shfl_xor(v, o);
    return v;
}
DI float wave_max(float v) {
#pragma unroll
    for (int o = 32; o > 0; o >>= 1) v = fmaxf(v, __shfl_xor(v, o));
    return v;
}
DI float lam_init_of(int l) { return l == 0 ? 0.2f : (l == 1 ? 0.35550907f : (l == 2 ? 0.47071302f : 0.55605820f)); }
DI float sigmoidf_(float x) { return __builtin_amdgcn_rcpf(1.0f + __builtin_amdgcn_exp2f(-1.4426950408889634f * x)); }
DI int tidx() { int t = threadIdx.x; asm volatile("" : "+v"(t)); return t; }

namespace pg8 {
constexpr int BM = 256, BK = 64, HALF = 128, HTB = HALF * BK * 2, STAGE_BYTES = 8 * HTB, NXCD = 8, WGM = 8;
DI int lds_byte(int r, int c) { const int st = (r >> 4) * 2 + (c >> 5), rr = r & 15, cc = c & 31, ob = rr * 64 + cc * 2; return st * 1024 + (ob ^ (((ob >> 9) & 1) << 5)); }
DI void stage_rc(int b, int& R, int& C) { const int st = b / 1024, sb = b % 1024, swz = sb ^ (((sb >> 9) & 1) << 5); R = (st >> 1) * 16 + swz / 64; C = (st & 1) * 32 + (swz % 64) / 2; }
DI int perm32(int rho) { const int n = rho >> 4, i = rho & 15; return 8 * (i >> 2) + 4 * n + (i & 3); }
struct Unit { int pm, pn, k0, nt, split; };
struct Gemm { const bf16_t* A; const bf16_t* Bt; int lda, K; };

struct Sched {
    int nM, nN, nwg, G, c, rep, aStride, bStride, ntFull;
    int nSplit, P, splitPm0, nb;
    int kseg;
    DI void init(int M, int N, int K, int G_, int c_, int rep_ = 1, int as_ = 0, int bs_ = 0) { nM = M / BM; nN = N / BM; nwg = nM * nN; G = G_; c = c_; rep = rep_; aStride = as_; bStride = bs_; ntFull = K / BK;
        nSplit = 0; P = 1; splitPm0 = 0; nb = K / 128; kseg = 0; }
    DI void add_split(int tilesM, int pm0, int P_) { nSplit = tilesM * nN * P_; P = P_; splitPm0 = pm0; }
    DI bool next(int i, Unit& u) const {
        int it = i, n = 0;
        if (rep > 1) { it = i / rep; n = i - it * rep; }
        const long L = (long)it * G + c;
        if (L >= nwg) {
            const int s = (int)(L - nwg); if (s >= nSplit) return false;
            const int tile = s / P, j = s - tile * P, base = nb / P, rem = nb - base * P;
            u.pm = splitPm0 + tile / nN; u.pn = tile % nN; u.k0 = 128 * (j * base + (j < rem ? j : rem)); u.nt = 2 * (base + (j < rem ? 1 : 0)); u.split = j + 1; return true;
        }
        int wgid = (int)L; { const int q = nwg / NXCD, r = nwg % NXCD, xcd = wgid % NXCD, off = wgid / NXCD; wgid = (xcd < r ? xcd * (q + 1) : r * (q + 1) + (xcd - r) * q) + off; }
        const int nig = WGM * nN, gid = wgid / nig, fm = gid * WGM, gsz = (nM - fm) < WGM ? (nM - fm) : WGM;
        u.pm = fm + ((wgid % nig) % gsz) + n * aStride; u.pn = (wgid % nig) / gsz + n * bStride; u.k0 = 0; u.nt = ntFull; u.split = 0;
        if (kseg) { u.k0 = n * kseg; u.split = n; }
        return true;
    }
};

template <class Epi>
DI void gemm_phase(LAS unsigned char* lds, const Gemm g, const Sched& S, const Epi& E) {
    const int tid = tidx(), wid = __builtin_amdgcn_readfirstlane(tid >> 6), lane = tid & 63, wr = wid >> 2, wc = wid & 3, fr = lane & 15, fq = lane >> 4;
    const int K = g.K, lda = g.lda;
    unsigned voffA[2], voffB[2];
#pragma unroll
    for (int i = 0; i < 2; ++i) { int R, C; stage_rc(tid * 16 + i * 8192, R, C); const int Rb = Epi::PERM ? ((R & ~31) + perm32(R & 31)) : R;
        voffA[i] = (unsigned)(R * lda + C) * 2u; voffB[i] = (unsigned)(Rb * K + C) * 2u; }
    const size_t kstep = (size_t)(BK * 2);
    const size_t hstepA = (size_t)HALF * lda * 2, hstepB = (size_t)HALF * K * 2;
    const size_t tstepA = 2 * hstepA, tstepB = 2 * hstepB;
    const unsigned ldsw = (unsigned)wid * 1024u;
    const int aoff = lds_byte(wr * 64 + fr, fq * 8), boff = lds_byte(wc * 32 + fr, fq * 8);
#define PG8_SA(b, h) (((b) * 2 + (h)) * HTB)
#define PG8_SB(b, h) ((4 + (b) * 2 + (h)) * HTB)
#define PG8_STAGE(bufoff, gbase, voff) do { _Pragma("unroll") for (int _i = 0; _i < 2; ++_i) \
        __builtin_amdgcn_global_load_lds((const unsigned*)((const char*)(gbase) + (voff)[_i]), (LAS unsigned*)(lds + (bufoff) + ldsw + _i * 8192), 16, 0, 0); } while (0)
#define PG8_LDA(dst, b, h) do { _Pragma("unroll") for (int m = 0; m < 4; ++m) _Pragma("unroll") for (int k = 0; k < 2; ++k) dst[m][k] = *(const LAS bf16x8*)(lds + PG8_SA(b, h) + aoff + m * 2048 + k * 1024); } while (0)
#define PG8_LDB(dst, b, h) do { _Pragma("unroll") for (int n = 0; n < 2; ++n) _Pragma("unroll") for (int k = 0; k < 2; ++k) dst[n][k] = *(const LAS bf16x8*)(lds + PG8_SB(b, h) + boff + n * 2048 + k * 1024); } while (0)
#define PG8_MMA(ai, bj, At, Bt) do { __builtin_amdgcn_s_setprio(1); _Pragma("unroll") for (int m = 0; m < 4; ++m) _Pragma("unroll") for (int n = 0; n < 2; ++n) _Pragma("unroll") for (int k = 0; k < 2; ++k) \
        acc[ai][bj][m][n] = __builtin_amdgcn_mfma_f32_16x16x32_bf16(Bt[n][k], At[m][k], acc[ai][bj][m][n], 0, 0, 0); __builtin_amdgcn_s_setprio(0); } while (0)
#define PG8_WAIT_V(n) asm volatile("s_waitcnt vmcnt(" #n ")" ::: "memory")
#define PG8_WAIT_L(n) asm volatile("s_waitcnt lgkmcnt(" #n ")" ::: "memory")
#define PG8_BAR __builtin_amdgcn_s_barrier()
#define PG8_SCHED __builtin_amdgcn_sched_barrier(0)
    Unit cur, nxt; int ui = 0;
    if (!S.next(0, cur)) return;
    f32x4 acc[2][2][4][2];
#pragma unroll
    for (int a = 0; a < 2; ++a)
#pragma unroll
        for (int b = 0; b < 2; ++b)
#pragma unroll
            for (int m = 0; m < 4; ++m)
#pragma unroll
                for (int n = 0; n < 2; ++n) acc[a][b][m][n] = (f32x4){0.f, 0.f, 0.f, 0.f};
    bf16x8 At[4][2], B0[2][2], B1[2][2];
    const char* cA = (const char*)g.A + (size_t)cur.pm * tstepA + (size_t)cur.k0 * 2; const char* cB = (const char*)g.Bt + (size_t)cur.pn * tstepB + (size_t)cur.k0 * 2;
    PG8_STAGE(PG8_SB(0, 0), cB, voffB); PG8_STAGE(PG8_SA(0, 0), cA, voffA); PG8_STAGE(PG8_SB(0, 1), cB + hstepB, voffB); PG8_STAGE(PG8_SA(0, 1), cA + hstepA, voffA);
    if (wr == 1) PG8_BAR;
    PG8_WAIT_V(4); PG8_BAR;
    PG8_STAGE(PG8_SB(1, 0), cB + kstep, voffB); PG8_STAGE(PG8_SA(1, 0), cA + kstep, voffA); PG8_STAGE(PG8_SB(1, 1), cB + hstepB + kstep, voffB);
    PG8_WAIT_V(6); PG8_BAR;
    for (;;) {
        const bool has_next = S.next(ui + 1, nxt);
        const char* nA = has_next ? (const char*)g.A + (size_t)nxt.pm * tstepA + (size_t)nxt.k0 * 2 : cA; const char* nB = has_next ? (const char*)g.Bt + (size_t)nxt.pn * tstepB + (size_t)nxt.k0 * 2 : cB;
        const int nt = cur.nt;
        for (int t = 0; t < nt; t += 2) {
            const bool last = (t == nt - 2);
            const char* a1 = cA + (size_t)(t + 1) * kstep;
            const char* a2 = last ? nA : cA + (size_t)(t + 2) * kstep; const char* b2 = last ? nB : cB + (size_t)(t + 2) * kstep;
            const char* a3 = a2 + kstep; const char* b3 = b2 + kstep;
            PG8_LDB(B0, 0, 0); PG8_SCHED; PG8_LDA(At, 0, 0); PG8_STAGE(PG8_SA(1, 1), a1 + hstepA, voffA);
            PG8_WAIT_L(8); PG8_BAR; PG8_WAIT_L(0); PG8_MMA(0, 0, At, B0); PG8_BAR; PG8_SCHED;
            PG8_LDB(B1, 0, 1); PG8_STAGE(PG8_SB(0, 0), b2, voffB);
            PG8_BAR; PG8_WAIT_L(0); PG8_MMA(0, 1, At, B1); PG8_BAR;
            PG8_LDA(At, 0, 1); PG8_STAGE(PG8_SA(0, 0), a2, voffA);
            PG8_BAR; PG8_WAIT_L(0); PG8_MMA(1, 0, At, B0); PG8_BAR; PG8_SCHED;
            PG8_STAGE(PG8_SB(0, 1), b2 + hstepB, voffB);
            PG8_WAIT_V(6); PG8_BAR; PG8_MMA(1, 1, At, B1); PG8_BAR;
            PG8_LDB(B0, 1, 0); PG8_SCHED; PG8_LDA(At, 1, 0); PG8_STAGE(PG8_SA(0, 1), a2 + hstepA, voffA);
            PG8_WAIT_L(8); PG8_BAR; PG8_WAIT_L(0); PG8_MMA(0, 0, At, B0); PG8_BAR; PG8_SCHED;
            PG8_LDB(B1, 1, 1); PG8_STAGE(PG8_SB(1, 0), b3, voffB);
            PG8_BAR; PG8_WAIT_L(0); PG8_MMA(0, 1, At, B1); PG8_BAR;
            PG8_LDA(At, 1, 1); PG8_STAGE(PG8_SA(1, 0), a3, voffA);
            PG8_BAR; PG8_WAIT_L(0); PG8_MMA(1, 0, At, B0); PG8_BAR; PG8_SCHED;
            PG8_STAGE(PG8_SB(1, 1), b3 + hstepB, voffB);
            PG8_WAIT_V(6); PG8_BAR; PG8_MMA(1, 1, At, B1); PG8_BAR;
        }
        E(acc, cur, wr, wc, fr, fq);
        if (!has_next) break;
        if (!(Epi::CHAIN && nxt.split != 0)) {
#pragma unroll
            for (int a = 0; a < 2; ++a)
#pragma unroll
                for (int b = 0; b < 2; ++b)
#pragma unroll
                    for (int m = 0; m < 4; ++m)
#pragma unroll
                        for (int n = 0; n < 2; ++n) acc[a][b][m][n] = (f32x4){0.f, 0.f, 0.f, 0.f};
        }
        cur = nxt; cA = nA; cB = nB; ++ui;
    }
    PG8_WAIT_V(0);
    if (wr == 0) PG8_BAR;
    PG8_BAR;
#undef PG8_SA
#undef PG8_SB
#undef PG8_STAGE
#undef PG8_LDA
#undef PG8_LDB
#undef PG8_MMA
#undef PG8_WAIT_V
#undef PG8_WAIT_L
#undef PG8_BAR
#undef PG8_SCHED
}
}
using pg8::Unit;
typedef f32x4 AccT[2][2][4][2];

struct EpiStore {
    static constexpr bool PERM = true, CHAIN = false;
    bf16_t* O; int ld; int sig0;
    DI void operator()(const AccT& acc, const Unit& u, int wr, int wc, int fr, int fq) const {
        const int row0 = u.pm * 256 + wr * 64 + fr, col0 = u.pn * 256 + wc * 32 + 8 * fq;
#pragma unroll
        for (int ai = 0; ai < 2; ++ai)
#pragma unroll
            for (int m = 0; m < 4; ++m) { bf16_t* rowp = O + (size_t)(row0 + ai * 128 + m * 16) * ld + col0;
#pragma unroll
                for (int bj = 0; bj < 2; ++bj) { f32x4 v0 = acc[ai][bj][m][0], v1 = acc[ai][bj][m][1];
                    if (u.pn * 256 + bj * 128 + wc * 32 >= sig0) {
#pragma unroll
                        for (int j = 0; j < 4; ++j) { v0[j] = sigmoidf_(v0[j]); v1[j] = sigmoidf_(v1[j]); } }
                    u32x4 w; w.x = pk2(v0[0], v0[1]); w.y = pk2(v0[2], v0[3]); w.z = pk2(v1[0], v1[1]); w.w = pk2(v1[2], v1[3]);
                    *(u32x4*)(rowp + bj * 128) = w; } }
    }
};
struct EpiSwiglu {
    static constexpr bool PERM = true, CHAIN = false;
    bf16_t* O;
    DI void operator()(const AccT& acc, const Unit& u, int wr, int wc, int fr, int fq) const {
        const int row0 = u.pm * 256 + wr * 64 + fr, col0 = u.pn * 128 + (wc * 4 + fq) * 8;
#pragma unroll
        for (int ai = 0; ai < 2; ++ai)
#pragma unroll
            for (int m = 0; m < 4; ++m) { bf16_t* rowp = O + (size_t)(row0 + ai * 128 + m * 16) * DFF + col0;
                unsigned o[4];
#pragma unroll
                for (int bj = 0; bj < 2; ++bj) { const f32x4 v0 = acc[ai][bj][m][0], v1 = acc[ai][bj][m][1];
                    const float r0 = v0[0] * sigmoidf_(v0[0]) * v0[1], r1 = v0[2] * sigmoidf_(v0[2]) * v0[3];
                    const float r2 = v1[0] * sigmoidf_(v1[0]) * v1[1], r3 = v1[2] * sigmoidf_(v1[2]) * v1[3];
                    o[2 * bj] = pk2(r0, r1); o[2 * bj + 1] = pk2(r2, r3); }
                u32x4 w; w.x = o[0]; w.y = o[1]; w.z = o[2]; w.w = o[3];
                *(u32x4*)rowp = w; }
    }
};
struct EpiResid {
    static constexpr bool PERM = false, CHAIN = false;
    float* xl; float* xc; const float* modl; int midx; float coef; float* part;
    DI void operator()(const AccT& acc, const Unit& u, int wr, int wc, int fr, int fq) const {
        const int bi = u.pm < 64 ? (u.pm >> 3) : 8;
        float* base = u.pm < 64 ? xl + (size_t)u.pm * 256 * D : xc + (size_t)(u.pm - 64) * 256 * D;
        if (u.split) base = part + (size_t)(u.split - 1) * MC * D + (size_t)(u.pm - 64) * 256 * D;
        const int row0 = wr * 64 + fr, col0 = u.pn * 256 + wc * 32 + 4 * fq;
        const float* mp = modl + (size_t)bi * 9216 + midx * 1024 + col0;
#pragma unroll
        for (int bj = 0; bj < 2; ++bj) {
            f32x4 mv[2];
#pragma unroll
            for (int n = 0; n < 2; ++n) mv[n] = *(const f32x4*)(mp + bj * 128 + n * 16) * coef;
            float* cb = base + (size_t)row0 * D + col0 + bj * 128;
            f32x4 xv[2][2][4];
            if (!u.split) {
#pragma unroll
                for (int n = 0; n < 2; ++n)
#pragma unroll
                    for (int ai = 0; ai < 2; ++ai)
#pragma unroll
                        for (int m = 0; m < 4; ++m) xv[n][ai][m] = *(const f32x4*)(cb + n * 16 + (size_t)(ai * 128 + m * 16) * D);
            } else {
#pragma unroll
                for (int n = 0; n < 2; ++n)
#pragma unroll
                    for (int ai = 0; ai < 2; ++ai)
#pragma unroll
                        for (int m = 0; m < 4; ++m) xv[n][ai][m] = (f32x4){0.f, 0.f, 0.f, 0.f};
            }
#pragma unroll
            for (int n = 0; n < 2; ++n)
#pragma unroll
                for (int ai = 0; ai < 2; ++ai)
#pragma unroll
                    for (int m = 0; m < 4; ++m) *(f32x4*)(cb + n * 16 + (size_t)(ai * 128 + m * 16) * D) = xv[n][ai][m] + mv[n] * acc[ai][bj][m][n];
        }
    }
};
struct EpiMerge {
    static constexpr bool PERM = true, CHAIN = true;
    bf16_t* mb; const bf16_t* proj;
    DI void operator()(AccT& acc, const Unit& u, int wr, int wc, int fr, int fq) const {
        const int seg = u.split;
        const int row0 = u.pm * 256 + wr * 64 + fr, col0 = u.pn * 256 + wc * 32 + 8 * fq;
#pragma unroll
        for (int ai = 0; ai < 2; ++ai) {
            u32x4 ga[4][2], gb[4][2];
#pragma unroll
            for (int m = 0; m < 4; ++m) { const bf16_t* gp = proj + (size_t)(row0 + ai * 128 + m * 16) * INWP + O_G + seg * 1024 + col0;
#pragma unroll
                for (int bj = 0; bj < 2; ++bj) { ga[m][bj] = *(const u32x4*)(gp + bj * 128); gb[m][bj] = seg < 2 ? *(const u32x4*)(gp + 1024 + bj * 128) : (u32x4){0u, 0u, 0u, 0u}; } }
#pragma unroll
            for (int m = 0; m < 4; ++m) { const size_t row = (size_t)(row0 + ai * 128 + m * 16);
#pragma unroll
                for (int bj = 0; bj < 2; ++bj) {
                    const unsigned aw[4] = {ga[m][bj].x, ga[m][bj].y, ga[m][bj].z, ga[m][bj].w}, bw[4] = {gb[m][bj].x, gb[m][bj].y, gb[m][bj].z, gb[m][bj].w};
                    float r[8];
#pragma unroll
                    for (int j = 0; j < 4; ++j) { r[2 * j] = fmaxf(bflo(aw[j]), 1e-20f); r[2 * j + 1] = fmaxf(bfhi(aw[j]), 1e-20f); }
                    if (seg < 2) {
#pragma unroll
                        for (int j = 0; j < 4; ++j) { r[2 * j] *= __builtin_amdgcn_rcpf(fmaxf(bflo(bw[j]), 1e-20f)); r[2 * j + 1] *= __builtin_amdgcn_rcpf(fmaxf(bfhi(bw[j]), 1e-20f)); }
#pragma unroll
                        for (int n = 0; n < 2; ++n) { f32x4 rv; rv[0] = r[4 * n]; rv[1] = r[4 * n + 1]; rv[2] = r[4 * n + 2]; rv[3] = r[4 * n + 3]; acc[ai][bj][m][n] = acc[ai][bj][m][n] * rv; }
                    } else {
                        const f32x4 v0 = acc[ai][bj][m][0], v1 = acc[ai][bj][m][1];
                        u32x4 w; w.x = pk2(v0[0] * r[0], v0[1] * r[1]); w.y = pk2(v0[2] * r[2], v0[3] * r[3]); w.z = pk2(v1[0] * r[4], v1[1] * r[5]); w.w = pk2(v1[2] * r[6], v1[3] * r[7]);
                        *(u32x4*)(mb + row * D + col0 + bj * 128) = w; } } }
        }
    }
};

DI void mod_phase(const Params& p, LAS unsigned char* ldsb) {
    LAS float* sc = (LAS float*)ldsb;
    LAS float* red = sc + 9216;
    const int tid = tidx(), wid = tid >> 6, lane = tid & 63;
    for (int i = tid; i < 9216; i += 512) { const int bi = i >> 10, k = i & 1023; const float cv = bi < 8 ? p.in[1][bi * 1024 + k] : p.in[3][k]; sc[i] = cv / (1.0f + expf(-cv)); }
    __syncthreads();
    float* MOD = (float*)(p.ws + WS_MOD);
    for (int item = blockIdx.x; item < 144; item += gridDim.x) {
        const int l = item / 36, j0 = (item % 36) * 256;
        const float* w = p.in[4] + ((size_t)l * 1024 + wid * 128) * 9216 + j0 + lane * 4;
        f32x4 acc[9];
#pragma unroll
        for (int b = 0; b < 9; ++b) acc[b] = (f32x4){0.f, 0.f, 0.f, 0.f};
#pragma unroll 8
        for (int kk = 0; kk < 128; ++kk) { const f32x4 wv = __builtin_nontemporal_load((const f32x4*)(w + (size_t)kk * 9216)); const int k = wid * 128 + kk;
#pragma unroll
            for (int b = 0; b < 9; ++b) acc[b] = acc[b] + wv * sc[b * 1024 + k]; }
#pragma unroll
        for (int b = 0; b < 9; ++b) *(LAS f32x4*)(red + (wid * 9 + b) * 256 + lane * 4) = acc[b];
        __syncthreads();
        for (int o = tid; o < 9 * 256; o += 512) { const int b = o >> 8, cn = o & 255; float s = 0.f;
#pragma unroll
            for (int w8 = 0; w8 < 8; ++w8) s += red[(w8 * 9 + b) * 256 + cn];
            MOD[((size_t)l * 9 + b) * 9216 + j0 + cn] = s + p.in[5][(size_t)l * 9216 + j0 + cn]; }
        __syncthreads();
    }
}
DI void tab_phase(const Params& p) {
    float* TABM = (float*)(p.ws + WS_TAB);
    float* TABD = TABM + 2048 * 32;
    const int gt = blockIdx.x * 512 + tidx(), nth = gridDim.x * 512;
    for (int i = gt; i < 2048 * 48; i += nth) {
        const int s = i / 48, a = i % 48;
        const float row = (float)(s >> 6), col = (float)(s & 63);
        float pos, invf; int idx; float* dst; int half;
        if (a < 16) { const int axis = a >> 3, f = a & 7; pos = axis ? col : row; invf = exp2f(-(float)f * (13.287712379549449f / 8.0f)); dst = TABM + s * 32; idx = a; half = 16; }
        else { const int a2 = a - 16, axis = a2 >> 4, f = a2 & 15; pos = axis ? col : row; invf = exp2f(-(float)f * (13.287712379549449f / 16.0f)); dst = TABD + s * 64; idx = a2; half = 32; }
        const float ang = pos * invf;
        float rev = ang * 0.15915494309189535f; rev -= floorf(rev);
        dst[idx] = __builtin_amdgcn_cosf(rev); dst[half + idx] = __builtin_amdgcn_sinf(rev);
    }
}

DI void convT(const float* __restrict__ src, int K, int N, bf16_t* __restrict__ dst, int mode, const float* kscale, LAS float* tile, int rot, int vid, int vcnt, int ldd = 0, int koff = 0) {
    if (ldd == 0) ldd = K;
    const int tilesN = (N + 63) >> 6, tilesK = K >> 6, nt = tilesN * tilesK, tid = tidx();
    int start = vid - (rot % vcnt); if (start < 0) start += vcnt;
    const int kr = tid >> 4, c4 = (tid & 15) * 4;
    f32x4 r0, r1;
    auto fetch = [&](int tl) {
        const int tk = tl / tilesN, tn = tl - tk * tilesN, n = tn * 64 + c4, k0 = tk * 64 + kr;
        r0 = (f32x4){0.f, 0.f, 0.f, 0.f}; r1 = r0;
        if (n < N) { r0 = __builtin_nontemporal_load((const f32x4*)(src + (size_t)k0 * N + n)); r1 = __builtin_nontemporal_load((const f32x4*)(src + (size_t)(k0 + 32) * N + n)); }
        if (kscale) { r0 = r0 * kscale[k0]; r1 = r1 * kscale[k0 + 32]; }
    };
    if (start < nt) fetch(start);
    for (int tl = start; tl < nt; tl += vcnt) {
        const int tk = tl / tilesN, tn = tl - tk * tilesN;
        { LAS float* tp = tile + kr * 65 + c4; tp[0] = r0[0]; tp[1] = r0[1]; tp[2] = r0[2]; tp[3] = r0[3];
          tp += 32 * 65; tp[0] = r1[0]; tp[1] = r1[1]; tp[2] = r1[2]; tp[3] = r1[3]; }
        if (tl + vcnt < nt) fetch(tl + vcnt);
        __syncthreads();
        { const int nl = tid >> 3, k8 = (tid & 7) * 8, n = tn * 64 + nl;
          if (n < N) { float f[8];
#pragma unroll
              for (int j = 0; j < 8; ++j) f[j] = tile[(k8 + j) * 65 + nl];
              u32x4 w; w.x = pk2(f[0], f[1]); w.y = pk2(f[2], f[3]); w.z = pk2(f[4], f[5]); w.w = pk2(f[6], f[7]);
              int drow = n;
              if (mode == 1) { const int i = n < DFF ? n : n - DFF, role = n < DFF ? 0 : 1;
                  drow = (i >> 7) * 256 + ((i >> 2) & 1) * 128 + ((i & 127) >> 3) * 8 + (i & 3) * 2 + role; }
              else if (mode == 2) { const int h = n / 96, o = n - h * 96, q = o - 64; if (o >= 64) drow = h * 96 + 64 + 2 * ((q >> 4) * 8 + (q & 7)) + ((q >> 3) & 1); }
              else if (mode == 3) { if (n >= O_KR && n < O_DQ) { const int q = n - O_KR; drow = O_KR + 2 * ((q >> 4) * 8 + (q & 7)) + ((q >> 3) & 1); }
                                    else if (n >= O_DQ && n < O_DV) { const int o = (n - O_DQ) & 63; drow = n - o + 2 * ((o >> 5) * 16 + (o & 15)) + ((o >> 4) & 1); } }
              *(u32x4*)(dst + (size_t)drow * ldd + koff + tk * 64 + k8) = w; } }
        __syncthreads();
    }
}
DI void conv_weights(const Params& p, int l, LAS unsigned char* ldsb, bf16_t* W, int vid, int vcnt) {
    LAS float* tile = (LAS float*)ldsb;
    convT(p.in[7] + (size_t)l * 1024 * 5632, 1024, 5632, W + W_1U, 1, nullptr, tile, 0, vid, vcnt);
    convT(p.in[8] + (size_t)l * 2816 * 1024, 2816, 1024, W + W_1D, 0, nullptr, tile, 128, vid, vcnt);
    convT(p.in[9] + (size_t)l * 1024 * 5632, 1024, 5632, W + W_2U, 1, nullptr, tile, 64, vid, vcnt);
    convT(p.in[10] + (size_t)l * 2816 * 1024, 2816, 1024, W + W_2D, 0, nullptr, tile, 192, vid, vcnt);
    convT(p.in[11] + (size_t)l * 1024 * INW, 1024, INW, W + W_IN, 3, nullptr, tile, 32, vid, vcnt);
    convT(p.in[13] + (size_t)l * 384 * 768, 384, 768, W + W_UQ, 2, p.in[12] + l * 384, tile, 160, vid, vcnt);
    convT(p.in[15] + (size_t)l * 256 * 1024, 256, 1024, W + W_UKV, 0, p.in[14] + l * 256, tile, 232, vid, vcnt);
    for (int n = 0; n < 3; ++n) convT(p.in[23] + ((size_t)l * 3 + n) * 512 * 1024, 512, 1024, W + W_BR, 0, nullptr, tile, 40 + n * 72, vid, vcnt, 1536, n * 512);
    convT(p.in[24] + (size_t)l * 1024 * 1024, 1024, 1024, W + W_O, 0, nullptr, tile, 96, vid, vcnt);
    { u32x4* z = (u32x4*)(W + W_IN + (size_t)INW * 1024); const int nz = (INWP - INW) * 1024 / 8;
      for (int i = vid * 512 + tidx(); i < nz; i += vcnt * 512) z[i] = (u32x4){0u, 0u, 0u, 0u}; }
}

DI void norm_phase(const float* sl, const float* sc_, float* dl, float* dc, bool copy, bf16_t* H, const float* g, const float* modl, int shift_i, int scale_i, int Mrows, const float* part, int npart) {
    const int tid_ = tidx(), lane = tid_ & 63, gw = blockIdx.x * 8 + (tid_ >> 6), nw = gridDim.x * 8;
    constexpr int R = 5;
    for (int row0 = gw; row0 < Mrows; row0 += R * nw) {
        f32x4 v[R][4]; float ss[R]; bool ok[R];
#pragma unroll
        for (int r = 0; r < R; ++r) { int row = row0 + r * nw; ok[r] = row < Mrows; row = ok[r] ? row : Mrows - 1;
            const float* src = row < ML ? sl + (size_t)row * D : sc_ + (size_t)(row - ML) * D;
#pragma unroll
            for (int i = 0; i < 4; ++i) v[r][i] = *(const f32x4*)(src + i * 256 + lane * 4); }
#pragma unroll
        for (int r = 0; r < R; ++r) { const int row = row0 + r * nw;
            if (ok[r] && npart > 0 && row >= ML) {
                f32x4 pv[4][4];
#pragma unroll
                for (int j = 0; j < 4; ++j) { const float* pp = part + (size_t)j * MC * D + (size_t)(row - ML) * D;
#pragma unroll
                    for (int i = 0; i < 4; ++i) pv[j][i] = *(const f32x4*)(pp + i * 256 + lane * 4); }
#pragma unroll
                for (int j = 0; j < 4; ++j)
#pragma unroll
                    for (int i = 0; i < 4; ++i) v[r][i] = v[r][i] + pv[j][i]; }
            float s = 0.f;
#pragma unroll
            for (int i = 0; i < 4; ++i) s += v[r][i][0] * v[r][i][0] + v[r][i][1] * v[r][i][1] + v[r][i][2] * v[r][i][2] + v[r][i][3] * v[r][i][3];
            ss[r] = s; }
#pragma unroll
        for (int o = 32; o > 0; o >>= 1) {
#pragma unroll
            for (int r = 0; r < R; ++r) ss[r] += __shfl_xor(ss[r], o); }
#pragma unroll
        for (int r = 0; r < R; ++r) { const int row = row0 + r * nw;
            if (!ok[r]) continue;
            const int bi = row < ML ? (row >> 11) : 8;
            const float rstd = rsqrtf(ss[r] * (1.0f / 1024.0f) + EPS);
            const float* mb = modl + (size_t)bi * 9216;
#pragma unroll
            for (int i = 0; i < 4; ++i) { const int col = i * 256 + lane * 4;
                const f32x4 gg = *(const f32x4*)(g + col), scv = *(const f32x4*)(mb + scale_i * 1024 + col), shv = *(const f32x4*)(mb + shift_i * 1024 + col);
                const f32x4 h = v[r][i] * rstd * gg * (scv + 1.0f) + shv;
                u32x2 w; w.x = pk2(h[0], h[1]); w.y = pk2(h[2], h[3]);
                *(u32x2*)(H + (size_t)row * D + col) = w; }
            if (copy || (npart > 0 && row >= ML)) { float* dst = row < ML ? dl + (size_t)row * D : dc + (size_t)(row - ML) * D;
#pragma unroll
                for (int i = 0; i < 4; ++i) *(f32x4*)(dst + i * 256 + lane * 4) = v[r][i]; }
        }
    }
}

template <int NV> DI void load_bf16_row(const bf16_t* src, float* v, float mul) {
#pragma unroll
    for (int i = 0; i < NV / 8; ++i) { const u32x4 w = *(const u32x4*)(src + i * 8);
        v[i * 8 + 0] = bflo(w.x) * mul; v[i * 8 + 1] = bfhi(w.x) * mul; v[i * 8 + 2] = bflo(w.y) * mul; v[i * 8 + 3] = bfhi(w.y) * mul;
        v[i * 8 + 4] = bflo(w.z) * mul; v[i * 8 + 5] = bfhi(w.z) * mul; v[i * 8 + 6] = bflo(w.w) * mul; v[i * 8 + 7] = bfhi(w.w) * mul; }
}
template <int NV> DI void store_bf16_row(bf16_t* dst, const float* v) {
#pragma unroll
    for (int i = 0; i < NV / 8; ++i) { u32x4 w; w.x = pk2(v[i * 8], v[i * 8 + 1]); w.y = pk2(v[i * 8 + 2], v[i * 8 + 3]); w.z = pk2(v[i * 8 + 4], v[i * 8 + 5]); w.w = pk2(v[i * 8 + 6], v[i * 8 + 7]);
        *(u32x4*)(dst + i * 8) = w; }
}
template <int NV> DI float sumsq_row(const bf16_t* src, float mul) {
    float ss = 0.f;
#pragma unroll
    for (int i = 0; i < NV / 8; ++i) { const u32x4 w = *(const u32x4*)(src + i * 8); const unsigned ww[4] = {w.x, w.y, w.z, w.w};
#pragma unroll
        for (int j = 0; j < 4; ++j) { const float a = bflo(ww[j]) * mul, b = bfhi(ww[j]) * mul; ss += a * a; ss += b * b; } }
    return ss;
}
template <int NV> DI void emit_plain(const bf16_t* src, float mul, const LAS float* g, bf16_t* dst) {
#pragma unroll 2
    for (int i = 0; i < NV / 8; ++i) { const u32x4 w = *(const u32x4*)(src + i * 8); const unsigned ww[4] = {w.x, w.y, w.z, w.w}; unsigned o[4];
#pragma unroll
        for (int j = 0; j < 4; ++j) o[j] = pk2(bflo(ww[j]) * mul * g[i * 8 + 2 * j], bfhi(ww[j]) * mul * g[i * 8 + 2 * j + 1]);
        u32x4 ov; ov.x = o[0]; ov.y = o[1]; ov.z = o[2]; ov.w = o[3]; *(u32x4*)(dst + i * 8) = ov; }
}
template <int QF> DI void emit_rope_axis(const bf16_t* src, float mul, const LAS float* g, const float* cp, const float* sp, bf16_t* dst) {
    float v[2 * QF];
#pragma unroll
    for (int i = 0; i < QF / 4; ++i) { const u32x4 w = *(const u32x4*)(src + i * 8); const unsigned ww[4] = {w.x, w.y, w.z, w.w};
#pragma unroll
        for (int j = 0; j < 4; ++j) { v[i * 8 + 2 * j] = bflo(ww[j]) * mul * g[i * 8 + 2 * j]; v[i * 8 + 2 * j + 1] = bfhi(ww[j]) * mul * g[i * 8 + 2 * j + 1]; } }
    if (cp) {
#pragma unroll
        for (int f = 0; f < QF; ++f) { const float c = cp[f], s = sp[f], x1 = v[f], x2 = v[QF + f]; v[f] = x1 * c - x2 * s; v[QF + f] = x2 * c + x1 * s; }
    }
#pragma unroll
    for (int i = 0; i < QF / 4; ++i) { u32x4 ov; ov.x = pk2(v[i * 8], v[i * 8 + 1]); ov.y = pk2(v[i * 8 + 2], v[i * 8 + 3]); ov.z = pk2(v[i * 8 + 4], v[i * 8 + 5]); ov.w = pk2(v[i * 8 + 6], v[i * 8 + 7]); *(u32x4*)(dst + i * 8) = ov; }
}
DI float sumsq8(u32x4 w) { const unsigned ww[4] = {w.x, w.y, w.z, w.w}; float ss = 0.f;
#pragma unroll
    for (int j = 0; j < 4; ++j) { const float a = bflo(ww[j]), b = bfhi(ww[j]); ss += a * a; ss += b * b; }
    return ss; }
DI void unpack8(u32x4 w, float* v, float mul) { const unsigned ww[4] = {w.x, w.y, w.z, w.w};
#pragma unroll
    for (int j = 0; j < 4; ++j) { v[2 * j] = bflo(ww[j]) * mul; v[2 * j + 1] = bfhi(ww[j]) * mul; } }
DI u32x4 pack8(const float* v) { u32x4 o; o.x = pk2(v[0], v[1]); o.y = pk2(v[2], v[3]); o.z = pk2(v[4], v[5]); o.w = pk2(v[6], v[7]); return o; }
DI float red8(float v) { v += __shfl_xor(v, 1); v += __shfl_xor(v, 2); v += __shfl_xor(v, 4); return v; }

DI void prep_body(const Params& p, int l, LAS unsigned char* ldsb,
                  const bf16_t* __restrict__ PROJ, const bf16_t* __restrict__ QRAW, const bf16_t* __restrict__ KVRAW,
                  bf16_t* __restrict__ QM, bf16_t* __restrict__ KM, bf16_t* __restrict__ VTM, bf16_t* __restrict__ QD, bf16_t* __restrict__ KD, bf16_t* __restrict__ VTD, bf16_t* __restrict__ Y2,
                  const float* __restrict__ TABM, const float* __restrict__ TABD, const float* __restrict__ cw) {
    const int tid = tidx(), wid = tid >> 6, lane = tid & 63, hd = lane >> 3, s = lane & 7;
    const float qsm = 0.10206207261596577f * LOG2E, qsd = 0.125f * LOG2E;
    LAS float* gl = (LAS float*)ldsb;
    if (tid < 96) { const int q = tid - 64, pp = q >> 1, hh = q & 1; const int orig = tid < 64 ? tid : 64 + 16 * (pp >> 3) + 8 * hh + (pp & 7);
        gl[tid] = p.in[16][l * 96 + orig]; gl[96 + tid] = p.in[17][l * 96 + orig]; }
    if (tid < 64) { const int pp = tid >> 1, hh = tid & 1, orig = 32 * (pp >> 4) + 16 * hh + (pp & 15);
        gl[192 + tid] = p.in[18][l * 64 + orig]; gl[256 + tid] = p.in[19][l * 64 + orig]; }
    __syncthreads();
    float gqn[8], gqr[4], gkn[8], gkr[4], gdq[8], gdk[8];
#pragma unroll
    for (int j = 0; j < 8; ++j) { gqn[j] = gl[8 * s + j]; gkn[j] = gl[96 + 8 * s + j]; gdq[j] = gl[192 + 8 * s + j]; gdk[j] = gl[256 + 8 * s + j]; }
#pragma unroll
    for (int j = 0; j < 4; ++j) { gqr[j] = gl[64 + 4 * s + j]; gkr[j] = gl[96 + 64 + 4 * s + j]; }
    __syncthreads();
    LAS unsigned char* Vl = ldsb;
#pragma unroll 1
    for (int item = blockIdx.x; item < 5 * (MT / 64); item += gridDim.x) {
        const int type = item / (MT / 64), blk = item - type * (MT / 64);
        const int r0 = blk * 64; int b, t0, spos0, seglen; bool latent;
        if (r0 < ML) { b = r0 >> 11; spos0 = r0 & 2047; t0 = 256 + spos0; latent = true; seglen = 2048; }
        else { const int rc = r0 - ML; b = rc >> 8; spos0 = rc & 255; t0 = spos0; latent = false; seglen = 256; }
        if (type == 0) {
#pragma unroll 1
            for (int kb4 = 0; kb4 < 8; kb4 += 4) {
                float s1[4], s2[4]; u32x4 wqn[4], wkn[4]; u32x2 wqr[4], wkr[4]; f32x2 cm[4], sm[4];
#pragma unroll
            for (int k = 0; k < 4; ++k) {
                const int tl = wid * 8 + kb4 + k, r = r0 + tl, t = t0 + tl, spos = spos0 + tl;
                const bf16_t* prow = PROJ + (size_t)r * INWP;
                s1[k] = sumsq8(*(const u32x4*)(prow + O_CQ + (lane < 48 ? lane : 0) * 8)); s1[k] = lane < 48 ? s1[k] : 0.f;
                s2[k] = sumsq8(*(const u32x4*)(prow + O_CKV + (lane < 32 ? lane : 0) * 8)); s2[k] = lane < 32 ? s2[k] : 0.f;
                wqn[k] = *(const u32x4*)(QRAW + (size_t)r * 768 + hd * 96 + 8 * s);
                wqr[k] = *(const u32x2*)(QRAW + (size_t)r * 768 + hd * 96 + 64 + 4 * s);
                wkn[k] = *(const u32x4*)(KVRAW + (size_t)r * 1024 + hd * 128 + 8 * s);
                wkr[k] = *(const u32x2*)(prow + O_KR + 4 * s);
                cm[k] = *(const f32x2*)(TABM + (latent ? spos : 0) * 32 + 2 * s); sm[k] = *(const f32x2*)(TABM + (latent ? spos : 0) * 32 + 16 + 2 * s);
                cm[k][0] = latent ? cm[k][0] : 1.f; cm[k][1] = latent ? cm[k][1] : 1.f; sm[k][0] = latent ? sm[k][0] : 0.f; sm[k][1] = latent ? sm[k][1] : 0.f;
            }
#pragma unroll
            for (int k = 0; k < 4; ++k) {
                const int tl = wid * 8 + kb4 + k, r = r0 + tl, t = t0 + tl; (void)r;
                s1[k] = wave_sum(s1[k]); s2[k] = wave_sum(s2[k]);
                const float rcq = rsqrtf(s1[k] * (1.0f / 384.0f) + EPS), rckv = rsqrtf(s2[k] * (1.0f / 256.0f) + EPS);
                { float vn[8], vr[4]; unpack8(wqn[k], vn, rcq); vr[0] = bflo(wqr[k].x) * rcq; vr[1] = bfhi(wqr[k].x) * rcq; vr[2] = bflo(wqr[k].y) * rcq; vr[3] = bfhi(wqr[k].y) * rcq;
                  float ss = vr[0] * vr[0] + vr[1] * vr[1] + vr[2] * vr[2] + vr[3] * vr[3];
#pragma unroll
                  for (int j = 0; j < 8; ++j) ss += vn[j] * vn[j];
                  ss = red8(ss); const float mul = rsqrtf(ss * (1.0f / 96.0f) + EPS) * qsm;
#pragma unroll
                  for (int j = 0; j < 8; ++j) vn[j] *= mul * gqn[j];
#pragma unroll
                  for (int j = 0; j < 4; ++j) vr[j] *= mul * gqr[j];
                  const float a0 = vr[0] * cm[k][0] - vr[1] * sm[k][0], a1 = vr[1] * cm[k][0] + vr[0] * sm[k][0], a2 = vr[2] * cm[k][1] - vr[3] * sm[k][1], a3 = vr[3] * cm[k][1] + vr[2] * sm[k][1];
                  bf16_t* d = QM + ((size_t)(b * 8 + hd) * TT + t) * 96;
                  *(u32x4*)(d + 8 * s) = pack8(vn); u32x2 o; o.x = pk2(a0, a1); o.y = pk2(a2, a3); *(u32x2*)(d + 64 + 4 * s) = o; }
                { float vn[8], vr[4]; unpack8(wkn[k], vn, rckv); vr[0] = bflo(wkr[k].x); vr[1] = bfhi(wkr[k].x); vr[2] = bflo(wkr[k].y); vr[3] = bfhi(wkr[k].y);
                  float ss = vr[0] * vr[0] + vr[1] * vr[1] + vr[2] * vr[2] + vr[3] * vr[3];
#pragma unroll
                  for (int j = 0; j < 8; ++j) ss += vn[j] * vn[j];
                  ss = red8(ss); const float mul = rsqrtf(ss * (1.0f / 96.0f) + EPS);
#pragma unroll
                  for (int j = 0; j < 8; ++j) vn[j] *= mul * gkn[j];
#pragma unroll
                  for (int j = 0; j < 4; ++j) vr[j] *= mul * gkr[j];
                  const float a0 = vr[0] * cm[k][0] - vr[1] * sm[k][0], a1 = vr[1] * cm[k][0] + vr[0] * sm[k][0], a2 = vr[2] * cm[k][1] - vr[3] * sm[k][1], a3 = vr[3] * cm[k][1] + vr[2] * sm[k][1];
                  bf16_t* d = KM + ((size_t)(b * 8 + hd) * TT + t) * 96;
                  *(u32x4*)(d + 8 * s) = pack8(vn); u32x2 o; o.x = pk2(a0, a1); o.y = pk2(a2, a3); *(u32x2*)(d + 64 + 4 * s) = o; }
            }
            }
        } else if (type == 1) {
#pragma unroll 1
            for (int kb4 = 0; kb4 < 8; kb4 += 4) {
                u32x4 wdq[4], wdk[4]; f32x4 cd[4], sd[4];
#pragma unroll
                for (int k = 0; k < 4; ++k) { const int tl = wid * 8 + kb4 + k, r = r0 + tl, spos = spos0 + tl;
                    const bf16_t* prow = PROJ + (size_t)r * INWP;
                    wdq[k] = *(const u32x4*)(prow + O_DQ + lane * 8); wdk[k] = *(const u32x4*)(prow + O_DK + lane * 8);
                    cd[k] = *(const f32x4*)(TABD + (latent ? spos : 0) * 64 + 4 * s); sd[k] = *(const f32x4*)(TABD + (latent ? spos : 0) * 64 + 32 + 4 * s); }
#pragma unroll
                for (int k = 0; k < 4; ++k) { const int tl = wid * 8 + kb4 + k, t = t0 + tl;
#pragma unroll
                    for (int j = 0; j < 4; ++j) { cd[k][j] = latent ? cd[k][j] : 1.f; sd[k][j] = latent ? sd[k][j] : 0.f; }
#pragma unroll
                    for (int qk = 0; qk < 2; ++qk) { float v[8]; unpack8(qk ? wdk[k] : wdq[k], v, 1.0f); float ss = 0.f;
#pragma unroll
                      for (int j = 0; j < 8; ++j) ss += v[j] * v[j];
                      ss = red8(ss); const float mul = rsqrtf(ss * (1.0f / 64.0f) + EPS) * (qk ? 1.0f : qsd);
#pragma unroll
                      for (int j = 0; j < 8; ++j) v[j] *= mul * (qk ? gdk[j] : gdq[j]);
                      float o[8];
#pragma unroll
                      for (int jj = 0; jj < 4; ++jj) { o[2 * jj] = v[2 * jj] * cd[k][jj] - v[2 * jj + 1] * sd[k][jj]; o[2 * jj + 1] = v[2 * jj + 1] * cd[k][jj] + v[2 * jj] * sd[k][jj]; }
                      bf16_t* d = (qk ? KD : QD) + ((size_t)(b * 8 + hd) * TT + t) * 64 + 8 * s;
                      *(u32x4*)d = pack8(o); }
                }
            }
        } else if (type < 4) {
#pragma unroll 4
            for (int k = 0; k < 8; ++k) {
                const int tl = wid * 8 + k, r = r0 + tl;
                const bf16_t* prow = PROJ + (size_t)r * INWP;
                const bool mla = (type == 2);
                float s2 = sumsq8(*(const u32x4*)(prow + O_CKV + (lane < 32 ? lane : 0) * 8)); s2 = lane < 32 ? s2 : 0.f;
                const bf16_t* wsrc = mla ? KVRAW + (size_t)r * 1024 + hd * 128 + 64 + 8 * s : prow + O_DV + lane * 8;
                const u32x4 w = *(const u32x4*)wsrc;
                s2 = wave_sum(s2); const float sc = mla ? rsqrtf(s2 * (1.0f / 256.0f) + EPS) : 1.0f;
                float v[8]; unpack8(w, v, sc);
                const u32x4 o = pack8(v); const unsigned ow[4] = {o.x, o.y, o.z, o.w};
                LAS bf16_t* dl = (LAS bf16_t*)(Vl + (size_t)(hd * 64 + 8 * s) * 144) + tl;
#pragma unroll
                for (int j = 0; j < 4; ++j) { dl[(2 * j) * 72] = (bf16_t)(ow[j] & 0xffffu); dl[(2 * j + 1) * 72] = (bf16_t)(ow[j] >> 16); }
            }
            __syncthreads();
            { bf16_t* VT = type == 2 ? VTM : VTD;
#pragma unroll
              for (int kk = 0; kk < 8; ++kk) { const int row = (tid >> 3) + 64 * kk, ch = tid & 7;
                  const u32x4 w = *(LAS const u32x4*)(Vl + row * 144 + ch * 16);
                  *(u32x4*)(VT + ((size_t)(b * 512 + row) * TT + t0 + ch * 8)) = w; } }
            __syncthreads();
        } else {
            float w0[8], w1[8], w2[8];
            { const f32x4 a = *(const f32x4*)(cw + lane * 8), a2 = *(const f32x4*)(cw + lane * 8 + 4), b1 = *(const f32x4*)(cw + 512 + lane * 8), b2 = *(const f32x4*)(cw + 512 + lane * 8 + 4),
                          c1 = *(const f32x4*)(cw + 1024 + lane * 8), c2 = *(const f32x4*)(cw + 1024 + lane * 8 + 4);
#pragma unroll
              for (int j = 0; j < 4; ++j) { w0[j] = a[j]; w0[4 + j] = a2[j]; w1[j] = b1[j]; w1[4 + j] = b2[j]; w2[j] = c1[j]; w2[4 + j] = c2[j]; } }
            const int rf = r0 + wid * 8, sf = spos0 + wid * 8;
            const bf16_t* pb = PROJ + (size_t)rf * INWP + lane * 8;
            float up[8], uc[8];
#pragma unroll
            for (int j = 0; j < 8; ++j) up[j] = 0.f;
            { const bool hasp = sf > 0; const bf16_t* pp = hasp ? pb - (size_t)INWP : pb;
              float a[8], c[8]; unpack8(*(const u32x4*)(pp + O_CC), a, 1.0f); unpack8(*(const u32x4*)(pp + O_CX), c, 1.0f);
#pragma unroll
              for (int j = 0; j < 8; ++j) up[j] = hasp ? a[j] * c[j] : 0.f; }
            { float a[8], c[8]; unpack8(*(const u32x4*)(pb + O_CC), a, 1.0f); unpack8(*(const u32x4*)(pb + O_CX), c, 1.0f);
#pragma unroll
              for (int j = 0; j < 8; ++j) uc[j] = a[j] * c[j]; }
#pragma unroll
            for (int k = 0; k < 8; ++k) { const bf16_t* q = pb + (size_t)k * INWP;
                float un[8];
                { const bool hasn = sf + k + 1 < seglen; const bf16_t* qn = hasn ? q + INWP : q;
                  float a[8], c[8]; unpack8(*(const u32x4*)(qn + O_CC), a, 1.0f); unpack8(*(const u32x4*)(qn + O_CX), c, 1.0f);
#pragma unroll
                  for (int j = 0; j < 8; ++j) un[j] = hasn ? a[j] * c[j] : 0.f; }
                float cb[8]; unpack8(*(const u32x4*)(q + O_CB), cb, 1.0f);
                float y[8];
#pragma unroll
                for (int j = 0; j < 8; ++j) y[j] = cb[j] * (w0[j] * up[j] + w1[j] * uc[j] + w2[j] * un[j]);
                *(u32x4*)(Y2 + (size_t)(rf + k) * 1536 + lane * 8) = pack8(y);
#pragma unroll
                for (int j = 0; j < 8; ++j) { up[j] = uc[j]; uc[j] = un[j]; } }
        }
    }
}

DI void prep_phase(const Params& p, int l, LAS unsigned char* ldsb) {
    const float* TABM = (const float*)(p.ws + WS_TAB);
    prep_body(p, l, ldsb, (const bf16_t*)(p.ws + WS_PROJ), (const bf16_t*)(p.ws + WS_R1), (const bf16_t*)(p.ws + WS_R1 + R1_KVRAW),
              (bf16_t*)(p.ws + WS_QKV + Q_QM), (bf16_t*)(p.ws + WS_QKV + Q_KM), (bf16_t*)(p.ws + WS_QKV + Q_VTM), (bf16_t*)(p.ws + WS_QKV + Q_QD), (bf16_t*)(p.ws + WS_QKV + Q_KD), (bf16_t*)(p.ws + WS_QKV + Q_VTD),
              (bf16_t*)(p.ws + WS_Y) + 1024, TABM, TABM + 2048 * 32, p.in[22] + (size_t)l * 3 * 512);
}

template <int KC, int DS, bool DIFF>
DI void attn_item(LAS unsigned char* lds, const bf16_t* Qw  , const bf16_t* K0, const bf16_t* K1, const bf16_t* Vt, int nkeys, float cshift,
                  f32x4 (&oacc)[DS][2], float (&lsum)[2]) {
    constexpr int DK = KC * 32, KROW = DK * 2 + 32, VROW = 160, DV = DS * 16;
    constexpr int KBYTES = (DIFF ? 2 : 1) * 64 * KROW, STG = KBYTES + DV * VROW;
    const int tid = tidx(), wid = tid >> 6, lane = tid & 63, fr = lane & 15, fq = lane >> 4;
    const int comp = DIFF ? (wid >> 2) : 0;
    const int vpos = (((tid & 7) >> 2) * 32 + (tid & 1) * 16 + ((tid >> 1) & 1) * 4) * 2;
    bf16x8 qf[2][KC];
#pragma unroll
    for (int qs = 0; qs < 2; ++qs)
#pragma unroll
        for (int kc = 0; kc < KC; ++kc) qf[qs][kc] = *(const bf16x8*)(Qw + (size_t)(qs * 16 + fr) * DK + kc * 32 + fq * 8);
#pragma unroll
    for (int ds = 0; ds < DS; ++ds) { oacc[ds][0] = (f32x4){0.f, 0.f, 0.f, 0.f}; oacc[ds][1] = (f32x4){0.f, 0.f, 0.f, 0.f}; }
    lsum[0] = 0.f; lsum[1] = 0.f;
    u32x4 rk0, rk1, rv0, rv1;
    auto gload = [&](int t) {
        if constexpr (!DIFF) {
            const char* kb = (const char*)K0 + (size_t)t * 64 * DK * 2;
            rk0 = *(const u32x4*)(kb + tid * 16);
            if (tid < 256) rk1 = *(const u32x4*)(kb + (512 + tid) * 16);
            rv0 = *(const u32x4*)((const char*)Vt + (size_t)(tid >> 3) * TT * 2 + (size_t)t * 128 + (tid & 7) * 16);
        } else {
            rk0 = *(const u32x4*)((const char*)K0 + (size_t)t * 64 * DK * 2 + tid * 16);
            rk1 = *(const u32x4*)((const char*)K1 + (size_t)t * 64 * DK * 2 + tid * 16);
            rv0 = *(const u32x4*)((const char*)Vt + (size_t)(tid >> 3) * TT * 2 + (size_t)t * 128 + (tid & 7) * 16);
            rv1 = *(const u32x4*)((const char*)Vt + (size_t)(64 + (tid >> 3)) * TT * 2 + (size_t)t * 128 + (tid & 7) * 16);
        }
    };
    auto lstore = [&](int st) {
        LAS unsigned char* kb = lds + st * STG; LAS unsigned char* vb = kb + KBYTES;
        if constexpr (!DIFF) {
            { const int key = tid / 12, pc = tid - key * 12; *(LAS u32x4*)(kb + key * KROW + pc * 16) = rk0; }
            if (tid < 256) { const int c = 512 + tid, key = c / 12, pc = c - key * 12; *(LAS u32x4*)(kb + key * KROW + pc * 16) = rk1; }
            { LAS unsigned char* d = vb + (tid >> 3) * VROW + vpos; *(LAS u32x2*)d = (u32x2){rv0.x, rv0.y}; *(LAS u32x2*)(d + 16) = (u32x2){rv0.z, rv0.w}; }
        } else {
            *(LAS u32x4*)(kb + (tid >> 3) * KROW + (tid & 7) * 16) = rk0;
            *(LAS u32x4*)(kb + 64 * KROW + (tid >> 3) * KROW + (tid & 7) * 16) = rk1;
            { LAS unsigned char* d = vb + (tid >> 3) * VROW + vpos; *(LAS u32x2*)d = (u32x2){rv0.x, rv0.y}; *(LAS u32x2*)(d + 16) = (u32x2){rv0.z, rv0.w}; }
            { LAS unsigned char* d = vb + (64 + (tid >> 3)) * VROW + vpos; *(LAS u32x2*)d = (u32x2){rv1.x, rv1.y}; *(LAS u32x2*)(d + 16) = (u32x2){rv1.z, rv1.w}; }
        }
    };
    auto readK = [&](int st, int kk, bf16x8 (&kf)[2][KC]) {
        LAS const unsigned char* kb = lds + st * STG + comp * 64 * KROW;
#pragma unroll
        for (int kc = 0; kc < KC; ++kc)
#pragma unroll
            for (int ks = 0; ks < 2; ++ks) kf[ks][kc] = *(LAS const bf16x8*)(kb + ((2 * kk + ks) * 16 + fr) * KROW + (kc * 32 + fq * 8) * 2);
    };
    auto readV = [&](int st, int kk, int d0, bf16x8 (&vf)[4]) {
        LAS const unsigned char* vb = lds + st * STG + KBYTES;
#pragma unroll
        for (int i = 0; i < 4; ++i) vf[i] = *(LAS const bf16x8*)(vb + ((d0 + i) * 16 + fr) * VROW + (kk * 32 + fq * 8) * 2);
    };
    auto smma = [&](const bf16x8 (&kf)[2][KC], f32x4 (&sacc)[2][2]) {
#pragma unroll
        for (int ks = 0; ks < 2; ++ks) { sacc[ks][0] = (f32x4){-cshift, -cshift, -cshift, -cshift}; sacc[ks][1] = (f32x4){-cshift, -cshift, -cshift, -cshift}; }
#pragma unroll
        for (int kc = 0; kc < KC; ++kc)
#pragma unroll
            for (int ks = 0; ks < 2; ++ks)
#pragma unroll
                for (int qs = 0; qs < 2; ++qs) sacc[ks][qs] = __builtin_amdgcn_mfma_f32_16x16x32_bf16(kf[ks][kc], qf[qs][kc], sacc[ks][qs], 0, 0, 0);
    };
    auto softmax = [&](const f32x4 (&sacc)[2][2], bf16x8 (&pb)[2]) {
#pragma unroll
        for (int qs = 0; qs < 2; ++qs) {
            float e[8];
#pragma unroll
            for (int j = 0; j < 4; ++j) { e[j] = __builtin_amdgcn_exp2f(sacc[0][qs][j]); e[4 + j] = __builtin_amdgcn_exp2f(sacc[1][qs][j]); }
            lsum[qs] += ((e[0] + e[1]) + (e[2] + e[3])) + ((e[4] + e[5]) + (e[6] + e[7]));
            u32x4 w; w.x = pk2(e[0], e[1]); w.y = pk2(e[2], e[3]); w.z = pk2(e[4], e[5]); w.w = pk2(e[6], e[7]);
            pb[qs] = __builtin_bit_cast(bf16x8, w);
        }
    };
    auto pv4 = [&](const bf16x8 (&vf)[4], int d0, const bf16x8 (&pb)[2]) {
#pragma unroll
        for (int i = 0; i < 4; ++i)
#pragma unroll
            for (int qs = 0; qs < 2; ++qs) oacc[d0 + i][qs] = __builtin_amdgcn_mfma_f32_16x16x32_bf16(vf[i], pb[qs], oacc[d0 + i][qs], 0, 0, 0);
    };
#define SB() __builtin_amdgcn_sched_barrier(0)
    const int ntiles = nkeys >> 6;
    if constexpr (!DIFF) {
        gload(0); lstore(0); gload(1); lstore(1);
        __syncthreads();
        f32x4 sA[2][2], sB[2][2]; bf16x8 pb[2]; bf16x8 kf[2][KC]; bf16x8 vf[4];
        readK(0, 0, kf); smma(kf, sA);
        int st = 0;
        auto iter = [&](auto m1c, auto m2c, int t) {
            constexpr bool m1 = decltype(m1c)::value, m2 = decltype(m2c)::value;
            const int st1 = (st == 2) ? 0 : st + 1, st2 = (st1 == 2) ? 0 : st1 + 1;
            if constexpr (m2) gload(t + 2);
            readK(st, 1, kf); readV(st, 0, 0, vf); SB();
            smma(kf, sB); softmax(sA, pb);
            pv4(vf, 0, pb); SB();
            if constexpr (m1) readK(st1, 0, kf);
            readV(st, 1, 0, vf); SB();
            if constexpr (m1) smma(kf, sA);
            softmax(sB, pb);
            pv4(vf, 0, pb); SB();
            if constexpr (m2) lstore(st2);
            __syncthreads();
            st = st1;
        };
#pragma unroll 1
        for (int t = 0; t + 2 < ntiles; ++t) iter(std::true_type{}, std::true_type{}, t);
        iter(std::true_type{}, std::false_type{}, ntiles - 2);
        iter(std::false_type{}, std::false_type{}, ntiles - 1);
    } else {
        gload(0); lstore(0);
        __syncthreads();
        f32x4 sA[2][2]; bf16x8 pb[2]; bf16x8 kf[2][KC]; bf16x8 vf[4], vg[4];
        auto iter = [&](auto morec, int t) {
            constexpr bool more = decltype(morec)::value;
            const int st = t & 1;
            if constexpr (more) gload(t + 1);
#pragma unroll
            for (int kk = 0; kk < 2; ++kk) {
                readK(st, kk, kf); readV(st, kk, 0, vf); SB();
                smma(kf, sA); softmax(sA, pb); readV(st, kk, 4, vg);
                pv4(vf, 0, pb);
                pv4(vg, 4, pb); SB();
            }
            if constexpr (more) lstore((t + 1) & 1);
            __syncthreads();
        };
#pragma unroll 1
        for (int t = 0; t + 1 < ntiles; ++t) iter(std::true_type{}, t);
        iter(std::false_type{}, ntiles - 1);
    }
#undef SB
#pragma unroll
    for (int qs = 0; qs < 2; ++qs) { lsum[qs] += __shfl_xor(lsum[qs], 16); lsum[qs] += __shfl_xor(lsum[qs], 32); }
}

DI void attn_phase(const Params& p, int l, bool need_ctx, LAS unsigned char* lds) {
    const int tid = tidx(), wid = tid >> 6, lane = tid & 63, fr = lane & 15, fq = lane >> 4;
    const bf16_t* QM = (const bf16_t*)(p.ws + WS_QKV + Q_QM); const bf16_t* KM = (const bf16_t*)(p.ws + WS_QKV + Q_KM); const bf16_t* VTM = (const bf16_t*)(p.ws + WS_QKV + Q_VTM);
    const bf16_t* QD = (const bf16_t*)(p.ws + WS_QKV + Q_QD); const bf16_t* KD = (const bf16_t*)(p.ws + WS_QKV + Q_KD); const bf16_t* VTD = (const bf16_t*)(p.ws + WS_QKV + Q_VTD);
    bf16_t* Y0 = (bf16_t*)(p.ws + WS_Y); bf16_t* Y1 = Y0 + 512;
    float gq = 0.f, gk = 0.f;
    { const float a = lane < 48 ? fmaxf(fabsf(p.in[16][l * 96 + lane]), fabsf(p.in[16][l * 96 + 48 + lane])) : 0.f; gq = wave_max(a);
      const float b = lane < 48 ? fmaxf(fabsf(p.in[17][l * 96 + lane]), fabsf(p.in[17][l * 96 + 48 + lane])) : 0.f; gk = wave_max(b); }
    const float cs_m = gq * gk * 9.797958971132712f * LOG2E;
    { gq = wave_max(fabsf(p.in[18][l * 64 + lane])); gk = wave_max(fabsf(p.in[19][l * 64 + lane])); }
    const float cs_d = gq * gk * 8.0f * LOG2E;
    const float li = lam_init_of(l);
    float lam;
    { const float* lv = p.in[20] + (size_t)l * 256; const float s1 = wave_sum(lv[lane] * lv[64 + lane]), s2 = wave_sum(lv[128 + lane] * lv[192 + lane]); lam = expf(s1) - expf(s2) + li; }
    const float* gsub = p.in[21] + l * 128;
    const int first = need_ctx ? 0 : 128;
    for (int item = first + blockIdx.x; item < 1152; item += gridDim.x) {
        if (item < 64 || (item >= 128 && item < 640)) {
            int bh, tq0, nkeys;
            if (item < 64) { bh = item; tq0 = 0; nkeys = 256; } else { const int i = item - 128; bh = (i >> 8) * 32 + (i & 31); tq0 = 256 + ((i >> 5) & 7) * 256; nkeys = TT; }
            const int b = bh >> 3, h = bh & 7;
            f32x4 oacc[4][2]; float lsum[2];
            attn_item<3, 4, false>(lds, QM + ((size_t)bh * TT + tq0 + wid * 32) * 96, KM + (size_t)bh * TT * 96, nullptr, VTM + (size_t)bh * 64 * TT, nkeys, cs_m, oacc, lsum);
#pragma unroll
            for (int qs = 0; qs < 2; ++qs) { const float inv = 1.0f / lsum[qs]; const int tq = tq0 + wid * 32 + qs * 16 + fr;
                const size_t row = tq >= 256 ? (size_t)b * 2048 + (tq - 256) : (size_t)ML + b * 256 + tq;
#pragma unroll
                for (int ds = 0; ds < 4; ++ds) { const f32x4 o = oacc[ds][qs] * inv; u32x2 w; w.x = pk2(o[0], o[1]); w.y = pk2(o[2], o[3]);
                    *(u32x2*)(Y0 + row * 1536 + h * 64 + ds * 16 + fq * 4) = w; } }
        } else {
            int bh, tq0, nkeys;
            if (item < 128) { const int i = item - 64; bh = i & 31; tq0 = (i >> 5) * 128; nkeys = 256; } else { const int i = item - 640; bh = (i >> 8) * 16 + (i & 15); tq0 = 256 + ((i >> 4) & 15) * 128; nkeys = TT; }
            const int b = bh >> 2, h = bh & 3, comp = wid >> 2, wq = wid & 3;
            f32x4 oacc[8][2]; float lsum[2];
            const size_t kvec = (size_t)(bh * 2) * TT * 64;
            attn_item<2, 8, true>(lds, QD + ((size_t)(bh * 2 + comp) * TT + tq0 + wq * 32) * 64, KD + kvec, KD + kvec + (size_t)TT * 64, VTD + (size_t)bh * 128 * TT, nkeys, cs_d, oacc, lsum);
            LAS float* X = (LAS float*)lds;
            if (comp == 1) {
#pragma unroll
                for (int qs = 0; qs < 2; ++qs) { const float sc = lam / lsum[qs]; const int ql = wq * 32 + qs * 16 + fr;
#pragma unroll
                    for (int ds = 0; ds < 8; ++ds) *(LAS f32x4*)(X + ql * 132 + ds * 16 + fq * 4) = oacc[ds][qs] * sc; }
            }
            __syncthreads();
            if (comp == 0) {
#pragma unroll
                for (int qs = 0; qs < 2; ++qs) { const float inv = 1.0f / lsum[qs]; const int ql = wq * 32 + qs * 16 + fr; const int tq = tq0 + ql;
                    float ss = 0.f;
#pragma unroll
                    for (int ds = 0; ds < 8; ++ds) { const f32x4 o2 = *(LAS const f32x4*)(X + ql * 132 + ds * 16 + fq * 4); const f32x4 o = oacc[ds][qs] * inv - o2; oacc[ds][qs] = o;
                        ss += o[0] * o[0] + o[1] * o[1] + o[2] * o[2] + o[3] * o[3]; }
                    ss += __shfl_xor(ss, 16); ss += __shfl_xor(ss, 32);
                    const float rs = rsqrtf(ss * (1.0f / 128.0f) + EPS) * (1.0f - li);
                    const size_t row = tq >= 256 ? (size_t)b * 2048 + (tq - 256) : (size_t)ML + b * 256 + tq;
#pragma unroll
                    for (int ds = 0; ds < 8; ++ds) { const f32x4 gg = *(const f32x4*)(gsub + ds * 16 + fq * 4); const f32x4 o = oacc[ds][qs] * rs * gg;
                        u32x2 w; w.x = pk2(o[0], o[1]); w.y = pk2(o[2], o[3]);
                        *(u32x2*)(Y1 + row * 1536 + h * 128 + ds * 16 + fq * 4) = w; } }
            }
            __syncthreads();
        }
    }
}

#define XB_TMO      128
#define XB_XCNT(j)  (256  + 64 * (j))
#define XB_XSUB(j)  (1280 + 64 * (j))
#define XB_XGEN(j)  (2304 + 64 * (j))
#define XB_TOP      3328
#define XB_TOPGEN   3392
#define XCD_BAR_WORDS 3456
#define XB_SPIN_CAP (1u << 18)
DI unsigned xb_ld(unsigned* p) { return __hip_atomic_load(p, __ATOMIC_RELAXED, __HIP_MEMORY_SCOPE_AGENT); }
DI unsigned xb_add(unsigned* p, unsigned v) { return __hip_atomic_fetch_add(p, v, __ATOMIC_RELAXED, __HIP_MEMORY_SCOPE_AGENT); }
DI unsigned xb_xcc_id() { return (unsigned)__builtin_amdgcn_s_getreg((3 << 11) | 20) & 0xFu; }
#define XB_SPIN(cond, bar) do { unsigned _sp = 0; while (cond) { __builtin_amdgcn_s_sleep(1); \
    if ((++_sp & 255u) == 0u) { if (xb_ld(&(bar)[XB_TMO])) break; if (_sp > XB_SPIN_CAP) { atomicAdd(&(bar)[XB_TMO], 1u); break; } } } } while (0)
struct XcdBarrier { unsigned* bar; unsigned x; volatile LAS unsigned* st; };
DI XcdBarrier xcd_barrier_post(unsigned* bar, volatile LAS unsigned* st) {
    XcdBarrier b; b.bar = bar; b.x = xb_xcc_id(); b.st = st;
    if (threadIdx.x == 0) (void)xb_add(&bar[XB_XCNT(b.x)], 1u);
    return b;
}
DI void xcd_barrier_complete(unsigned* bar, unsigned x, unsigned& nloc, unsigned& nx) {
    const unsigned G = gridDim.x * gridDim.y * gridDim.z;
    unsigned sum, cnt, mine, sp = 0u;
    for (;;) {
        sum = 0u; cnt = 0u; mine = 0u;
#pragma unroll
        for (unsigned j = 0; j < 16; ++j) { const unsigned c = xb_ld(&bar[XB_XCNT(j)]); sum += c; cnt += (c > 0u) ? 1u : 0u; mine = (j == x) ? c : mine; }
        if (sum == G) break;
        __builtin_amdgcn_s_sleep(1);
        if ((++sp & 255u) == 0u) { if (xb_ld(&bar[XB_TMO])) break; if (sp > XB_SPIN_CAP) { atomicAdd(&bar[XB_TMO], 1u); break; } }
    }
    nloc = mine > 0u ? mine : 1u; nx = cnt > 0u ? cnt : 1u;
}
DI void xcd_barrier(const XcdBarrier& b) {
    asm volatile("s_waitcnt vmcnt(0)" ::: "memory");
    __syncthreads();
    if (threadIdx.x == 0) {
        unsigned* bar = b.bar;
        __builtin_amdgcn_s_waitcnt(0);
        unsigned nloc = b.st[0], nx = b.st[1];
        if (nloc == 0u) { xcd_barrier_complete(bar, b.x, nloc, nx); b.st[0] = nloc; b.st[1] = nx; }
        const unsigned old = xb_add(&bar[XB_XSUB(b.x)], 1u);
        const unsigned gen = old / nloc;
        if (old + 1u == (gen + 1u) * nloc) {
            __builtin_amdgcn_fence(__ATOMIC_RELEASE, "agent");
            asm volatile("s_waitcnt vmcnt(0)" ::: "memory");
            const unsigned og = xb_add(&bar[XB_TOP], 1u);
            const unsigned tg = og / nx;
            if (og + 1u == (tg + 1u) * nx) xb_add(&bar[XB_TOPGEN], 1u);
            else XB_SPIN(xb_ld(&bar[XB_TOPGEN]) == tg, bar);
            __builtin_amdgcn_fence(__ATOMIC_ACQUIRE, "agent");
            xb_add(&bar[XB_XGEN(b.x)], 1u);
            asm volatile("s_waitcnt vmcnt(0)" ::: "memory");
        } else {
            XB_SPIN(xb_ld(&bar[XB_XGEN(b.x)]) == gen, bar);
            __builtin_amdgcn_fence(__ATOMIC_ACQUIRE, "agent");
            asm volatile("s_waitcnt vmcnt(0)" ::: "memory");
        }
    }
    __syncthreads();
}

#ifndef PROBE_MASK
#define PROBE_MASK 0
#endif
#define REPS(bit) for (int rep_ = 0; rep_ < (((PROBE_MASK) >> (bit)) & 1) + 1; ++rep_)
typedef const __attribute__((address_space(4))) Params* KP;
#define PH_BEGIN KP pp_ = (KP)__builtin_amdgcn_kernarg_segment_ptr(); asm volatile("" : "+s"(pp_)); const Params& p = *(const Params*)pp_; \
    int G = gridDim.x, c = blockIdx.x; asm volatile("" : "+s"(G), "+s"(c)); \
    float* XL = p.out; float* XC = (float*)(p.ws + WS_XC); const float* modl = (const float*)(p.ws + WS_MOD) + (size_t)l * 9 * 9216; const float* ng = p.in[6] + (size_t)l * 3 * 1024; \
    bf16_t* W = (bf16_t*)(p.ws + ((l & 1) ? WS_W2 : WS_W)); bf16_t* H = (bf16_t*)(p.ws + WS_R1); bf16_t* MB = H; bf16_t* QRAW = H; bf16_t* KVRAW = (bf16_t*)(p.ws + WS_R1 + R1_KVRAW); \
    bf16_t* PROJ = (bf16_t*)(p.ws + WS_PROJ); bf16_t* ACT = PROJ; float* MACC = (float*)(p.ws + WS_QKV); float* PART = MACC; bf16_t* Y = (bf16_t*)(p.ws + WS_Y); \
    (void)G; (void)c; (void)XL; (void)XC; (void)modl; (void)ng; (void)W; (void)H; (void)MB; (void)QRAW; (void)KVRAW; (void)PROJ; (void)ACT; (void)MACC; (void)Y; (void)PART;

__global__ void __launch_bounds__(512, 2) fwd_megakernel(Params p_unused) {
    extern __shared__ __attribute__((aligned(16))) unsigned char shm[];
    LAS unsigned char* lds = (LAS unsigned char*)shm;
    cg::grid_group grid = cg::this_grid();
    volatile LAS unsigned* xst = (volatile LAS unsigned*)(lds + pg8::STAGE_BYTES);
    if (threadIdx.x < 4) xst[threadIdx.x] = 0u;
    __syncthreads();
    XcdBarrier xb;
    { KP pp_ = (KP)__builtin_amdgcn_kernarg_segment_ptr(); xb = xcd_barrier_post((unsigned*)(pp_->ws + WS_BAR), xst); }
#define GSYNC() xcd_barrier(xb)

    REPS(6) { int l = 0; PH_BEGIN; mod_phase(p, lds); }
    { int l = 0; PH_BEGIN; tab_phase(p); }
    REPS(6) { int l = 0; PH_BEGIN; conv_weights(p, 0, lds, W, c, G); }
    grid.sync();

#pragma unroll 1
    for (int lq = 0; lq < DEPTH; ++lq) {
        int l = lq; asm volatile("" : "+s"(l));
        const bool last = (l == DEPTH - 1);
        const int Mx = last ? ML : MT;
        REPS(2) { PH_BEGIN; if (l == 0) norm_phase(p.in[0], p.in[2], XL, XC, true, H, ng, modl, 0, 1, MT, PART, 0); else norm_phase(XL, XC, XL, XC, false, H, ng, modl, 0, 1, MT, PART, 4); }
        GSYNC();
        REPS(1) { PH_BEGIN; pg8::Sched S; S.init(MT, 5632, 1024, G, c); pg8::Gemm g{H, W + W_1U, 1024, 1024}; EpiSwiglu E{ACT}; pg8::gemm_phase(lds, g, S, E); }
        GSYNC();
        { PH_BEGIN; pg8::Sched S; S.init(ML, 1024, DFF, G, c); S.add_split(MC / 256, ML / 256, 4); pg8::Gemm g{ACT, W + W_1D, DFF, DFF}; EpiResid E{XL, XC, modl, 2, 0.5f, PART}; pg8::gemm_phase(lds, g, S, E); }
        GSYNC();
        REPS(2) { PH_BEGIN; norm_phase(XL, XC, XL, XC, false, H, ng + 1024, modl, 3, 4, MT, PART, 4); }
        GSYNC();
        if (!last) { REPS(1) { PH_BEGIN; pg8::Sched S; S.init(MT, INWP, 1024, G, c); pg8::Gemm g{H, W + W_IN, 1024, 1024}; EpiStore E{PROJ, INWP, O_G}; pg8::gemm_phase(lds, g, S, E); } }
        else {
            { PH_BEGIN; pg8::Sched S; S.init(ML, INWP, 1024, G, c); pg8::Gemm g{H, W + W_IN, 1024, 1024}; EpiStore E{PROJ, INWP, O_G}; pg8::gemm_phase(lds, g, S, E); }
            { PH_BEGIN; pg8::Sched S; S.init(MC, 2048, 1024, G, (c + 64) % G); pg8::Gemm g{H + (size_t)ML * 1024, W + W_IN + (size_t)256 * 1024, 1024, 1024}; EpiStore E{PROJ + (size_t)ML * INWP + 256, INWP, 1 << 30}; pg8::gemm_phase(lds, g, S, E); }
        }
        GSYNC();
        REPS(2) { PH_BEGIN; pg8::Sched S; S.init(MT, 768, 384, G, c); pg8::Gemm g{PROJ + O_CQ, W + W_UQ, INWP, 384}; EpiStore E{QRAW, 768, 1 << 30}; pg8::gemm_phase(lds, g, S, E); }
        REPS(2) { PH_BEGIN; pg8::Sched S; S.init(MT, 1024, 256, G, (c + 40) % G); pg8::Gemm g{PROJ + O_CKV, W + W_UKV, INWP, 256}; EpiStore E{KVRAW, 1024, 1 << 30}; pg8::gemm_phase(lds, g, S, E); }
        GSYNC();
        REPS(2) { PH_BEGIN; prep_phase(p, l, lds); }
        GSYNC();
        REPS(0) { PH_BEGIN; attn_phase(p, l, !last, lds); }
        GSYNC();
        { PH_BEGIN; pg8::Sched S; S.init(Mx, 1024, 512, G, c, 3, 0, 0); S.kseg = 512; pg8::Gemm g{Y, W + W_BR, 1536, 1536}; EpiMerge E{MB, PROJ}; pg8::gemm_phase(lds, g, S, E);
          { int heavy = (MT / 256) * 4 - G; if (heavy < 0 || heavy >= G) heavy = 0;
            if (!last && c >= heavy) { bf16_t* Wn = (bf16_t*)(p.ws + (((l + 1) & 1) ? WS_W2 : WS_W)); conv_weights(p, l + 1, lds, Wn, c - heavy, G - heavy); } } }
        GSYNC();
        for (int r_ = 0; r_ < 6 * (((PROBE_MASK) >> 3) & 1); ++r_) GSYNC();
        { PH_BEGIN; pg8::Sched S; S.init(ML, 1024, 1024, G, c); if (!last) S.add_split(MC / 256, ML / 256, 4); pg8::Gemm g{MB, W + W_O, 1024, 1024}; EpiResid E{XL, XC, modl, 5, 1.0f, PART}; pg8::gemm_phase(lds, g, S, E); }
        GSYNC();
        REPS(2) { PH_BEGIN; norm_phase(XL, XC, XL, XC, false, H, ng + 2048, modl, 6, 7, Mx, PART, last ? 0 : 4); }
        GSYNC();
        REPS(1) { PH_BEGIN; pg8::Sched S; S.init(Mx, 5632, 1024, G, c); pg8::Gemm g{H, W + W_2U, 1024, 1024}; EpiSwiglu E{ACT}; pg8::gemm_phase(lds, g, S, E); }
        GSYNC();
        { PH_BEGIN; pg8::Sched S; S.init(ML, 1024, DFF, G, c); if (!last) S.add_split(MC / 256, ML / 256, 4); pg8::Gemm g{ACT, W + W_2D, DFF, DFF}; EpiResid E{XL, XC, modl, 8, 0.5f, PART}; pg8::gemm_phase(lds, g, S, E); }
        GSYNC();
    }
}

extern "C" void kernel_launch(void* const* d_in, const int* in_sizes, int n_in, void* d_out, int out_size, void* d_ws, size_t ws_size, hipStream_t stream) {
    constexpr int LDS_BYTES = pg8::STAGE_BYTES + 16;
    static int grid = 0;
    if (grid == 0) {
        if (n_in != 25 || ws_size < WS_END) { fprintf(stderr, "kernel_launch: bad inputs (n_in %d, ws %zu need %zu)\n", n_in, ws_size, (size_t)WS_END); grid = -1; return; }
        int dev = 0, cus = 0, per_cu = 0;
        hipGetDevice(&dev);
        hipDeviceGetAttribute(&cus, hipDeviceAttributeMultiprocessorCount, dev);
        hipFuncSetAttribute((const void*)fwd_megakernel, hipFuncAttributeMaxDynamicSharedMemorySize, LDS_BYTES);
        hipOccupancyMaxActiveBlocksPerMultiprocessor(&per_cu, (const void*)fwd_megakernel, 512, LDS_BYTES);
        if (per_cu < 1) per_cu = 1;
        (void)hipGetLastError();
        grid = cus;
    }
    if (grid < 0) return;
    Params p{};
    for (int i = 0; i < 25; ++i) p.in[i] = (const float*)d_in[i];
    p.out = (float*)d_out; p.ws = (unsigned char*)d_ws;
    (void)hipMemsetAsync((unsigned char*)d_ws + WS_BAR, 0, XCD_BAR_WORDS * 4, stream);
    void* args[] = {&p};
    hipError_t e = hipLaunchCooperativeKernel((const void*)fwd_megakernel, dim3(grid), dim3(512), args, LDS_BYTES, stream);
    if (e != hipSuccess) fprintf(stderr, "cooperative launch failed: %s (grid %d)\n", hipGetErrorString(e), grid);
}
```

```cpp
#include <hip/hip_runtime.h>
#include <hip/hip_cooperative_groups.h>
#include <cstdio>
#include <type_traits>
namespace cg = cooperative_groups;

#define LAS __attribute__((address_space(3)))
typedef unsigned short bf16_t;
typedef short bf16x8 __attribute__((ext_vector_type(8)));
typedef float f32x4 __attribute__((ext_vector_type(4)));
typedef float f32x2 __attribute__((ext_vector_type(2)));
typedef unsigned u32x4 __attribute__((ext_vector_type(4)));
typedef unsigned u32x2 __attribute__((ext_vector_type(2)));
typedef __bf16 bf16x2_t __attribute__((ext_vector_type(2)));
#define DI __device__ __forceinline__

constexpr int D = 1024, NB = 8, SEQ = 2048, NCTX = 256, TT = 2304, DEPTH = 4;
constexpr int ML = NB * SEQ;
constexpr int MC = NB * NCTX;
constexpr int MT = ML + MC;
constexpr int DFF = 2816, INW = 6816, INWP = 6912;
constexpr int O_CQ = 0, O_CKV = 384, O_KR = 640, O_DQ = 672, O_DK = 1184, O_DV = 1696, O_CB = 2208, O_CC = 2720, O_CX = 3232, O_G = 3744;
constexpr float EPS = 1e-6f;
constexpr float LOG2E = 1.4426950408889634f;

constexpr size_t al256(size_t x) { return (x + 255) & ~(size_t)255; }
constexpr size_t WS_MOD = 0;
constexpr size_t WS_TAB = al256(WS_MOD + (size_t)4 * 9 * 9216 * 4);
constexpr size_t WS_XC = al256(WS_TAB + (size_t)2048 * 96 * 4);
constexpr size_t WS_W = al256(WS_XC + (size_t)MC * D * 4);
constexpr size_t W_1U = 0, W_1D = W_1U + (size_t)5632 * 1024, W_2U = W_1D + (size_t)1024 * 2816, W_2D = W_2U + (size_t)5632 * 1024,
                 W_IN = W_2D + (size_t)1024 * 2816, W_UQ = W_IN + (size_t)INWP * 1024, W_UKV = W_UQ + (size_t)768 * 384,
                 W_BR = W_UKV + (size_t)1024 * 256, W_O = W_BR + (size_t)3 * 1024 * 512, W_END = W_O + (size_t)1024 * 1024;
constexpr size_t WS_R1 = al256(WS_W + W_END * 2);
constexpr size_t R1_KVRAW = (size_t)MT * 768 * 2;
constexpr size_t WS_PROJ = al256(WS_R1 + (size_t)MT * (768 + 1024) * 2);
constexpr size_t WS_QKV = al256(WS_PROJ + (size_t)MT * INWP * 2);
constexpr size_t Q_QM = 0, Q_KM = Q_QM + (size_t)NB * 8 * TT * 96 * 2, Q_VTM = Q_KM + (size_t)NB * 8 * TT * 96 * 2, Q_QD = Q_VTM + (size_t)NB * 8 * 64 * TT * 2,
                 Q_KD = Q_QD + (size_t)NB * 8 * TT * 64 * 2, Q_VTD = Q_KD + (size_t)NB * 8 * TT * 64 * 2, Q_END = Q_VTD + (size_t)NB * 4 * 128 * TT * 2;
constexpr size_t WS_Y = al256(WS_QKV + Q_END);
constexpr size_t WS_BAR = al256(WS_Y + (size_t)3 * MT * 512 * 2);
constexpr size_t WS_W2 = al256(WS_BAR + 3456 * 4);
constexpr size_t WS_END = al256(WS_W2 + W_END * 2);
static_assert(Q_END >= (size_t)MT * 1024 * 4, "MACC alias");

struct Params {
    const float* in[25];
    float* out;
    unsigned char* ws;
};

DI unsigned pk2(float a, float b) { f32x2 f = {a, b}; bf16x2_t h = __builtin_convertvector(f, bf16x2_t); return __builtin_bit_cast(unsigned, h); }
DI float bflo(unsigned u) { return __uint_as_float(u << 16); }
DI float bfhi(unsigned u) { return __uint_as_float(u & 0xffff0000u); }
DI float wave_sum(float v) {
#pragma unroll
    for (int o = 32; o > 0; o >>= 1) v += __shfl_xor(v, o);
    return v;
}
DI float wave_max(float v) {
#pragma unroll
    for (int o = 32; o > 0; o >>= 1) v = fmaxf(v, __shfl_xor(v, o));
    return v;
}
DI float lam_init_of(int l) { return l == 0 ? 0.2f : (l == 1 ? 0.35550907f : (l == 2 ? 0.47071302f : 0.55605820f)); }
DI float sigmoidf_(float x) { return __builtin_amdgcn_rcpf(1.0f + __builtin_amdgcn_exp2f(-1.4426950408889634f * x)); }
DI int tidx() { int t = threadIdx.x; asm volatile("" : "+v"(t)); return t; }

namespace pg8 {
constexpr int BM = 256, BK = 64, HALF = 128, HTB = HALF * BK * 2, STAGE_BYTES = 8 * HTB, NXCD = 8, WGM = 8;
DI int lds_byte(int r, int c) { const int st = (r >> 4) * 2 + (c >> 5), rr = r & 15, cc = c & 31, ob = rr * 64 + cc * 2; return st * 1024 + (ob ^ (((ob >> 9) & 1) << 5)); }
DI void stage_rc(int b, int& R, int& C) { const int st = b / 1024, sb = b % 1024, swz = sb ^ (((sb >> 9) & 1) << 5); R = (st >> 1) * 16 + swz / 64; C = (st & 1) * 32 + (swz % 64) / 2; }
DI int perm32(int rho) { const int n = rho >> 4, i = rho & 15; return 8 * (i >> 2) + 4 * n + (i & 3); }
struct Unit { int pm, pn, k0, nt, split; };
struct Gemm { const bf16_t* A; const bf16_t* Bt; int lda, K; };

struct Sched {
    int nM, nN, nwg, G, c, rep, aStride, bStride, ntFull;
    int nSplit, P, splitPm0, nb;
    int kseg;
    DI void init(int M, int N, int K, int G_, int c_, int rep_ = 1, int as_ = 0, int bs_ = 0) { nM = M / BM; nN = N / BM; nwg = nM * nN; G = G_; c = c_; rep = rep_; aStride = as_; bStride = bs_; ntFull = K / BK;
        nSplit = 0; P = 1; splitPm0 = 0; nb = K / 128; kseg = 0; }
    DI void add_split(int tilesM, int pm0, int P_) { nSplit = tilesM * nN * P_; P = P_; splitPm0 = pm0; }
    DI bool next(int i, Unit& u) const {
        int it = i, n = 0;
        if (rep > 1) { it = i / rep; n = i - it * rep; }
        const long L = (long)it * G + c;
        if (L >= nwg) {
            const int s = (int)(L - nwg); if (s >= nSplit) return false;
            const int tile = s / P, j = s - tile * P, base = nb / P, rem = nb - base * P;
            u.pm = splitPm0 + tile / nN; u.pn = tile % nN; u.k0 = 128 * (j * base + (j < rem ? j : rem)); u.nt = 2 * (base + (j < rem ? 1 : 0)); u.split = j + 1; return true;
        }
        int wgid = (int)L; { const int q = nwg / NXCD, r = nwg % NXCD, xcd = wgid % NXCD, off = wgid / NXCD; wgid = (xcd < r ? xcd * (q + 1) : r * (q + 1) + (xcd - r) * q) + off; }
        const int nig = WGM * nN, gid = wgid / nig, fm = gid * WGM, gsz = (nM - fm) < WGM ? (nM - fm) : WGM;
        u.pm = fm + ((wgid % nig) % gsz) + n * aStride; u.pn = (wgid % nig) / gsz + n * bStride; u.k0 = 0; u.nt = ntFull; u.split = 0;
        if (kseg) { u.k0 = n * kseg; u.split = n; }
        return true;
    }
};

template <class Epi>
DI void gemm_phase(LAS unsigned char* lds, const Gemm g, const Sched& S, const Epi& E) {
    const int tid = tidx(), wid = __builtin_amdgcn_readfirstlane(tid >> 6), lane = tid & 63, wr = wid >> 2, wc = wid & 3, fr = lane & 15, fq = lane >> 4;
    const int K = g.K, lda = g.lda;
    unsigned voffA[2], voffB[2];
#pragma unroll
    for (int i = 0; i < 2; ++i) { int R, C; stage_rc(tid * 16 + i * 8192, R, C); const int Rb = Epi::PERM ? ((R & ~31) + perm32(R & 31)) : R;
        voffA[i] = (unsigned)(R * lda + C) * 2u; voffB[i] = (unsigned)(Rb * K + C) * 2u; }
    const size_t kstep = (size_t)(BK * 2);
    const size_t hstepA = (size_t)HALF * lda * 2, hstepB = (size_t)HALF * K * 2;
    const size_t tstepA = 2 * hstepA, tstepB = 2 * hstepB;
    const unsigned ldsw = (unsigned)wid * 1024u;
    const int aoff = lds_byte(wr * 64 + fr, fq * 8), boff = lds_byte(wc * 32 + fr, fq * 8);
#define PG8_SA(b, h) (((b) * 2 + (h)) * HTB)
#define PG8_SB(b, h) ((4 + (b) * 2 + (h)) * HTB)
#define PG8_STAGE(bufoff, gbase, voff) do { _Pragma("unroll") for (int _i = 0; _i < 2; ++_i) \
        __builtin_amdgcn_global_load_lds((const unsigned*)((const char*)(gbase) + (voff)[_i]), (LAS unsigned*)(lds + (bufoff) + ldsw + _i * 8192), 16, 0, 0); } while (0)
#define PG8_LDA(dst, b, h) do { _Pragma("unroll") for (int m = 0; m < 4; ++m) _Pragma("unroll") for (int k = 0; k < 2; ++k) dst[m][k] = *(const LAS bf16x8*)(lds + PG8_SA(b, h) + aoff + m * 2048 + k * 1024); } while (0)
#define PG8_LDB(dst, b, h) do { _Pragma("unroll") for (int n = 0; n < 2; ++n) _Pragma("unroll") for (int k = 0; k < 2; ++k) dst[n][k] = *(const LAS bf16x8*)(lds + PG8_SB(b, h) + boff + n * 2048 + k * 1024); } while (0)
#define PG8_MMA(ai, bj, At, Bt) do { __builtin_amdgcn_s_setprio(1); _Pragma("unroll") for (int m = 0; m < 4; ++m) _Pragma("unroll") for (int n = 0; n < 2; ++n) _Pragma("unroll") for (int k = 0; k < 2; ++k) \
        acc[ai][bj][m][n] = __builtin_amdgcn_mfma_f32_16x16x32_bf16(Bt[n][k], At[m][k], acc[ai][bj][m][n], 0, 0, 0); __builtin_amdgcn_s_setprio(0); } while (0)
#define PG8_WAIT_V(n) asm volatile("s_waitcnt vmcnt(" #n ")" ::: "memory")
#define PG8_WAIT_L(n) asm volatile("s_waitcnt lgkmcnt(" #n ")" ::: "memory")
#define PG8_BAR __builtin_amdgcn_s_barrier()
#define PG8_SCHED __builtin_amdgcn_sched_barrier(0)
    Unit cur, nxt; int ui = 0;
    if (!S.next(0, cur)) return;
    f32x4 acc[2][2][4][2];
#pragma unroll
    for (int a = 0; a < 2; ++a)
#pragma unroll
        for (int b = 0; b < 2; ++b)
#pragma unroll
            for (int m = 0; m < 4; ++m)
#pragma unroll
                for (int n = 0; n < 2; ++n) acc[a][b][m][n] = (f32x4){0.f, 0.f, 0.f, 0.f};
    bf16x8 At[4][2], B0[2][2], B1[2][2];
    const char* cA = (const char*)g.A + (size_t)cur.pm * tstepA + (size_t)cur.k0 * 2; const char* cB = (const char*)g.Bt + (size_t)cur.pn * tstepB + (size_t)cur.k0 * 2;
    PG8_STAGE(PG8_SB(0, 0), cB, voffB); PG8_STAGE(PG8_SA(0, 0), cA, voffA); PG8_STAGE(PG8_SB(0, 1), cB + hstepB, voffB); PG8_STAGE(PG8_SA(0, 1), cA + hstepA, voffA);
    if (wr == 1) PG8_BAR;
    PG8_WAIT_V(4); PG8_BAR;
    PG8_STAGE(PG8_SB(1, 0), cB + kstep, voffB); PG8_STAGE(PG8_SA(1, 0), cA + kstep, voffA); PG8_STAGE(PG8_SB(1, 1), cB + hstepB + kstep, voffB);
    PG8_WAIT_V(6); PG8_BAR;
    for (;;) {
        const bool has_next = S.next(ui + 1, nxt);
        const char* nA = has_next ? (const char*)g.A + (size_t)nxt.pm * tstepA + (size_t)nxt.k0 * 2 : cA; const char* nB = has_next ? (const char*)g.Bt + (size_t)nxt.pn * tstepB + (size_t)nxt.k0 * 2 : cB;
        const int nt = cur.nt;
        for (int t = 0; t < nt; t += 2) {
            const bool last = (t == nt - 2);
            const char* a1 = cA + (size_t)(t + 1) * kstep;
            const char* a2 = last ? nA : cA + (size_t)(t + 2) * kstep; const char* b2 = last ? nB : cB + (size_t)(t + 2) * kstep;
            const char* a3 = a2 + kstep; const char* b3 = b2 + kstep;
            PG8_LDB(B0, 0, 0); PG8_SCHED; PG8_LDA(At, 0, 0); PG8_STAGE(PG8_SA(1, 1), a1 + hstepA, voffA);
            PG8_WAIT_L(8); PG8_BAR; PG8_WAIT_L(0); PG8_MMA(0, 0, At, B0); PG8_BAR; PG8_SCHED;
            PG8_LDB(B1, 0, 1); PG8_STAGE(PG8_SB(0, 0), b2, voffB);
            PG8_BAR; PG8_WAIT_L(0); PG8_MMA(0, 1, At, B1); PG8_BAR;
            PG8_LDA(At, 0, 1); PG8_STAGE(PG8_SA(0, 0), a2, voffA);
            PG8_BAR; PG8_WAIT_L(0); PG8_MMA(1, 0, At, B0); PG8_BAR; PG8_SCHED;
            PG8_STAGE(PG8_SB(0, 1), b2 + hstepB, voffB);
            PG8_WAIT_V(6); PG8_BAR; PG8_MMA(1, 1, At, B1); PG8_BAR;
            PG8_LDB(B0, 1, 0); PG8_SCHED; PG8_LDA(At, 1, 0); PG8_STAGE(PG8_SA(0, 1), a2 + hstepA, voffA);
            PG8_WAIT_L(8); PG8_BAR; PG8_WAIT_L(0); PG8_MMA(0, 0, At, B0); PG8_BAR; PG8_SCHED;
            PG8_LDB(B1, 1, 1); PG8_STAGE(PG8_SB(1, 0), b3, voffB);
            PG8_BAR; PG8_WAIT_L(0); PG8_MMA(0, 1, At, B1); PG8_BAR;
            PG8_LDA(At, 1, 1); PG8_STAGE(PG8_SA(1, 0), a3, voffA);
            PG8_BAR; PG8_WAIT_L(0); PG8_MMA(1, 0, At, B0); PG8_BAR; PG8_SCHED;
            PG8_STAGE(PG8_SB(1, 1), b3 + hstepB, voffB);
            PG8_WAIT_V(6); PG8_BAR; PG8_MMA(1, 1, At, B1); PG8_BAR;
        }
        E(acc, cur, wr, wc, fr, fq);
        if (!has_next) break;
        if (!(Epi::CHAIN && nxt.split != 0)) {
#pragma unroll
            for (int a = 0; a < 2; ++a)
#pragma unroll
                for (int b = 0; b < 2; ++b)
#pragma unroll
                    for (int m = 0; m < 4; ++m)
#pragma unroll
                        for (int n = 0; n < 2; ++n) acc[a][b][m][n] = (f32x4){0.f, 0.f, 0.f, 0.f};
        }
        cur = nxt; cA = nA; cB = nB; ++ui;
    }
    PG8_WAIT_V(0);
    if (wr == 0) PG8_BAR;
    PG8_BAR;
#undef PG8_SA
#undef PG8_SB
#undef PG8_STAGE
#undef PG8_LDA
#undef PG8_LDB
#undef PG8_MMA
#undef PG8_WAIT_V
#undef PG8_WAIT_L
#undef PG8_BAR
#undef PG8_SCHED
}
}
using pg8::Unit;
typedef f32x4 AccT[2][2][4][2];

struct EpiStore {
    static constexpr bool PERM = true, CHAIN = false;
    bf16_t* O; int ld; int sig0;
    DI void operator()(const AccT& acc, const Unit& u, int wr, int wc, int fr, int fq) const {
        const int row0 = u.pm * 256 + wr * 64 + fr, col0 = u.pn * 256 + wc * 32 + 8 * fq;
#pragma unroll
        for (int ai = 0; ai < 2; ++ai)
#pragma unroll
            for (int m = 0; m < 4; ++m) { bf16_t* rowp = O + (size_t)(row0 + ai * 128 + m * 16) * ld + col0;
#pragma unroll
                for (int bj = 0; bj < 2; ++bj) { f32x4 v0 = acc[ai][bj][m][0], v1 = acc[ai][bj][m][1];
                    if (u.pn * 256 + bj * 128 + wc * 32 >= sig0) {
#pragma unroll
                        for (int j = 0; j < 4; ++j) { v0[j] = sigmoidf_(v0[j]); v1[j] = sigmoidf_(v1[j]); } }
                    u32x4 w; w.x = pk2(v0[0], v0[1]); w.y = pk2(v0[2], v0[3]); w.z = pk2(v1[0], v1[1]); w.w = pk2(v1[2], v1[3]);
                    *(u32x4*)(rowp + bj * 128) = w; } }
    }
};
struct EpiSwiglu {
    static constexpr bool PERM = true, CHAIN = false;
    bf16_t* O;
    DI void operator()(const AccT& acc, const Unit& u, int wr, int wc, int fr, int fq) const {
        const int row0 = u.pm * 256 + wr * 64 + fr, col0 = u.pn * 128 + (wc * 4 + fq) * 8;
#pragma unroll
        for (int ai = 0; ai < 2; ++ai)
#pragma unroll
            for (int m = 0; m < 4; ++m) { bf16_t* rowp = O + (size_t)(row0 + ai * 128 + m * 16) * DFF + col0;
                unsigned o[4];
#pragma unroll
                for (int bj = 0; bj < 2; ++bj) { const f32x4 v0 = acc[ai][bj][m][0], v1 = acc[ai][bj][m][1];
                    const float r0 = v0[0] * sigmoidf_(v0[0]) * v0[1], r1 = v0[2] * sigmoidf_(v0[2]) * v0[3];
                    const float r2 = v1[0] * sigmoidf_(v1[0]) * v1[1], r3 = v1[2] * sigmoidf_(v1[2]) * v1[3];
                    o[2 * bj] = pk2(r0, r1); o[2 * bj + 1] = pk2(r2, r3); }
                u32x4 w; w.x = o[0]; w.y = o[1]; w.z = o[2]; w.w = o[3];
                *(u32x4*)rowp = w; }
    }
};
struct EpiResid {
    static constexpr bool PERM = false, CHAIN = false;
    float* xl; float* xc; const float* modl; int midx; float coef; float* part;
    DI void operator()(const AccT& acc, const Unit& u, int wr, int wc, int fr, int fq) const {
        const int bi = u.pm < 64 ? (u.pm >> 3) : 8;
        float* base = u.pm < 64 ? xl + (size_t)u.pm * 256 * D : xc + (size_t)(u.pm - 64) * 256 * D;
        if (u.split) base = part + (size_t)(u.split - 1) * MC * D + (size_t)(u.pm - 64) * 256 * D;
        const int row0 = wr * 64 + fr, col0 = u.pn * 256 + wc * 32 + 4 * fq;
        const float* mp = modl + (size_t)bi * 9216 + midx * 1024 + col0;
#pragma unroll
        for (int bj = 0; bj < 2; ++bj) {
            f32x4 mv[2];
#pragma unroll
            for (int n = 0; n < 2; ++n) mv[n] = *(const f32x4*)(mp + bj * 128 + n * 16) * coef;
            float* cb = base + (size_t)row0 * D + col0 + bj * 128;
            f32x4 xv[2][2][4];
            if (!u.split) {
#pragma unroll
                for (int n = 0; n < 2; ++n)
#pragma unroll
                    for (int ai = 0; ai < 2; ++ai)
#pragma unroll
                        for (int m = 0; m < 4; ++m) xv[n][ai][m] = *(const f32x4*)(cb + n * 16 + (size_t)(ai * 128 + m * 16) * D);
            } else {
#pragma unroll
                for (int n = 0; n < 2; ++n)
#pragma unroll
                    for (int ai = 0; ai < 2; ++ai)
#pragma unroll
                        for (int m = 0; m < 4; ++m) xv[n][ai][m] = (f32x4){0.f, 0.f, 0.f, 0.f};
            }
#pragma unroll
            for (int n = 0; n < 2; ++n)
#pragma unroll
                for (int ai = 0; ai < 2; ++ai)
#pragma unroll
                    for (int m = 0; m < 4; ++m) *(f32x4*)(cb + n * 16 + (size_t)(ai * 128 + m * 16) * D) = xv[n][ai][m] + mv[n] * acc[ai][bj][m][n];
        }
    }
};
struct EpiMerge {
    static constexpr bool PERM = true, CHAIN = true;
    bf16_t* mb; const bf16_t* proj;
    DI void operator()(AccT& acc, const Unit& u, int wr, int wc, int fr, int fq) const {
        const int seg = u.split;
        const int row0 = u.pm * 256 + wr * 64 + fr, col0 = u.pn * 256 + wc * 32 + 8 * fq;
#pragma unroll
        for (int ai = 0; ai < 2; ++ai) {
            u32x4 ga[4][2], gb[4][2];
#pragma unroll
            for (int m = 0; m < 4; ++m) { const bf16_t* gp = proj + (size_t)(row0 + ai * 128 + m * 16) * INWP + O_G + seg * 1024 + col0;
#pragma unroll
                for (int bj = 0; bj < 2; ++bj) { ga[m][bj] = *(const u32x4*)(gp + bj * 128); gb[m][bj] = seg < 2 ? *(const u32x4*)(gp + 1024 + bj * 128) : (u32x4){0u, 0u, 0u, 0u}; } }
#pragma unroll
            for (int m = 0; m < 4; ++m) { const size_t row = (size_t)(row0 + ai * 128 + m * 16);
#pragma unroll
                for (int bj = 0; bj < 2; ++bj) {
                    const unsigned aw[4] = {ga[m][bj].x, ga[m][bj].y, ga[m][bj].z, ga[m][bj].w}, bw[4] = {gb[m][bj].x, gb[m][bj].y, gb[m][bj].z, gb[m][bj].w};
                    float r[8];
#pragma unroll
                    for (int j = 0; j < 4; ++j) { r[2 * j] = fmaxf(bflo(aw[j]), 1e-20f); r[2 * j + 1] = fmaxf(bfhi(aw[j]), 1e-20f); }
                    if (seg < 2) {
#pragma unroll
                        for (int j = 0; j < 4; ++j) { r[2 * j] *= __builtin_amdgcn_rcpf(fmaxf(bflo(bw[j]), 1e-20f)); r[2 * j + 1] *= __builtin_amdgcn_rcpf(fmaxf(bfhi(bw[j]), 1e-20f)); }
#pragma unroll
                        for (int n = 0; n < 2; ++n) { f32x4 rv; rv[0] = r[4 * n]; rv[1] = r[4 * n + 1]; rv[2] = r[4 * n + 2]; rv[3] = r[4 * n + 3]; acc[ai][bj][m][n] = acc[ai][bj][m][n] * rv; }
                    } else {
                        const f32x4 v0 = acc[ai][bj][m][0], v1 = acc[ai][bj][m][1];
                        u32x4 w; w.x = pk2(v0[0] * r[0], v0[1] * r[1]); w.y = pk2(v0[2] * r[2], v0[3] * r[3]); w.z = pk2(v1[0] * r[4], v1[1] * r[5]); w.w = pk2(v1[2] * r[6], v1[3] * r[7]);
                        *(u32x4*)(mb + row * D + col0 + bj * 128) = w; } } }
        }
    }
};

DI void mod_phase(const Params& p, LAS unsigned char* ldsb) {
    LAS float* sc = (LAS float*)ldsb;
    LAS float* red = sc + 9216;
    const int tid = tidx(), wid = tid >> 6, lane = tid & 63;
    for (int i = tid; i < 9216; i += 512) { const int bi = i >> 10, k = i & 1023; const float cv = bi < 8 ? p.in[1][bi * 1024 + k] : p.in[3][k]; sc[i] = cv / (1.0f + expf(-cv)); }
    __syncthreads();
    float* MOD = (float*)(p.ws + WS_MOD);
    for (int item = blockIdx.x; item < 144; item += gridDim.x) {
        const int l = item / 36, j0 = (item % 36) * 256;
        const float* w = p.in[4] + ((size_t)l * 1024 + wid * 128) * 9216 + j0 + lane * 4;
        f32x4 acc[9];
#pragma unroll
        for (int b = 0; b < 9; ++b) acc[b] = (f32x4){0.f, 0.f, 0.f, 0.f};
#pragma unroll 8
        for (int kk = 0; kk < 128; ++kk) { const f32x4 wv = __builtin_nontemporal_load((const f32x4*)(w + (size_t)kk * 9216)); const int k = wid * 128 + kk;
#pragma unroll
            for (int b = 0; b < 9; ++b) acc[b] = acc[b] + wv * sc[b * 1024 + k]; }
#pragma unroll
        for (int b = 0; b < 9; ++b) *(LAS f32x4*)(red + (wid * 9 + b) * 256 + lane * 4) = acc[b];
        __syncthreads();
        for (int o = tid; o < 9 * 256; o += 512) { const int b = o >> 8, cn = o & 255; float s = 0.f;
#pragma unroll
            for (int w8 = 0; w8 < 8; ++w8) s += red[(w8 * 9 + b) * 256 + cn];
            MOD[((size_t)l * 9 + b) * 9216 + j0 + cn] = s + p.in[5][(size_t)l * 9216 + j0 + cn]; }
        __syncthreads();
    }
}
DI void tab_phase(const Params& p) {
    float* TABM = (float*)(p.ws + WS_TAB);
    float* TABD = TABM + 2048 * 32;
    const int gt = blockIdx.x * 512 + tidx(), nth = gridDim.x * 512;
    for (int i = gt; i < 2048 * 48; i += nth) {
        const int s = i / 48, a = i % 48;
        const float row = (float)(s >> 6), col = (float)(s & 63);
        float pos, invf; int idx; float* dst; int half;
        if (a < 16) { const int axis = a >> 3, f = a & 7; pos = axis ? col : row; invf = exp2f(-(float)f * (13.287712379549449f / 8.0f)); dst = TABM + s * 32; idx = a; half = 16; }
        else { const int a2 = a - 16, axis = a2 >> 4, f = a2 & 15; pos = axis ? col : row; invf = exp2f(-(float)f * (13.287712379549449f / 16.0f)); dst = TABD + s * 64; idx = a2; half = 32; }
        const float ang = pos * invf;
        float rev = ang * 0.15915494309189535f; rev -= floorf(rev);
        dst[idx] = __builtin_amdgcn_cosf(rev); dst[half + idx] = __builtin_amdgcn_sinf(rev);
    }
}

DI void convT(const float* __restrict__ src, int K, int N, bf16_t* __restrict__ dst, int mode, const float* kscale, LAS float* tile, int rot, int vid, int vcnt, int ldd = 0, int koff = 0) {
    if (ldd == 0) ldd = K;
    const int tilesN = (N + 63) >> 6, tilesK = K >> 6, nt = tilesN * tilesK, tid = tidx();
    int start = vid - (rot % vcnt); if (start < 0) start += vcnt;
    const int kr = tid >> 4, c4 = (tid & 15) * 4;
    f32x4 r0, r1;
    auto fetch = [&](int tl) {
        const int tk = tl / tilesN, tn = tl - tk * tilesN, n = tn * 64 + c4, k0 = tk * 64 + kr;
        r0 = (f32x4){0.f, 0.f, 0.f, 0.f}; r1 = r0;
        if (n < N) { r0 = __builtin_nontemporal_load((const f32x4*)(src + (size_t)k0 * N + n)); r1 = __builtin_nontemporal_load((const f32x4*)(src + (size_t)(k0 + 32) * N + n)); }
        if (kscale) { r0 = r0 * kscale[k0]; r1 = r1 * kscale[k0 + 32]; }
    };
    if (start < nt) fetch(start);
    for (int tl = start; tl < nt; tl += vcnt) {
        const int tk = tl / tilesN, tn = tl - tk * tilesN;
        { LAS float* tp = tile + kr * 65 + c4; tp[0] = r0[0]; tp[1] = r0[1]; tp[2] = r0[2]; tp[3] = r0[3];
          tp += 32 * 65; tp[0] = r1[0]; tp[1] = r1[1]; tp[2] = r1[2]; tp[3] = r1[3]; }
        if (tl + vcnt < nt) fetch(tl + vcnt);
        __syncthreads();
        { const int nl = tid >> 3, k8 = (tid & 7) * 8, n = tn * 64 + nl;
          if (n < N) { float f[8];
#pragma unroll
              for (int j = 0; j < 8; ++j) f[j] = tile[(k8 + j) * 65 + nl];
              u32x4 w; w.x = pk2(f[0], f[1]); w.y = pk2(f[2], f[3]); w.z = pk2(f[4], f[5]); w.w = pk2(f[6], f[7]);
              int drow = n;
              if (mode == 1) { const int i = n < DFF ? n : n - DFF, role = n < DFF ? 0 : 1;
                  drow = (i >> 7) * 256 + ((i >> 2) & 1) * 128 + ((i & 127) >> 3) * 8 + (i & 3) * 2 + role; }
              else if (mode == 2) { const int h = n / 96, o = n - h * 96, q = o - 64; if (o >= 64) drow = h * 96 + 64 + 2 * ((q >> 4) * 8 + (q & 7)) + ((q >> 3) & 1); }
              else if (mode == 3) { if (n >= O_KR && n < O_DQ) { const int q = n - O_KR; drow = O_KR + 2 * ((q >> 4) * 8 + (q & 7)) + ((q >> 3) & 1); }
                                    else if (n >= O_DQ && n < O_DV) { const int o = (n - O_DQ) & 63; drow = n - o + 2 * ((o >> 5) * 16 + (o & 15)) + ((o >> 4) & 1); } }
              *(u32x4*)(dst + (size_t)drow * ldd + koff + tk * 64 + k8) = w; } }
        __syncthreads();
    }
}
DI void conv_weights(const Params& p, int l, LAS unsigned char* ldsb, bf16_t* W, int vid, int vcnt) {
    LAS float* tile = (LAS float*)ldsb;
    convT(p.in[7] + (size_t)l * 1024 * 5632, 1024, 5632, W + W_1U, 1, nullptr, tile, 0, vid, vcnt);
    convT(p.in[8] + (size_t)l * 2816 * 1024, 2816, 1024, W + W_1D, 0, nullptr, tile, 128, vid, vcnt);
    convT(p.in[9] + (size_t)l * 1024 * 5632, 1024, 5632, W + W_2U, 1, nullptr, tile, 64, vid, vcnt);
    convT(p.in[10] + (size_t)l * 2816 * 1024, 2816, 1024, W + W_2D, 0, nullptr, tile, 192, vid, vcnt);
    convT(p.in[11] + (size_t)l * 1024 * INW, 1024, INW, W + W_IN, 3, nullptr, tile, 32, vid, vcnt);
    convT(p.in[13] + (size_t)l * 384 * 768, 384, 768, W + W_UQ, 2, p.in[12] + l * 384, tile, 160, vid, vcnt);
    convT(p.in[15] + (size_t)l * 256 * 1024, 256, 1024, W + W_UKV, 0, p.in[14] + l * 256, tile, 232, vid, vcnt);
    for (int n = 0; n < 3; ++n) convT(p.in[23] + ((size_t)l * 3 + n) * 512 * 1024, 512, 1024, W + W_BR, 0, nullptr, tile, 40 + n * 72, vid, vcnt, 1536, n * 512);
    convT(p.in[24] + (size_t)l * 1024 * 1024, 1024, 1024, W + W_O, 0, nullptr, tile, 96, vid, vcnt);
    { u32x4* z = (u32x4*)(W + W_IN + (size_t)INW * 1024); const int nz = (INWP - INW) * 1024 / 8;
      for (int i = vid * 512 + tidx(); i < nz; i += vcnt * 512) z[i] = (u32x4){0u, 0u, 0u, 0u}; }
}

DI void norm_phase(const float* sl, const float* sc_, float* dl, float* dc, bool copy, bf16_t* H, const float* g, const float* modl, int shift_i, int scale_i, int Mrows, const float* part, int npart) {
    const int tid_ = tidx(), lane = tid_ & 63, gw = blockIdx.x * 8 + (tid_ >> 6), nw = gridDim.x * 8;
    constexpr int R = 5;
    for (int row0 = gw; row0 < Mrows; row0 += R * nw) {
        f32x4 v[R][4]; float ss[R]; bool ok[R];
#pragma unroll
        for (int r = 0; r < R; ++r) { int row = row0 + r * nw; ok[r] = row < Mrows; row = ok[r] ? row : Mrows - 1;
            const float* src = row < ML ? sl + (size_t)row * D : sc_ + (size_t)(row - ML) * D;
#pragma unroll
            for (int i = 0; i < 4; ++i) v[r][i] = *(const f32x4*)(src + ((i >> 1) * 512 + lane * 8 + (i & 1) * 4)); }
#pragma unroll
        for (int r = 0; r < R; ++r) { const int row = row0 + r * nw;
            if (ok[r] && npart > 0 && row >= ML) {
                f32x4 pv[4][4];
#pragma unroll
                for (int j = 0; j < 4; ++j) { const float* pp = part + (size_t)j * MC * D + (size_t)(row - ML) * D;
#pragma unroll
                    for (int i = 0; i < 4; ++i) pv[j][i] = *(const f32x4*)(pp + ((i >> 1) * 512 + lane * 8 + (i & 1) * 4)); }
#pragma unroll
                for (int j = 0; j < 4; ++j)
#pragma unroll
                    for (int i = 0; i < 4; ++i) v[r][i] = v[r][i] + pv[j][i]; }
            float s = 0.f;
#pragma unroll
            for (int i = 0; i < 4; ++i) s += v[r][i][0] * v[r][i][0] + v[r][i][1] * v[r][i][1] + v[r][i][2] * v[r][i][2] + v[r][i][3] * v[r][i][3];
            ss[r] = s; }
#pragma unroll
        for (int o = 32; o > 0; o >>= 1) {
#pragma unroll
            for (int r = 0; r < R; ++r) ss[r] += __shfl_xor(ss[r], o); }
#pragma unroll
        for (int r = 0; r < R; ++r) { const int row = row0 + r * nw;
            if (!ok[r]) continue;
            const int bi = row < ML ? (row >> 11) : 8;
            const float rstd = rsqrtf(ss[r] * (1.0f / 1024.0f) + EPS);
            const float* mb = modl + (size_t)bi * 9216;
#pragma unroll
            for (int ip = 0; ip < 2; ++ip) { const int col = ip * 512 + lane * 8;
                f32x4 h[2];
#pragma unroll
                for (int q = 0; q < 2; ++q) { const int c = col + q * 4;
                    const f32x4 gg = *(const f32x4*)(g + c), scv = *(const f32x4*)(mb + scale_i * 1024 + c), shv = *(const f32x4*)(mb + shift_i * 1024 + c);
                    h[q] = v[r][2 * ip + q] * rstd * gg * (scv + 1.0f) + shv; }
                u32x4 w; w.x = pk2(h[0][0], h[0][1]); w.y = pk2(h[0][2], h[0][3]); w.z = pk2(h[1][0], h[1][1]); w.w = pk2(h[1][2], h[1][3]);
                *(u32x4*)(H + (size_t)row * D + col) = w; }
            if (copy || (npart > 0 && row >= ML)) { float* dst = row < ML ? dl + (size_t)row * D : dc + (size_t)(row - ML) * D;
#pragma unroll
                for (int i = 0; i < 4; ++i) *(f32x4*)(dst + ((i >> 1) * 512 + lane * 8 + (i & 1) * 4)) = v[r][i]; }
        }
    }
}

template <int NV> DI void load_bf16_row(const bf16_t* src, float* v, float mul) {
#pragma unroll
    for (int i = 0; i < NV / 8; ++i) { const u32x4 w = *(const u32x4*)(src + i * 8);
        v[i * 8 + 0] = bflo(w.x) * mul; v[i * 8 + 1] = bfhi(w.x) * mul; v[i * 8 + 2] = bflo(w.y) * mul; v[i * 8 + 3] = bfhi(w.y) * mul;
        v[i * 8 + 4] = bflo(w.z) * mul; v[i * 8 + 5] = bfhi(w.z) * mul; v[i * 8 + 6] = bflo(w.w) * mul; v[i * 8 + 7] = bfhi(w.w) * mul; }
}
template <int NV> DI void store_bf16_row(bf16_t* dst, const float* v) {
#pragma unroll
    for (int i = 0; i < NV / 8; ++i) { u32x4 w; w.x = pk2(v[i * 8], v[i * 8 + 1]); w.y = pk2(v[i * 8 + 2], v[i * 8 + 3]); w.z = pk2(v[i * 8 + 4], v[i * 8 + 5]); w.w = pk2(v[i * 8 + 6], v[i * 8 + 7]);
        *(u32x4*)(dst + i * 8) = w; }
}
template <int NV> DI float sumsq_row(const bf16_t* src, float mul) {
    float ss = 0.f;
#pragma unroll
    for (int i = 0; i < NV / 8; ++i) { const u32x4 w = *(const u32x4*)(src + i * 8); const unsigned ww[4] = {w.x, w.y, w.z, w.w};
#pragma unroll
        for (int j = 0; j < 4; ++j) { const float a = bflo(ww[j]) * mul, b = bfhi(ww[j]) * mul; ss += a * a; ss += b * b; } }
    return ss;
}
template <int NV> DI void emit_plain(const bf16_t* src, float mul, const LAS float* g, bf16_t* dst) {
#pragma unroll 2
    for (int i = 0; i < NV / 8; ++i) { const u32x4 w = *(const u32x4*)(src + i * 8); const unsigned ww[4] = {w.x, w.y, w.z, w.w}; unsigned o[4];
#pragma unroll
        for (int j = 0; j < 4; ++j) o[j] = pk2(bflo(ww[j]) * mul * g[i * 8 + 2 * j], bfhi(ww[j]) * mul * g[i * 8 + 2 * j + 1]);
        u32x4 ov; ov.x = o[0]; ov.y = o[1]; ov.z = o[2]; ov.w = o[3]; *(u32x4*)(dst + i * 8) = ov; }
}
template <int QF> DI void emit_rope_axis(const bf16_t* src, float mul, const LAS float* g, const float* cp, const float* sp, bf16_t* dst) {
    float v[2 * QF];
#pragma unroll
    for (int i = 0; i < QF / 4; ++i) { const u32x4 w = *(const u32x4*)(src + i * 8); const unsigned ww[4] = {w.x, w.y, w.z, w.w};
#pragma unroll
        for (int j = 0; j < 4; ++j) { v[i * 8 + 2 * j] = bflo(ww[j]) * mul * g[i * 8 + 2 * j]; v[i * 8 + 2 * j + 1] = bfhi(ww[j]) * mul * g[i * 8 + 2 * j + 1]; } }
    if (cp) {
#pragma unroll
        for (int f = 0; f < QF; ++f) { const float c = cp[f], s = sp[f], x1 = v[f], x2 = v[QF + f]; v[f] = x1 * c - x2 * s; v[QF + f] = x2 * c + x1 * s; }
    }
#pragma unroll
    for (int i = 0; i < QF / 4; ++i) { u32x4 ov; ov.x = pk2(v[i * 8], v[i * 8 + 1]); ov.y = pk2(v[i * 8 + 2], v[i * 8 + 3]); ov.z = pk2(v[i * 8 + 4], v[i * 8 + 5]); ov.w = pk2(v[i * 8 + 6], v[i * 8 + 7]); *(u32x4*)(dst + i * 8) = ov; }
}
DI float sumsq8(u32x4 w) { const unsigned ww[4] = {w.x, w.y, w.z, w.w}; float ss = 0.f;
#pragma unroll
    for (int j = 0; j < 4; ++j) { const float a = bflo(ww[j]), b = bfhi(ww[j]); ss += a * a; ss += b * b; }
    return ss; }
DI void unpack8(u32x4 w, float* v, float mul) { const unsigned ww[4] = {w.x, w.y, w.z, w.w};
#pragma unroll
    for (int j = 0; j < 4; ++j) { v[2 * j] = bflo(ww[j]) * mul; v[2 * j + 1] = bfhi(ww[j]) * mul; } }
DI u32x4 pack8(const float* v) { u32x4 o; o.x = pk2(v[0], v[1]); o.y = pk2(v[2], v[3]); o.z = pk2(v[4], v[5]); o.w = pk2(v[6], v[7]); return o; }
DI float red8(float v) { v += __shfl_xor(v, 1); v += __shfl_xor(v, 2); v += __shfl_xor(v, 4); return v; }

DI void prep_body(const Params& p, int l, LAS unsigned char* ldsb,
                  const bf16_t* __restrict__ PROJ, const bf16_t* __restrict__ QRAW, const bf16_t* __restrict__ KVRAW,
                  bf16_t* __restrict__ QM, bf16_t* __restrict__ KM, bf16_t* __restrict__ VTM, bf16_t* __restrict__ QD, bf16_t* __restrict__ KD, bf16_t* __restrict__ VTD, bf16_t* __restrict__ Y2,
                  const float* __restrict__ TABM, const float* __restrict__ TABD, const float* __restrict__ cw) {
    const int tid = tidx(), wid = tid >> 6, lane = tid & 63, hd = lane >> 3, s = lane & 7;
    const float qsm = 0.10206207261596577f * LOG2E, qsd = 0.125f * LOG2E;
    LAS float* gl = (LAS float*)ldsb;
    if (tid < 96) { const int q = tid - 64, pp = q >> 1, hh = q & 1; const int orig = tid < 64 ? tid : 64 + 16 * (pp >> 3) + 8 * hh + (pp & 7);
        gl[tid] = p.in[16][l * 96 + orig]; gl[96 + tid] = p.in[17][l * 96 + orig]; }
    if (tid < 64) { const int pp = tid >> 1, hh = tid & 1, orig = 32 * (pp >> 4) + 16 * hh + (pp & 15);
        gl[192 + tid] = p.in[18][l * 64 + orig]; gl[256 + tid] = p.in[19][l * 64 + orig]; }
    __syncthreads();
    float gqn[8], gqr[4], gkn[8], gkr[4], gdq[8], gdk[8];
#pragma unroll
    for (int j = 0; j < 8; ++j) { gqn[j] = gl[8 * s + j]; gkn[j] = gl[96 + 8 * s + j]; gdq[j] = gl[192 + 8 * s + j]; gdk[j] = gl[256 + 8 * s + j]; }
#pragma unroll
    for (int j = 0; j < 4; ++j) { gqr[j] = gl[64 + 4 * s + j]; gkr[j] = gl[96 + 64 + 4 * s + j]; }
    __syncthreads();
    LAS unsigned char* Vl = ldsb;
#pragma unroll 1
    for (int item = blockIdx.x; item < 5 * (MT / 64); item += gridDim.x) {
        const int type = item / (MT / 64), blk = item - type * (MT / 64);
        const int r0 = blk * 64; int b, t0, spos0, seglen; bool latent;
        if (r0 < ML) { b = r0 >> 11; spos0 = r0 & 2047; t0 = 256 + spos0; latent = true; seglen = 2048; }
        else { const int rc = r0 - ML; b = rc >> 8; spos0 = rc & 255; t0 = spos0; latent = false; seglen = 256; }
        if (type == 0) {
#pragma unroll 1
            for (int kb4 = 0; kb4 < 8; kb4 += 4) {
                float s1[4], s2[4]; u32x4 wqn[4], wkn[4]; u32x2 wqr[4], wkr[4]; f32x2 cm[4], sm[4];
#pragma unroll
            for (int k = 0; k < 4; ++k) {
                const int tl = wid * 8 + kb4 + k, r = r0 + tl, t = t0 + tl, spos = spos0 + tl;
                const bf16_t* prow = PROJ + (size_t)r * INWP;
                s1[k] = sumsq8(*(const u32x4*)(prow + O_CQ + (lane < 48 ? lane : 0) * 8)); s1[k] = lane < 48 ? s1[k] : 0.f;
                s2[k] = sumsq8(*(const u32x4*)(prow + O_CKV + (lane < 32 ? lane : 0) * 8)); s2[k] = lane < 32 ? s2[k] : 0.f;
                wqn[k] = *(const u32x4*)(QRAW + (size_t)r * 768 + hd * 96 + 8 * s);
                wqr[k] = *(const u32x2*)(QRAW + (size_t)r * 768 + hd * 96 + 64 + 4 * s);
                wkn[k] = *(const u32x4*)(KVRAW + (size_t)r * 1024 + hd * 128 + 8 * s);
                wkr[k] = *(const u32x2*)(prow + O_KR + 4 * s);
                cm[k] = *(const f32x2*)(TABM + (latent ? spos : 0) * 32 + 2 * s); sm[k] = *(const f32x2*)(TABM + (latent ? spos : 0) * 32 + 16 + 2 * s);
                cm[k][0] = latent ? cm[k][0] : 1.f; cm[k][1] = latent ? cm[k][1] : 1.f; sm[k][0] = latent ? sm[k][0] : 0.f; sm[k][1] = latent ? sm[k][1] : 0.f;
            }
#pragma unroll
            for (int k = 0; k < 4; ++k) {
                const int tl = wid * 8 + kb4 + k, r = r0 + tl, t = t0 + tl; (void)r;
                s1[k] = wave_sum(s1[k]); s2[k] = wave_sum(s2[k]);
                const float rcq = rsqrtf(s1[k] * (1.0f / 384.0f) + EPS), rckv = rsqrtf(s2[k] * (1.0f / 256.0f) + EPS);
                { float vn[8], vr[4]; unpack8(wqn[k], vn, rcq); vr[0] = bflo(wqr[k].x) * rcq; vr[1] = bfhi(wqr[k].x) * rcq; vr[2] = bflo(wqr[k].y) * rcq; vr[3] = bfhi(wqr[k].y) * rcq;
                  float ss = vr[0] * vr[0] + vr[1] * vr[1] + vr[2] * vr[2] + vr[3] * vr[3];
#pragma unroll
                  for (int j = 0; j < 8; ++j) ss += vn[j] * vn[j];
                  ss = red8(ss); const float mul = rsqrtf(ss * (1.0f / 96.0f) + EPS) * qsm;
#pragma unroll
                  for (int j = 0; j < 8; ++j) vn[j] *= mul * gqn[j];
#pragma unroll
                  for (int j = 0; j < 4; ++j) vr[j] *= mul * gqr[j];
                  const float a0 = vr[0] * cm[k][0] - vr[1] * sm[k][0], a1 = vr[1] * cm[k][0] + vr[0] * sm[k][0], a2 = vr[2] * cm[k][1] - vr[3] * sm[k][1], a3 = vr[3] * cm[k][1] + vr[2] * sm[k][1];
                  bf16_t* d = QM + ((size_t)(b * 8 + hd) * TT + t) * 96;
                  *(u32x4*)(d + 8 * s) = pack8(vn); u32x2 o; o.x = pk2(a0, a1); o.y = pk2(a2, a3); *(u32x2*)(d + 64 + 4 * s) = o; }
                { float vn[8], vr[4]; unpack8(wkn[k], vn, rckv); vr[0] = bflo(wkr[k].x); vr[1] = bfhi(wkr[k].x); vr[2] = bflo(wkr[k].y); vr[3] = bfhi(wkr[k].y);
                  float ss = vr[0] * vr[0] + vr[1] * vr[1] + vr[2] * vr[2] + vr[3] * vr[3];
#pragma unroll
                  for (int j = 0; j < 8; ++j) ss += vn[j] * vn[j];
                  ss = red8(ss); const float mul = rsqrtf(ss * (1.0f / 96.0f) + EPS);
#pragma unroll
                  for (int j = 0; j < 8; ++j) vn[j] *= mul * gkn[j];
#pragma unroll
                  for (int j = 0; j < 4; ++j) vr[j] *= mul * gkr[j];
                  const float a0 = vr[0] * cm[k][0] - vr[1] * sm[k][0], a1 = vr[1] * cm[k][0] + vr[0] * sm[k][0], a2 = vr[2] * cm[k][1] - vr[3] * sm[k][1], a3 = vr[3] * cm[k][1] + vr[2] * sm[k][1];
                  bf16_t* d = KM + ((size_t)(b * 8 + hd) * TT + t) * 96;
                  *(u32x4*)(d + 8 * s) = pack8(vn); u32x2 o; o.x = pk2(a0, a1); o.y = pk2(a2, a3); *(u32x2*)(d + 64 + 4 * s) = o; }
            }
            }
        } else if (type == 1) {
#pragma unroll 1
            for (int kb4 = 0; kb4 < 8; kb4 += 4) {
                u32x4 wdq[4], wdk[4]; f32x4 cd[4], sd[4];
#pragma unroll
                for (int k = 0; k < 4; ++k) { const int tl = wid * 8 + kb4 + k, r = r0 + tl, spos = spos0 + tl;
                    const bf16_t* prow = PROJ + (size_t)r * INWP;
                    wdq[k] = *(const u32x4*)(prow + O_DQ + lane * 8); wdk[k] = *(const u32x4*)(prow + O_DK + lane * 8);
                    cd[k] = *(const f32x4*)(TABD + (latent ? spos : 0) * 64 + 4 * s); sd[k] = *(const f32x4*)(TABD + (latent ? spos : 0) * 64 + 32 + 4 * s); }
#pragma unroll
                for (int k = 0; k < 4; ++k) { const int tl = wid * 8 + kb4 + k, t = t0 + tl;
#pragma unroll
                    for (int j = 0; j < 4; ++j) { cd[k][j] = latent ? cd[k][j] : 1.f; sd[k][j] = latent ? sd[k][j] : 0.f; }
#pragma unroll
                    for (int qk = 0; qk < 2; ++qk) { float v[8]; unpack8(qk ? wdk[k] : wdq[k], v, 1.0f); float ss = 0.f;
#pragma unroll
                      for (int j = 0; j < 8; ++j) ss += v[j] * v[j];
                      ss = red8(ss); const float mul = rsqrtf(ss * (1.0f / 64.0f) + EPS) * (qk ? 1.0f : qsd);
#pragma unroll
                      for (int j = 0; j < 8; ++j) v[j] *= mul * (qk ? gdk[j] : gdq[j]);
                      float o[8];
#pragma unroll
                      for (int jj = 0; jj < 4; ++jj) { o[2 * jj] = v[2 * jj] * cd[k][jj] - v[2 * jj + 1] * sd[k][jj]; o[2 * jj + 1] = v[2 * jj + 1] * cd[k][jj] + v[2 * jj] * sd[k][jj]; }
                      bf16_t* d = (qk ? KD : QD) + ((size_t)(b * 8 + hd) * TT + t) * 64 + 8 * s;
                      *(u32x4*)d = pack8(o); }
                }
            }
        } else if (type < 4) {
#pragma unroll 4
            for (int k = 0; k < 8; ++k) {
                const int tl = wid * 8 + k, r = r0 + tl;
                const bf16_t* prow = PROJ + (size_t)r * INWP;
                const bool mla = (type == 2);
                float s2 = sumsq8(*(const u32x4*)(prow + O_CKV + (lane < 32 ? lane : 0) * 8)); s2 = lane < 32 ? s2 : 0.f;
                const bf16_t* wsrc = mla ? KVRAW + (size_t)r * 1024 + hd * 128 + 64 + 8 * s : prow + O_DV + lane * 8;
                const u32x4 w = *(const u32x4*)wsrc;
                s2 = wave_sum(s2); const float sc = mla ? rsqrtf(s2 * (1.0f / 256.0f) + EPS) : 1.0f;
                float v[8]; unpack8(w, v, sc);
                const u32x4 o = pack8(v); const unsigned ow[4] = {o.x, o.y, o.z, o.w};
                LAS bf16_t* dl = (LAS bf16_t*)(Vl + (size_t)(hd * 64 + 8 * s) * 144) + tl;
#pragma unroll
                for (int j = 0; j < 4; ++j) { dl[(2 * j) * 72] = (bf16_t)(ow[j] & 0xffffu); dl[(2 * j + 1) * 72] = (bf16_t)(ow[j] >> 16); }
            }
            __syncthreads();
            { bf16_t* VT = type == 2 ? VTM : VTD;
#pragma unroll
              for (int kk = 0; kk < 8; ++kk) { const int row = (tid >> 3) + 64 * kk, ch = tid & 7;
                  const u32x4 w = *(LAS const u32x4*)(Vl + row * 144 + ch * 16);
                  *(u32x4*)(VT + ((size_t)(b * 512 + row) * TT + t0 + ch * 8)) = w; } }
            __syncthreads();
        } else {
            float w0[8], w1[8], w2[8];
            { const f32x4 a = *(const f32x4*)(cw + lane * 8), a2 = *(const f32x4*)(cw + lane * 8 + 4), b1 = *(const f32x4*)(cw + 512 + lane * 8), b2 = *(const f32x4*)(cw + 512 + lane * 8 + 4),
                          c1 = *(const f32x4*)(cw + 1024 + lane * 8), c2 = *(const f32x4*)(cw + 1024 + lane * 8 + 4);
#pragma unroll
              for (int j = 0; j < 4; ++j) { w0[j] = a[j]; w0[4 + j] = a2[j]; w1[j] = b1[j]; w1[4 + j] = b2[j]; w2[j] = c1[j]; w2[4 + j] = c2[j]; } }
            const int rf = r0 + wid * 8, sf = spos0 + wid * 8;
            const bf16_t* pb = PROJ + (size_t)rf * INWP + lane * 8;
            float up[8], uc[8];
#pragma unroll
            for (int j = 0; j < 8; ++j) up[j] = 0.f;
            { const bool hasp = sf > 0; const bf16_t* pp = hasp ? pb - (size_t)INWP : pb;
              float a[8], c[8]; unpack8(*(const u32x4*)(pp + O_CC), a, 1.0f); unpack8(*(const u32x4*)(pp + O_CX), c, 1.0f);
#pragma unroll
              for (int j = 0; j < 8; ++j) up[j] = hasp ? a[j] * c[j] : 0.f; }
            { float a[8], c[8]; unpack8(*(const u32x4*)(pb + O_CC), a, 1.0f); unpack8(*(const u32x4*)(pb + O_CX), c, 1.0f);
#pragma unroll
              for (int j = 0; j < 8; ++j) uc[j] = a[j] * c[j]; }
#pragma unroll
            for (int k = 0; k < 8; ++k) { const bf16_t* q = pb + (size_t)k * INWP;
                float un[8];
                { const bool hasn = sf + k + 1 < seglen; const bf16_t* qn = hasn ? q + INWP : q;
                  float a[8], c[8]; unpack8(*(const u32x4*)(qn + O_CC), a, 1.0f); unpack8(*(const u32x4*)(qn + O_CX), c, 1.0f);
#pragma unroll
                  for (int j = 0; j < 8; ++j) un[j] = hasn ? a[j] * c[j] : 0.f; }
                float cb[8]; unpack8(*(const u32x4*)(q + O_CB), cb, 1.0f);
                float y[8];
#pragma unroll
                for (int j = 0; j < 8; ++j) y[j] = cb[j] * (w0[j] * up[j] + w1[j] * uc[j] + w2[j] * un[j]);
                *(u32x4*)(Y2 + (size_t)(rf + k) * 1536 + lane * 8) = pack8(y);
#pragma unroll
                for (int j = 0; j < 8; ++j) { up[j] = uc[j]; uc[j] = un[j]; } }
        }
    }
}

DI void prep_phase(const Params& p, int l, LAS unsigned char* ldsb) {
    const float* TABM = (const float*)(p.ws + WS_TAB);
    prep_body(p, l, ldsb, (const bf16_t*)(p.ws + WS_PROJ), (const bf16_t*)(p.ws + WS_R1), (const bf16_t*)(p.ws + WS_R1 + R1_KVRAW),
              (bf16_t*)(p.ws + WS_QKV + Q_QM), (bf16_t*)(p.ws + WS_QKV + Q_KM), (bf16_t*)(p.ws + WS_QKV + Q_VTM), (bf16_t*)(p.ws + WS_QKV + Q_QD), (bf16_t*)(p.ws + WS_QKV + Q_KD), (bf16_t*)(p.ws + WS_QKV + Q_VTD),
              (bf16_t*)(p.ws + WS_Y) + 1024, TABM, TABM + 2048 * 32, p.in[22] + (size_t)l * 3 * 512);
}

template <int KC, int DS, bool DIFF>
DI void attn_item(LAS unsigned char* lds, const bf16_t* Qw  , const bf16_t* K0, const bf16_t* K1, const bf16_t* Vt, int nkeys, float cshift,
                  f32x4 (&oacc)[DS][2], float (&lsum)[2]) {
    constexpr int DK = KC * 32, KROW = DK * 2 + 32, VROW = 160, DV = DS * 16;
    constexpr int KBYTES = (DIFF ? 2 : 1) * 64 * KROW, STG = KBYTES + DV * VROW;
    const int tid = tidx(), wid = tid >> 6, lane = tid & 63, fr = lane & 15, fq = lane >> 4;
    const int comp = DIFF ? (wid >> 2) : 0;
    const int vpos = (((tid & 7) >> 2) * 32 + (tid & 1) * 16 + ((tid >> 1) & 1) * 4) * 2;
    bf16x8 qf[2][KC];
#pragma unroll
    for (int qs = 0; qs < 2; ++qs)
#pragma unroll
        for (int kc = 0; kc < KC; ++kc) qf[qs][kc] = *(const bf16x8*)(Qw + (size_t)(qs * 16 + fr) * DK + kc * 32 + fq * 8);
#pragma unroll
    for (int ds = 0; ds < DS; ++ds) { oacc[ds][0] = (f32x4){0.f, 0.f, 0.f, 0.f}; oacc[ds][1] = (f32x4){0.f, 0.f, 0.f, 0.f}; }
    lsum[0] = 0.f; lsum[1] = 0.f;
    u32x4 rk0, rk1, rv0, rv1;
    auto gload = [&](int t) {
        if constexpr (!DIFF) {
            const char* kb = (const char*)K0 + (size_t)t * 64 * DK * 2;
            rk0 = *(const u32x4*)(kb + tid * 16);
            if (tid < 256) rk1 = *(const u32x4*)(kb + (512 + tid) * 16);
            rv0 = *(const u32x4*)((const char*)Vt + (size_t)(tid >> 3) * TT * 2 + (size_t)t * 128 + (tid & 7) * 16);
        } else {
            rk0 = *(const u32x4*)((const char*)K0 + (size_t)t * 64 * DK * 2 + tid * 16);
            rk1 = *(const u32x4*)((const char*)K1 + (size_t)t * 64 * DK * 2 + tid * 16);
            rv0 = *(const u32x4*)((const char*)Vt + (size_t)(tid >> 3) * TT * 2 + (size_t)t * 128 + (tid & 7) * 16);
            rv1 = *(const u32x4*)((const char*)Vt + (size_t)(64 + (tid >> 3)) * TT * 2 + (size_t)t * 128 + (tid & 7) * 16);
        }
    };
    auto lstore = [&](int st) {
        LAS unsigned char* kb = lds + st * STG; LAS unsigned char* vb = kb + KBYTES;
        if constexpr (!DIFF) {
            { const int key = tid / 12, pc = tid - key * 12; *(LAS u32x4*)(kb + key * KROW + pc * 16) = rk0; }
            if (tid < 256) { const int c = 512 + tid, key = c / 12, pc = c - key * 12; *(LAS u32x4*)(kb + key * KROW + pc * 16) = rk1; }
            { LAS unsigned char* d = vb + (tid >> 3) * VROW + vpos; *(LAS u32x2*)d = (u32x2){rv0.x, rv0.y}; *(LAS u32x2*)(d + 16) = (u32x2){rv0.z, rv0.w}; }
        } else {
            *(LAS u32x4*)(kb + (tid >> 3) * KROW + (tid & 7) * 16) = rk0;
            *(LAS u32x4*)(kb + 64 * KROW + (tid >> 3) * KROW + (tid & 7) * 16) = rk1;
            { LAS unsigned char* d = vb + (tid >> 3) * VROW + vpos; *(LAS u32x2*)d = (u32x2){rv0.x, rv0.y}; *(LAS u32x2*)(d + 16) = (u32x2){rv0.z, rv0.w}; }
            { LAS unsigned char* d = vb + (64 + (tid >> 3)) * VROW + vpos; *(LAS u32x2*)d = (u32x2){rv1.x, rv1.y}; *(LAS u32x2*)(d + 16) = (u32x2){rv1.z, rv1.w}; }
        }
    };
    auto readK = [&](int st, int kk, bf16x8 (&kf)[2][KC]) {
        LAS const unsigned char* kb = lds + st * STG + comp * 64 * KROW;
#pragma unroll
        for (int kc = 0; kc < KC; ++kc)
#pragma unroll
            for (int ks = 0; ks < 2; ++ks) kf[ks][kc] = *(LAS const bf16x8*)(kb + ((2 * kk + ks) * 16 + fr) * KROW + (kc * 32 + fq * 8) * 2);
    };
    auto readV = [&](int st, int kk, int d0, bf16x8 (&vf)[4]) {
        LAS const unsigned char* vb = lds + st * STG + KBYTES;
#pragma unroll
        for (int i = 0; i < 4; ++i) vf[i] = *(LAS const bf16x8*)(vb + ((d0 + i) * 16 + fr) * VROW + (kk * 32 + fq * 8) * 2);
    };
    auto smma = [&](const bf16x8 (&kf)[2][KC], f32x4 (&sacc)[2][2]) {
#pragma unroll
        for (int ks = 0; ks < 2; ++ks) { sacc[ks][0] = (f32x4){-cshift, -cshift, -cshift, -cshift}; sacc[ks][1] = (f32x4){-cshift, -cshift, -cshift, -cshift}; }
#pragma unroll
        for (int kc = 0; kc < KC; ++kc)
#pragma unroll
            for (int ks = 0; ks < 2; ++ks)
#pragma unroll
                for (int qs = 0; qs < 2; ++qs) sacc[ks][qs] = __builtin_amdgcn_mfma_f32_16x16x32_bf16(kf[ks][kc], qf[qs][kc], sacc[ks][qs], 0, 0, 0);
    };
    auto softmax = [&](const f32x4 (&sacc)[2][2], bf16x8 (&pb)[2]) {
#pragma unroll
        for (int qs = 0; qs < 2; ++qs) {
            float e[8];
#pragma unroll
            for (int j = 0; j < 4; ++j) { e[j] = __builtin_amdgcn_exp2f(sacc[0][qs][j]); e[4 + j] = __builtin_amdgcn_exp2f(sacc[1][qs][j]); }
            lsum[qs] += ((e[0] + e[1]) + (e[2] + e[3])) + ((e[4] + e[5]) + (e[6] + e[7]));
            u32x4 w; w.x = pk2(e[0], e[1]); w.y = pk2(e[2], e[3]); w.z = pk2(e[4], e[5]); w.w = pk2(e[6], e[7]);
            pb[qs] = __builtin_bit_cast(bf16x8, w);
        }
    };
    auto pv4 = [&](const bf16x8 (&vf)[4], int d0, const bf16x8 (&pb)[2]) {
#pragma unroll
        for (int i = 0; i < 4; ++i)
#pragma unroll
            for (int qs = 0; qs < 2; ++qs) oacc[d0 + i][qs] = __builtin_amdgcn_mfma_f32_16x16x32_bf16(vf[i], pb[qs], oacc[d0 + i][qs], 0, 0, 0);
    };
#define SB() __builtin_amdgcn_sched_barrier(0)
    const int ntiles = nkeys >> 6;
    if constexpr (!DIFF) {
        gload(0); lstore(0); gload(1); lstore(1);
        __syncthreads();
        f32x4 sA[2][2], sB[2][2]; bf16x8 pb[2]; bf16x8 kf[2][KC]; bf16x8 vf[4];
        readK(0, 0, kf); smma(kf, sA);
        int st = 0;
        auto iter = [&](auto m1c, auto m2c, int t) {
            constexpr bool m1 = decltype(m1c)::value, m2 = decltype(m2c)::value;
            const int st1 = (st == 2) ? 0 : st + 1, st2 = (st1 == 2) ? 0 : st1 + 1;
            if constexpr (m2) gload(t + 2);
            readK(st, 1, kf); readV(st, 0, 0, vf); SB();
            smma(kf, sB); softmax(sA, pb);
            pv4(vf, 0, pb); SB();
            if constexpr (m1) readK(st1, 0, kf);
            readV(st, 1, 0, vf); SB();
            if constexpr (m1) smma(kf, sA);
            softmax(sB, pb);
            pv4(vf, 0, pb); SB();
            if constexpr (m2) lstore(st2);
            __syncthreads();
            st = st1;
        };
#pragma unroll 1
        for (int t = 0; t + 2 < ntiles; ++t) iter(std::true_type{}, std::true_type{}, t);
        iter(std::true_type{}, std::false_type{}, ntiles - 2);
        iter(std::false_type{}, std::false_type{}, ntiles - 1);
    } else {
        gload(0); lstore(0);
        __syncthreads();
        f32x4 sA[2][2]; bf16x8 pb[2]; bf16x8 kf[2][KC]; bf16x8 vf[4], vg[4];
        auto iter = [&](auto morec, int t) {
            constexpr bool more = decltype(morec)::value;
            const int st = t & 1;
            if constexpr (more) gload(t + 1);
#pragma unroll
            for (int kk = 0; kk < 2; ++kk) {
                readK(st, kk, kf); readV(st, kk, 0, vf); SB();
                smma(kf, sA); softmax(sA, pb); readV(st, kk, 4, vg);
                pv4(vf, 0, pb);
                pv4(vg, 4, pb); SB();
            }
            if constexpr (more) lstore((t + 1) & 1);
            __syncthreads();
        };
#pragma unroll 1
        for (int t = 0; t + 1 < ntiles; ++t) iter(std::true_type{}, t);
        iter(std::false_type{}, ntiles - 1);
    }
#undef SB
#pragma unroll
    for (int qs = 0; qs < 2; ++qs) { lsum[qs] += __shfl_xor(lsum[qs], 16); lsum[qs] += __shfl_xor(lsum[qs], 32); }
}

DI void attn_phase(const Params& p, int l, bool need_ctx, LAS unsigned char* lds) {
    const int tid = tidx(), wid = tid >> 6, lane = tid & 63, fr = lane & 15, fq = lane >> 4;
    const bf16_t* QM = (const bf16_t*)(p.ws + WS_QKV + Q_QM); const bf16_t* KM = (const bf16_t*)(p.ws + WS_QKV + Q_KM); const bf16_t* VTM = (const bf16_t*)(p.ws + WS_QKV + Q_VTM);
    const bf16_t* QD = (const bf16_t*)(p.ws + WS_QKV + Q_QD); const bf16_t* KD = (const bf16_t*)(p.ws + WS_QKV + Q_KD); const bf16_t* VTD = (const bf16_t*)(p.ws + WS_QKV + Q_VTD);
    bf16_t* Y0 = (bf16_t*)(p.ws + WS_Y); bf16_t* Y1 = Y0 + 512;
    float gq = 0.f, gk = 0.f;
    { const float a = lane < 48 ? fmaxf(fabsf(p.in[16][l * 96 + lane]), fabsf(p.in[16][l * 96 + 48 + lane])) : 0.f; gq = wave_max(a);
      const float b = lane < 48 ? fmaxf(fabsf(p.in[17][l * 96 + lane]), fabsf(p.in[17][l * 96 + 48 + lane])) : 0.f; gk = wave_max(b); }
    const float cs_m = gq * gk * 9.797958971132712f * LOG2E;
    { gq = wave_max(fabsf(p.in[18][l * 64 + lane])); gk = wave_max(fabsf(p.in[19][l * 64 + lane])); }
    const float cs_d = gq * gk * 8.0f * LOG2E;
    const float li = lam_init_of(l);
    float lam;
    { const float* lv = p.in[20] + (size_t)l * 256; const float s1 = wave_sum(lv[lane] * lv[64 + lane]), s2 = wave_sum(lv[128 + lane] * lv[192 + lane]); lam = expf(s1) - expf(s2) + li; }
    const float* gsub = p.in[21] + l * 128;
    const int first = need_ctx ? 0 : 128;
    for (int item = first + blockIdx.x; item < 1152; item += gridDim.x) {
        if (item < 64 || (item >= 128 && item < 640)) {
            int bh, tq0, nkeys;
            if (item < 64) { bh = item; tq0 = 0; nkeys = 256; } else { const int i = item - 128; bh = (i >> 8) * 32 + (i & 31); tq0 = 256 + ((i >> 5) & 7) * 256; nkeys = TT; }
            const int b = bh >> 3, h = bh & 7;
            f32x4 oacc[4][2]; float lsum[2];
            attn_item<3, 4, false>(lds, QM + ((size_t)bh * TT + tq0 + wid * 32) * 96, KM + (size_t)bh * TT * 96, nullptr, VTM + (size_t)bh * 64 * TT, nkeys, cs_m, oacc, lsum);
#pragma unroll
            for (int qs = 0; qs < 2; ++qs) { const float inv = 1.0f / lsum[qs]; const int tq = tq0 + wid * 32 + qs * 16 + fr;
                const size_t row = tq >= 256 ? (size_t)b * 2048 + (tq - 256) : (size_t)ML + b * 256 + tq;
#pragma unroll
                for (int ds = 0; ds < 4; ++ds) { const f32x4 o = oacc[ds][qs] * inv; u32x2 w; w.x = pk2(o[0], o[1]); w.y = pk2(o[2], o[3]);
                    *(u32x2*)(Y0 + row * 1536 + h * 64 + ds * 16 + fq * 4) = w; } }
        } else {
            int bh, tq0, nkeys;
            if (item < 128) { const int i = item - 64; bh = i & 31; tq0 = (i >> 5) * 128; nkeys = 256; } else { const int i = item - 640; bh = (i >> 8) * 16 + (i & 15); tq0 = 256 + ((i >> 4) & 15) * 128; nkeys = TT; }
            const int b = bh >> 2, h = bh & 3, comp = wid >> 2, wq = wid & 3;
            f32x4 oacc[8][2]; float lsum[2];
            const size_t kvec = (size_t)(bh * 2) * TT * 64;
            attn_item<2, 8, true>(lds, QD + ((size_t)(bh * 2 + comp) * TT + tq0 + wq * 32) * 64, KD + kvec, KD + kvec + (size_t)TT * 64, VTD + (size_t)bh * 128 * TT, nkeys, cs_d, oacc, lsum);
            LAS float* X = (LAS float*)lds;
            if (comp == 1) {
#pragma unroll
                for (int qs = 0; qs < 2; ++qs) { const float sc = lam / lsum[qs]; const int ql = wq * 32 + qs * 16 + fr;
#pragma unroll
                    for (int ds = 0; ds < 8; ++ds) *(LAS f32x4*)(X + ql * 132 + ds * 16 + fq * 4) = oacc[ds][qs] * sc; }
            }
            __syncthreads();
            if (comp == 0) {
#pragma unroll
                for (int qs = 0; qs < 2; ++qs) { const float inv = 1.0f / lsum[qs]; const int ql = wq * 32 + qs * 16 + fr; const int tq = tq0 + ql;
                    float ss = 0.f;
#pragma unroll
                    for (int ds = 0; ds < 8; ++ds) { const f32x4 o2 = *(LAS const f32x4*)(X + ql * 132 + ds * 16 + fq * 4); const f32x4 o = oacc[ds][qs] * inv - o2; oacc[ds][qs] = o;
                        ss += o[0] * o[0] + o[1] * o[1] + o[2] * o[2] + o[3] * o[3]; }
                    ss += __shfl_xor(ss, 16); ss += __shfl_xor(ss, 32);
                    const float rs = rsqrtf(ss * (1.0f / 128.0f) + EPS) * (1.0f - li);
                    const size_t row = tq >= 256 ? (size_t)b * 2048 + (tq - 256) : (size_t)ML + b * 256 + tq;
#pragma unroll
                    for (int ds = 0; ds < 8; ++ds) { const f32x4 gg = *(const f32x4*)(gsub + ds * 16 + fq * 4); const f32x4 o = oacc[ds][qs] * rs * gg;
                        u32x2 w; w.x = pk2(o[0], o[1]); w.y = pk2(o[2], o[3]);
                        *(u32x2*)(Y1 + row * 1536 + h * 128 + ds * 16 + fq * 4) = w; } }
            }
            __syncthreads();
        }
    }
}

#define XB_TMO      128
#define XB_XCNT(j)  (256  + 64 * (j))
#define XB_XSUB(j)  (1280 + 64 * (j))
#define XB_XGEN(j)  (2304 + 64 * (j))
#define XB_TOP      3328
#define XB_TOPGEN   3392
#define XCD_BAR_WORDS 3456
#define XB_SPIN_CAP (1u << 18)
DI unsigned xb_ld(unsigned* p) { return __hip_atomic_load(p, __ATOMIC_RELAXED, __HIP_MEMORY_SCOPE_AGENT); }
DI unsigned xb_add(unsigned* p, unsigned v) { return __hip_atomic_fetch_add(p, v, __ATOMIC_RELAXED, __HIP_MEMORY_SCOPE_AGENT); }
DI unsigned xb_xcc_id() { return (unsigned)__builtin_amdgcn_s_getreg((3 << 11) | 20) & 0xFu; }
#define XB_SPIN(cond, bar) do { unsigned _sp = 0; while (cond) { __builtin_amdgcn_s_sleep(1); \
    if ((++_sp & 255u) == 0u) { if (xb_ld(&(bar)[XB_TMO])) break; if (_sp > XB_SPIN_CAP) { atomicAdd(&(bar)[XB_TMO], 1u); break; } } } } while (0)
struct XcdBarrier { unsigned* bar; unsigned x; volatile LAS unsigned* st; };
DI XcdBarrier xcd_barrier_post(unsigned* bar, volatile LAS unsigned* st) {
    XcdBarrier b; b.bar = bar; b.x = xb_xcc_id(); b.st = st;
    if (threadIdx.x == 0) (void)xb_add(&bar[XB_XCNT(b.x)], 1u);
    return b;
}
DI void xcd_barrier_complete(unsigned* bar, unsigned x, unsigned& nloc, unsigned& nx) {
    const unsigned G = gridDim.x * gridDim.y * gridDim.z;
    unsigned sum, cnt, mine, sp = 0u;
    for (;;) {
        sum = 0u; cnt = 0u; mine = 0u;
#pragma unroll
        for (unsigned j = 0; j < 16; ++j) { const unsigned c = xb_ld(&bar[XB_XCNT(j)]); sum += c; cnt += (c > 0u) ? 1u : 0u; mine = (j == x) ? c : mine; }
        if (sum == G) break;
        __builtin_amdgcn_s_sleep(1);
        if ((++sp & 255u) == 0u) { if (xb_ld(&bar[XB_TMO])) break; if (sp > XB_SPIN_CAP) { atomicAdd(&bar[XB_TMO], 1u); break; } }
    }
    nloc = mine > 0u ? mine : 1u; nx = cnt > 0u ? cnt : 1u;
}
DI void xcd_barrier(const XcdBarrier& b) {
    asm volatile("s_waitcnt vmcnt(0)" ::: "memory");
    __syncthreads();
    if (threadIdx.x == 0) {
        unsigned* bar = b.bar;
        __builtin_amdgcn_s_waitcnt(0);
        unsigned nloc = b.st[0], nx = b.st[1];
        if (nloc == 0u) { xcd_barrier_complete(bar, b.x, nloc, nx); b.st[0] = nloc; b.st[1] = nx; }
        const unsigned old = xb_add(&bar[XB_XSUB(b.x)], 1u);
        const unsigned gen = old / nloc;
        if (old + 1u == (gen + 1u) * nloc) {
            __builtin_amdgcn_fence(__ATOMIC_RELEASE, "agent");
            asm volatile("s_waitcnt vmcnt(0)" ::: "memory");
            const unsigned og = xb_add(&bar[XB_TOP], 1u);
            const unsigned tg = og / nx;
            if (og + 1u == (tg + 1u) * nx) xb_add(&bar[XB_TOPGEN], 1u);
            else XB_SPIN(xb_ld(&bar[XB_TOPGEN]) == tg, bar);
            __builtin_amdgcn_fence(__ATOMIC_ACQUIRE, "agent");
            xb_add(&bar[XB_XGEN(b.x)], 1u);
            asm volatile("s_waitcnt vmcnt(0)" ::: "memory");
        } else {
            XB_SPIN(xb_ld(&bar[XB_XGEN(b.x)]) == gen, bar);
            __builtin_amdgcn_fence(__ATOMIC_ACQUIRE, "agent");
            asm volatile("s_waitcnt vmcnt(0)" ::: "memory");
        }
    }
    __syncthreads();
}

#ifndef PROBE_MASK
#define PROBE_MASK 0
#endif
#define REPS(bit) for (int rep_ = 0; rep_ < (((PROBE_MASK) >> (bit)) & 1) + 1; ++rep_)
typedef const __attribute__((address_space(4))) Params* KP;
#define PH_BEGIN KP pp_ = (KP)__builtin_amdgcn_kernarg_segment_ptr(); asm volatile("" : "+s"(pp_)); const Params& p = *(const Params*)pp_; \
    int G = gridDim.x, c = blockIdx.x; asm volatile("" : "+s"(G), "+s"(c)); \
    float* XL = p.out; float* XC = (float*)(p.ws + WS_XC); const float* modl = (const float*)(p.ws + WS_MOD) + (size_t)l * 9 * 9216; const float* ng = p.in[6] + (size_t)l * 3 * 1024; \
    bf16_t* W = (bf16_t*)(p.ws + ((l & 1) ? WS_W2 : WS_W)); bf16_t* H = (bf16_t*)(p.ws + WS_R1); bf16_t* MB = H; bf16_t* QRAW = H; bf16_t* KVRAW = (bf16_t*)(p.ws + WS_R1 + R1_KVRAW); \
    bf16_t* PROJ = (bf16_t*)(p.ws + WS_PROJ); bf16_t* ACT = PROJ; float* MACC = (float*)(p.ws + WS_QKV); float* PART = MACC; bf16_t* Y = (bf16_t*)(p.ws + WS_Y); \
    (void)G; (void)c; (void)XL; (void)XC; (void)modl; (void)ng; (void)W; (void)H; (void)MB; (void)QRAW; (void)KVRAW; (void)PROJ; (void)ACT; (void)MACC; (void)Y; (void)PART;

__global__ void __launch_bounds__(512, 2) fwd_megakernel(Params p_unused) {
    extern __shared__ __attribute__((aligned(16))) unsigned char shm[];
    LAS unsigned char* lds = (LAS unsigned char*)shm;
    cg::grid_group grid = cg::this_grid();
    volatile LAS unsigned* xst = (volatile LAS unsigned*)(lds + pg8::STAGE_BYTES);
    if (threadIdx.x < 4) xst[threadIdx.x] = 0u;
    __syncthreads();
    XcdBarrier xb;
    { KP pp_ = (KP)__builtin_amdgcn_kernarg_segment_ptr(); xb = xcd_barrier_post((unsigned*)(pp_->ws + WS_BAR), xst); }
#define GSYNC() xcd_barrier(xb)

    REPS(6) { int l = 0; PH_BEGIN; mod_phase(p, lds); }
    { int l = 0; PH_BEGIN; tab_phase(p); }
    REPS(6) { int l = 0; PH_BEGIN; conv_weights(p, 0, lds, W, c, G); }
    grid.sync();

#pragma unroll 1
    for (int lq = 0; lq < DEPTH; ++lq) {
        int l = lq; asm volatile("" : "+s"(l));
        const bool last = (l == DEPTH - 1);
        const int Mx = last ? ML : MT;
        REPS(2) { PH_BEGIN; if (l == 0) norm_phase(p.in[0], p.in[2], XL, XC, true, H, ng, modl, 0, 1, MT, PART, 0); else norm_phase(XL, XC, XL, XC, false, H, ng, modl, 0, 1, MT, PART, 4); }
        GSYNC();
        REPS(1) { PH_BEGIN; pg8::Sched S; S.init(MT, 5632, 1024, G, c); pg8::Gemm g{H, W + W_1U, 1024, 1024}; EpiSwiglu E{ACT}; pg8::gemm_phase(lds, g, S, E); }
        GSYNC();
        { PH_BEGIN; pg8::Sched S; S.init(ML, 1024, DFF, G, c); S.add_split(MC / 256, ML / 256, 4); pg8::Gemm g{ACT, W + W_1D, DFF, DFF}; EpiResid E{XL, XC, modl, 2, 0.5f, PART}; pg8::gemm_phase(lds, g, S, E); }
        GSYNC();
        REPS(2) { PH_BEGIN; norm_phase(XL, XC, XL, XC, false, H, ng + 1024, modl, 3, 4, MT, PART, 4); }
        GSYNC();
        if (!last) { REPS(1) { PH_BEGIN; pg8::Sched S; S.init(MT, INWP, 1024, G, c); pg8::Gemm g{H, W + W_IN, 1024, 1024}; EpiStore E{PROJ, INWP, O_G}; pg8::gemm_phase(lds, g, S, E); } }
        else {
            { PH_BEGIN; pg8::Sched S; S.init(ML, INWP, 1024, G, c); pg8::Gemm g{H, W + W_IN, 1024, 1024}; EpiStore E{PROJ, INWP, O_G}; pg8::gemm_phase(lds, g, S, E); }
            { PH_BEGIN; pg8::Sched S; S.init(MC, 2048, 1024, G, (c + 64) % G); pg8::Gemm g{H + (size_t)ML * 1024, W + W_IN + (size_t)256 * 1024, 1024, 1024}; EpiStore E{PROJ + (size_t)ML * INWP + 256, INWP, 1 << 30}; pg8::gemm_phase(lds, g, S, E); }
        }
        GSYNC();
        REPS(2) { PH_BEGIN; pg8::Sched S; S.init(MT, 768, 384, G, c); pg8::Gemm g{PROJ + O_CQ, W + W_UQ, INWP, 384}; EpiStore E{QRAW, 768, 1 << 30}; pg8::gemm_phase(lds, g, S, E); }
        REPS(2) { PH_BEGIN; pg8::Sched S; S.init(MT, 1024, 256, G, (c + 40) % G); pg8::Gemm g{PROJ + O_CKV, W + W_UKV, INWP, 256}; EpiStore E{KVRAW, 1024, 1 << 30}; pg8::gemm_phase(lds, g, S, E); }
        GSYNC();
        REPS(2) { PH_BEGIN; prep_phase(p, l, lds); }
        GSYNC();
        REPS(0) { PH_BEGIN; attn_phase(p, l, !last, lds); }
        GSYNC();
        { PH_BEGIN; pg8::Sched S; S.init(Mx, 1024, 512, G, c, 3, 0, 0); S.kseg = 512; pg8::Gemm g{Y, W + W_BR, 1536, 1536}; EpiMerge E{MB, PROJ}; pg8::gemm_phase(lds, g, S, E);
          { int heavy = (MT / 256) * 4 - G; if (heavy < 0 || heavy >= G) heavy = 0;
            if (!last && c >= heavy) { bf16_t* Wn = (bf16_t*)(p.ws + (((l + 1) & 1) ? WS_W2 : WS_W)); conv_weights(p, l + 1, lds, Wn, c - heavy, G - heavy); } } }
        GSYNC();
        for (int r_ = 0; r_ < 6 * (((PROBE_MASK) >> 3) & 1); ++r_) GSYNC();
        { PH_BEGIN; pg8::Sched S; S.init(ML, 1024, 1024, G, c); if (!last) S.add_split(MC / 256, ML / 256, 4); pg8::Gemm g{MB, W + W_O, 1024, 1024}; EpiResid E{XL, XC, modl, 5, 1.0f, PART}; pg8::gemm_phase(lds, g, S, E); }
        GSYNC();
        REPS(2) { PH_BEGIN; norm_phase(XL, XC, XL, XC, false, H, ng + 2048, modl, 6, 7, Mx, PART, last ? 0 : 4); }
        GSYNC();
        REPS(1) { PH_BEGIN; pg8::Sched S; S.init(Mx, 5632, 1024, G, c); pg8::Gemm g{H, W + W_2U, 1024, 1024}; EpiSwiglu E{ACT}; pg8::gemm_phase(lds, g, S, E); }
        GSYNC();
        { PH_BEGIN; pg8::Sched S; S.init(ML, 1024, DFF, G, c); if (!last) S.add_split(MC / 256, ML / 256, 4); pg8::Gemm g{ACT, W + W_2D, DFF, DFF}; EpiResid E{XL, XC, modl, 8, 0.5f, PART}; pg8::gemm_phase(lds, g, S, E); }
        GSYNC();
    }
}

extern "C" void kernel_launch(void* const* d_in, const int* in_sizes, int n_in, void* d_out, int out_size, void* d_ws, size_t ws_size, hipStream_t stream) {
    constexpr int LDS_BYTES = pg8::STAGE_BYTES + 16;
    static int grid = 0;
    if (grid == 0) {
        if (n_in != 25 || ws_size < WS_END) { fprintf(stderr, "kernel_launch: bad inputs (n_in %d, ws %zu need %zu)\n", n_in, ws_size, (size_t)WS_END); grid = -1; return; }
        int dev = 0, cus = 0, per_cu = 0;
        hipGetDevice(&dev);
        hipDeviceGetAttribute(&cus, hipDeviceAttributeMultiprocessorCount, dev);
        hipFuncSetAttribute((const void*)fwd_megakernel, hipFuncAttributeMaxDynamicSharedMemorySize, LDS_BYTES);
        hipOccupancyMaxActiveBlocksPerMultiprocessor(&per_cu, (const void*)fwd_megakernel, 512, LDS_BYTES);
        if (per_cu < 1) per_cu = 1;
        (void)hipGetLastError();
        grid = cus;
    }
    if (grid < 0) return;
    Params p{};
    for (int i = 0; i < 25; ++i) p.in[i] = (const float*)d_in[i];
    p.out = (float*)d_out; p.ws = (unsigned char*)d_ws;
    (void)hipMemsetAsync((unsigned char*)d_ws + WS_BAR, 0, XCD_BAR_WORDS * 4, stream);
    void* args[] = {&p};
    hipError_t e = hipLaunchCooperativeKernel((const void*)fwd_megakernel, dim3(grid), dim3(512), args, LDS_BYTES, stream);
    if (e != hipSuccess) fprintf(stderr, "cooperative launch failed: %s (grid %d)\n", hipGetErrorString(e), grid);
}
```
